# Optimizing an MI355X kernel written in HIP

```python
import jax, jax.numpy as jnp
from jax import lax
import numpy as np

D_MODEL = 1024
BATCH = 8
SEQ = 2048
DEPTH = 1
DEC_BATCH = 128
DEC_SEQ = 4
PAST_LEN = 2048
PAGE_SIZE = 128

HEAD_DIM = 64
N_HEADS = 8
N_KV_HEADS = 2
GQA = N_HEADS // N_KV_HEADS
ATTN_WIDTH = N_HEADS * HEAD_DIM
D_RNN = D_MODEL - ATTN_WIDTH
RNN_BLOCKS = 8
RNN_BLOCK = D_RNN // RNN_BLOCKS
CONV_WIDTH = 4
LRU_C = 8.0
D_FF = 4 * D_MODEL
ROT_DIM = HEAD_DIM // 4
ROPE_THETA = 500000.0
CMP_BLOCK = 32
CMP_STRIDE = 16
SEL_BLOCK = 64
TOP_N = 16
WINDOW = 512
WIN_QBLK = 128
SLC_QBLK = 64
N_KV_SLOTS = 4
KV_COLS = N_KV_HEADS * HEAD_DIM
GATE_COLS = 3 * N_HEADS
IN_COLS = ATTN_WIDTH + 6 * KV_COLS + GATE_COLS + 2 * D_RNN
SPLITS = (ATTN_WIDTH, ATTN_WIDTH + KV_COLS, ATTN_WIDTH + 2 * KV_COLS, ATTN_WIDTH + 3 * KV_COLS,
          ATTN_WIDTH + 4 * KV_COLS, ATTN_WIDTH + 5 * KV_COLS, ATTN_WIDTH + 6 * KV_COLS,
          ATTN_WIDTH + 6 * KV_COLS + GATE_COLS, ATTN_WIDTH + 6 * KV_COLS + GATE_COLS + D_RNN)
EPS = 1e-6
NEG = -1e30
SEL_BONUS = 1e4

kernel_name = 'nsa_rglru_hybrid_step'


def rmsnorm(x, g):
    xf = x.astype(jnp.float32)
    y = xf * lax.rsqrt(jnp.mean(xf * xf, axis=-1, keepdims=True) + EPS) * g.astype(jnp.float32)
    return y.astype(x.dtype)


def rotary(x, pos):
    half = ROT_DIM // 2
    inv = ROPE_THETA ** (-jnp.arange(half, dtype=jnp.float32) / half)
    ang = pos.astype(jnp.float32)[:, None] * inv
    shp = (pos.shape[0],) + (1,) * (x.ndim - 3) + (half,)
    cos, sin = jnp.cos(ang).reshape(shp), jnp.sin(ang).reshape(shp)
    xf = x.astype(jnp.float32)
    x1, x2, rest = xf[..., :half], xf[..., half:ROT_DIM], xf[..., ROT_DIM:]
    return jnp.concatenate([x1 * cos - x2 * sin, x2 * cos + x1 * sin, rest], axis=-1).astype(x.dtype)


def attend(q, k, v, mask):
    s = jnp.einsum('...qhgd,...khd->...hgqk', q, k).astype(jnp.float32) * (HEAD_DIM ** -0.5)
    p = jax.nn.softmax(jnp.where(mask, s, NEG), axis=-1) * mask
    o = jnp.einsum('...hgqk,...khd->...qhgd', p.astype(v.dtype), v)
    return o, p


def compress(x, pe, w1, w2):
    T = x.shape[1]
    n_cmp = (T - CMP_BLOCK) // CMP_STRIDE + 1
    idx = np.arange(n_cmp)[:, None] * CMP_STRIDE + np.arange(CMP_BLOCK)[None, :]
    blocks = x[:, idx] + pe[:, None, :]
    hid = jax.nn.gelu(jnp.einsum('ncjhd,jde->nche', blocks, w1))
    return jnp.einsum('nche,ef->nchf', hid, w2)


def select_blocks(p_cmp, n_sel, qpos):
    n_cmp = p_cmp.shape[-1]
    c0 = np.arange(n_cmp) * CMP_STRIDE
    j0 = np.arange(n_sel) * SEL_BLOCK
    overlap = (c0[:, None] < j0[None, :] + SEL_BLOCK) & (c0[:, None] + CMP_BLOCK > j0[None, :])
    imp = jnp.einsum('nhgqc,cj->nhqj', p_cmp, jnp.asarray(overlap, jnp.float32))
    cur = qpos // SEL_BLOCK
    jj = jnp.arange(n_sel)
    valid = jj[None, :] <= cur[:, None]
    forced = (jj[None, :] == 0) | (jj[None, :] == cur[:, None]) | (jj[None, :] == cur[:, None] - 1)
    score = jnp.where(valid, imp, -SEL_BONUS) + jnp.where(forced, SEL_BONUS, 0.0)
    _, idx = lax.top_k(score, min(TOP_N, n_sel))
    return idx


def selected_attend(q, kb, vb, idx, qpos):
    gather = jax.vmap(jax.vmap(lambda blocks, ix: blocks[ix]))
    kg, vg = gather(kb, idx), gather(vb, idx)
    kpos = idx[..., None] * SEL_BLOCK + jnp.arange(SEL_BLOCK)
    mask = (kpos <= qpos[:, None, None])[:, :, None]
    s = jnp.einsum('nqhgd,nhqksd->nhgqks', q, kg).astype(jnp.float32) * (HEAD_DIM ** -0.5)
    s = jnp.where(mask, s, NEG)
    p = jax.nn.softmax(s.reshape(s.shape[:-2] + (-1,)), axis=-1).reshape(s.shape) * mask
    return jnp.einsum('nhgqks,nhqksd->nqhgd', p.astype(vg.dtype), vg)


def nsa_global(q, q_rot, kv_all, qpos, lw, q_chunk):
    N, T = kv_all.shape[:2]
    kc = compress(kv_all[:, :, 0], lw['pe_ck'], lw['w_ck1'], lw['w_ck2'])
    vc = compress(kv_all[:, :, 1], lw['pe_cv'], lw['w_cv1'], lw['w_cv2'])
    cmp_end = jnp.arange(kc.shape[1]) * CMP_STRIDE + CMP_BLOCK - 1
    o_cmp, p_cmp = attend(q, kc, vc, cmp_end[None, :] <= qpos[:, None])
    n_sel = -(-T // SEL_BLOCK)
    idx = select_blocks(p_cmp, n_sel, qpos)
    pad = n_sel * SEL_BLOCK - T

    def to_blocks(t):
        tp = jnp.pad(t, ((0, 0), (0, pad), (0, 0), (0, 0)))
        return tp.reshape(N, n_sel, SEL_BLOCK, N_KV_HEADS, HEAD_DIM).transpose(0, 3, 1, 2, 4)

    kb, vb = to_blocks(kv_all[:, :, 2]), to_blocks(kv_all[:, :, 3])
    Q = q.shape[1]
    if q_chunk is None or q_chunk >= Q:
        o_slc = selected_attend(q_rot, kb, vb, idx, qpos)
    else:
        nc = Q // q_chunk
        qs = jnp.moveaxis(q_rot.reshape((N, nc, q_chunk) + q_rot.shape[2:]), 1, 0)
        ids = jnp.moveaxis(idx.reshape(N, N_KV_HEADS, nc, q_chunk, idx.shape[-1]), 2, 0)
        ps = qpos.reshape(nc, q_chunk)
        o = lax.map(lambda a: selected_attend(a[0], kb, vb, a[1], a[2]), (qs, ids, ps))
        o_slc = jnp.moveaxis(o, 0, 1).reshape(q_rot.shape)
    return o_cmp, o_slc


def window_banded(q, k, v):
    N, S = q.shape[:2]
    nb, npv = S // WIN_QBLK, WINDOW // WIN_QBLK

    def band(t):
        tp = jnp.pad(t, ((0, 0), (WINDOW, 0), (0, 0), (0, 0)))
        tp = tp.reshape((N, nb + npv, WIN_QBLK) + t.shape[2:])
        return jnp.concatenate([tp[:, i:i + nb] for i in range(npv + 1)], axis=2)

    qb = q.reshape((N, nb, WIN_QBLK) + q.shape[2:])
    qpos = np.arange(nb)[:, None] * WIN_QBLK + np.arange(WIN_QBLK)[None, :]
    kpos = np.arange(nb)[:, None] * WIN_QBLK - WINDOW + np.arange((npv + 1) * WIN_QBLK)[None, :]
    qp, kp = qpos[:, :, None], kpos[:, None, :]
    mask = (kp <= qp) & (kp > qp - WINDOW) & (kp >= 0)
    o, _ = attend(qb, band(k), band(v), jnp.asarray(mask)[None, :, None, None])
    return o.reshape(q.shape)


def window_cached(q_rot, win_buf, win_new, qpos):
    Wc, Q = win_buf.shape[1], win_new.shape[1]
    rows = jnp.concatenate([win_buf, win_new], axis=1)
    kpos = PAST_LEN - Wc + jnp.arange(Wc + Q)
    mask = (kpos[None, :] <= qpos[:, None]) & (kpos[None, :] > qpos[:, None] - WINDOW)
    o, _ = attend(q_rot, rows[:, :, 0], rows[:, :, 1], mask)
    return o, rows[:, rows.shape[1] - Wc:]


def rglru(xr, conv_prev, h0, lw):
    N, T, _ = xr.shape
    xp = jnp.concatenate([conv_prev, xr], axis=1)
    w = lw['conv_w']
    xc = lw['conv_b'] + w[0] * xp[:, 0:T]
    for tap in range(1, CONV_WIDTH):
        xc = xc + w[tap] * xp[:, tap:tap + T]
    xb = xc.reshape(N, T, RNN_BLOCKS, RNN_BLOCK)
    r = jax.nn.sigmoid(jnp.einsum('ntbi,bij->ntbj', xb, lw['w_ra']).reshape(N, T, D_RNN) + lw['b_ra'])
    i = jax.nn.sigmoid(jnp.einsum('ntbi,bij->ntbj', xb, lw['w_ri']).reshape(N, T, D_RNN) + lw['b_ri'])
    log_a = -LRU_C * r.astype(jnp.float32) * jax.nn.softplus(-lw['lam'].astype(jnp.float32))
    a = jnp.exp(log_a)
    b = jnp.sqrt(-jnp.expm1(2.0 * log_a)) * (i * xc).astype(jnp.float32)
    b = b.at[:, 0].add(a[:, 0] * h0.astype(jnp.float32))
    _, h = lax.associative_scan(lambda l, rr: (l[0] * rr[0], rr[0] * l[1] + rr[1]), (a, b), axis=1)
    return h.astype(xr.dtype), xp[:, xp.shape[1] - (CONV_WIDTH - 1):], h[:, -1].astype(xr.dtype)


def project(u, w_in, pos):
    N, T, _ = u.shape
    z = u @ w_in
    q, kc, vc, ks, vs, kw, vw, gates, rg, rx = jnp.split(z, SPLITS, axis=-1)
    q = q.reshape(N, T, N_KV_HEADS, GQA, HEAD_DIM)
    kvr = lambda t: t.reshape(N, T, N_KV_HEADS, HEAD_DIM)
    kv_rows = jnp.stack([kvr(kc), kvr(vc), rotary(kvr(ks), pos), kvr(vs)], axis=2)
    win_rows = jnp.stack([rotary(kvr(kw), pos), kvr(vw)], axis=2)
    gates = jax.nn.sigmoid(gates).reshape(N, T, 3, N_KV_HEADS, GQA)
    return q, rotary(q, pos), kv_rows, win_rows, gates, rg, rx


def layer_step(x, pos, lw, kv_past=None, win_buf=None, conv_prev=None, h0=None):
    N, T, _ = x.shape
    u = rmsnorm(x, lw['norm_mix'])
    q, q_rot, kv_rows, win_rows, gates, rg, rx = project(u, lw['w_in'], pos)
    if kv_past is None:
        kv_all = kv_rows
        o_win = window_banded(q_rot, win_rows[:, :, 0], win_rows[:, :, 1])
        win_state = win_rows[:, T - min(WINDOW, T):]
        conv_prev = jnp.zeros((N, CONV_WIDTH - 1, D_RNN), x.dtype)
        h0 = jnp.zeros((N, D_RNN), x.dtype)
        q_chunk = SLC_QBLK
    else:
        kv_all = jnp.concatenate([kv_past, kv_rows], axis=1)
        o_win, win_state = window_cached(q_rot, win_buf, win_rows, pos)
        q_chunk = None
    o_cmp, o_slc = nsa_global(q, q_rot, kv_all, pos, lw, q_chunk)
    o_attn = (gates[:, :, 0, :, :, None] * o_cmp + gates[:, :, 1, :, :, None] * o_slc
              + gates[:, :, 2, :, :, None] * o_win).reshape(N, T, ATTN_WIDTH)
    h_rnn, conv_state, h_last = rglru(rx, conv_prev, h0, lw)
    mixed = jnp.concatenate([rmsnorm(o_attn, lw['g_attn']),
                             rmsnorm(jax.nn.gelu(rg) * h_rnn, lw['g_rnn'])], axis=-1)
    x = x + mixed @ lw['w_out']
    v = rmsnorm(x, lw['norm_mlp'])
    x = x + jnp.square(jax.nn.relu(v @ lw['w_up'])) @ lw['w_down']
    return x, kv_rows, win_state, conv_state, h_last


def setup_inputs(seed: int = 0) -> dict:
    key = jax.random.key(seed)
    ks = jax.random.split(key, 32)
    f32 = jnp.float32
    nrm = lambda k, shp, s: jax.random.normal(k, shp, f32) * s
    n_pages = PAST_LEN // PAGE_SIZE
    n_used = DEC_BATCH * n_pages
    n_pool = n_used + (n_used + 3) // 4
    perm = jax.random.permutation(ks[6], n_pool)
    page_table = perm[:n_used].reshape(DEC_BATCH, n_pages).astype(jnp.int32)
    a_base = jax.random.uniform(ks[22], (DEPTH, D_RNN), f32, 0.9 ** (1.0 / LRU_C), 0.999 ** (1.0 / LRU_C))
    return {
        'x_prompt': nrm(ks[0], (BATCH, SEQ, D_MODEL), 1.0),
        'x_sample': nrm(ks[1], (DEC_BATCH, DEC_SEQ, D_MODEL), 1.0),
        'cache_kv': nrm(ks[2], (DEPTH, n_pool, PAGE_SIZE, N_KV_SLOTS, N_KV_HEADS, HEAD_DIM), 1.0),
        'cache_win': nrm(ks[3], (DEPTH, DEC_BATCH, min(WINDOW, PAST_LEN), 2, N_KV_HEADS, HEAD_DIM), 1.0),
        'state_conv': nrm(ks[4], (DEPTH, DEC_BATCH, CONV_WIDTH - 1, D_RNN), 1.0),
        'state_rnn': nrm(ks[5], (DEPTH, DEC_BATCH, D_RNN), 0.5),
        'page_table': page_table,
        'w_in': nrm(ks[7], (DEPTH, D_MODEL, IN_COLS), D_MODEL ** -0.5),
        'pe_ck': nrm(ks[8], (DEPTH, CMP_BLOCK, HEAD_DIM), 0.5),
        'w_ck1': nrm(ks[9], (DEPTH, CMP_BLOCK, HEAD_DIM, HEAD_DIM), (CMP_BLOCK * HEAD_DIM) ** -0.5),
        'w_ck2': nrm(ks[10], (DEPTH, HEAD_DIM, HEAD_DIM), HEAD_DIM ** -0.5),
        'pe_cv': nrm(ks[11], (DEPTH, CMP_BLOCK, HEAD_DIM), 0.5),
        'w_cv1': nrm(ks[12], (DEPTH, CMP_BLOCK, HEAD_DIM, HEAD_DIM), (CMP_BLOCK * HEAD_DIM) ** -0.5),
        'w_cv2': nrm(ks[13], (DEPTH, HEAD_DIM, HEAD_DIM), HEAD_DIM ** -0.5),
        'g_attn': 1.0 + nrm(ks[14], (DEPTH, ATTN_WIDTH), 0.1),
        'g_rnn': 1.0 + nrm(ks[15], (DEPTH, D_RNN), 0.1),
        'conv_w': nrm(ks[16], (DEPTH, CONV_WIDTH, D_RNN), CONV_WIDTH ** -0.5),
        'conv_b': nrm(ks[17], (DEPTH, D_RNN), 0.01),
        'w_ra': nrm(ks[18], (DEPTH, RNN_BLOCKS, RNN_BLOCK, RNN_BLOCK), RNN_BLOCK ** -0.5),
        'b_ra': nrm(ks[19], (DEPTH, D_RNN), 0.01),
        'w_ri': nrm(ks[20], (DEPTH, RNN_BLOCKS, RNN_BLOCK, RNN_BLOCK), RNN_BLOCK ** -0.5),
        'b_ri': nrm(ks[21], (DEPTH, D_RNN), 0.01),
        'lam': jnp.log(a_base / (1.0 - a_base)),
        'w_out': nrm(ks[23], (DEPTH, D_MODEL, D_MODEL), D_MODEL ** -0.5),
        'norm_mix': 1.0 + nrm(ks[24], (DEPTH, D_MODEL), 0.1),
        'norm_mlp': 1.0 + nrm(ks[25], (DEPTH, D_MODEL), 0.1),
        'w_up': nrm(ks[26], (DEPTH, D_MODEL, D_FF), D_MODEL ** -0.5),
        'w_down': nrm(ks[27], (DEPTH, D_FF, D_MODEL), D_FF ** -0.5),
        'norm_final': 1.0 + nrm(ks[28], (D_MODEL,), 0.1),
    }


def reference(x_prompt, x_sample, cache_kv, cache_win, state_conv, state_rnn, page_table,
              w_in, pe_ck, w_ck1, w_ck2, pe_cv, w_cv1, w_cv2, g_attn, g_rnn,
              conv_w, conv_b, w_ra, b_ra, w_ri, b_ri, lam, w_out,
              norm_mix, norm_mlp, w_up, w_down, norm_final):
    pos_p = jnp.arange(x_prompt.shape[1], dtype=jnp.int32)
    pos_s = PAST_LEN + jnp.arange(x_sample.shape[1], dtype=jnp.int32)
    n_db = x_sample.shape[0]
    yp, ys = x_prompt, x_sample
    kv_p, kv_s, win_p, win_s, conv_p, conv_s, h_p, h_s = [], [], [], [], [], [], [], []
    for l in range(DEPTH):
        lw = {'w_in': w_in[l], 'pe_ck': pe_ck[l], 'w_ck1': w_ck1[l], 'w_ck2': w_ck2[l],
              'pe_cv': pe_cv[l], 'w_cv1': w_cv1[l], 'w_cv2': w_cv2[l], 'g_attn': g_attn[l], 'g_rnn': g_rnn[l],
              'conv_w': conv_w[l], 'conv_b': conv_b[l], 'w_ra': w_ra[l], 'b_ra': b_ra[l],
              'w_ri': w_ri[l], 'b_ri': b_ri[l], 'lam': lam[l], 'w_out': w_out[l],
              'norm_mix': norm_mix[l], 'norm_mlp': norm_mlp[l], 'w_up': w_up[l], 'w_down': w_down[l]}
        yp, a, b, c, d = layer_step(yp, pos_p, lw)
        kv_p.append(a); win_p.append(b); conv_p.append(c); h_p.append(d)
        past = cache_kv[l][page_table].reshape(n_db, -1, N_KV_SLOTS, N_KV_HEADS, HEAD_DIM)
        ys, a, b, c, d = layer_step(ys, pos_s, lw, past, cache_win[l], state_conv[l], state_rnn[l])
        kv_s.append(a); win_s.append(b); conv_s.append(c); h_s.append(d)
    y_prompt = rmsnorm(yp, norm_final)
    y_sample = rmsnorm(ys, norm_final)
    return (y_prompt, y_sample, jnp.stack(kv_p), jnp.stack(kv_s), jnp.stack(win_p), jnp.stack(win_s),
            jnp.stack(conv_p), jnp.stack(conv_s), jnp.stack(h_p), jnp.stack(h_s))
```

```cpp
#include <hip/hip_runtime.h>
#include <cstdio>
#include <cstdint>

constexpr int DM = 1024, NB = 8, SEQ = 2048, NS = 128, DT = 4;
constexpr int MP = NB * SEQ, MS = NS * DT, MT = MP + MS;
constexpr int NIN = 2560, FF = 4096;
constexpr float EPSN = 1e-6f;
constexpr size_t O_YP = 0, O_KV = 17301504, O_WINP = 25952256, O_WINS = 27000832, O_CONVP = 43778048, O_CONVS = 43790336, O_HP = 43986944, O_HS = 43991040;

namespace pg8 {
#define PG8_LAS __attribute__((address_space(3)))
typedef unsigned short bf16_t;
typedef short bf16x8 __attribute__((ext_vector_type(8)));
typedef float f32x4 __attribute__((ext_vector_type(4)));
typedef unsigned u32x4 __attribute__((ext_vector_type(4)));
constexpr int BM = 256, BK = 64, HALF = 128, HTB = HALF * BK * 2  , STAGE_BYTES = 8 * HTB, NXCD = 8, WGM = 8;

__host__ __device__ __forceinline__ int lds_byte(int r, int c) { const int st = (r >> 4) * 2 + (c >> 5), rr = r & 15, cc = c & 31, ob = rr * 64 + cc * 2; return st * 1024 + (ob ^ (((ob >> 9) & 1) << 5)); }
__host__ __device__ __forceinline__ void stage_rc(int b, int& R, int& C) { const int st = b / 1024, sb = b % 1024, swz = sb ^ (((sb >> 9) & 1) << 5); R = (st >> 1) * 16 + swz / 64; C = (st & 1) * 32 + (swz % 64) / 2; }
__host__ __device__ __forceinline__ int perm32(int rho) { const int n = rho >> 4, i = rho & 15; return 8 * (i >> 2) + 4 * n + (i & 3); }

struct Unit { int pm, pn; };
struct Gemm { const bf16_t* A; const bf16_t* Bt; int M, N, K; };

struct StaticOrder {
    int nM, nN, nwg, G, c;
    __host__ __device__ void init(int M, int N, int G_, int c_) { nM = M / BM; nN = N / BM; nwg = nM * nN; G = G_; c = c_; }
    __host__ __device__ bool next(int i, Unit& u) const {
        const long L = (long)i * G + c; if (L >= nwg) return false;
        int wgid = (int)L; { const int q = nwg / NXCD, r = nwg % NXCD, xcd = wgid % NXCD, off = wgid / NXCD; wgid = (xcd < r ? xcd * (q + 1) : r * (q + 1) + (xcd - r) * q) + off; }
        const int nig = WGM * nN, gid = wgid / nig, fm = gid * WGM, gsz = (nM - fm) < WGM ? (nM - fm) : WGM;
        u.pm = fm + ((wgid % nig) % gsz); u.pn = (wgid % nig) / gsz; return true;
    }
    __device__ __forceinline__ void a_ready(const Unit&) const {}
    __device__ __forceinline__ void done(const Unit&) const {}
};

__device__ __forceinline__ unsigned cvt_pk_bf16(float lo, float hi) { unsigned r; asm volatile("v_cvt_pk_bf16_f32 %0, %1, %2" : "=v"(r) : "v"(lo), "v"(hi)); return r; }
typedef unsigned u32x2 __attribute__((ext_vector_type(2)));
typedef float f32x2 __attribute__((ext_vector_type(2)));
__device__ __forceinline__ float gelu_tanh(float x) {
    const float y = 1.5957691216f * (x + 0.044715f * x * x * x);
    return x / (1.0f + __expf(-y));
}
__device__ __forceinline__ float sigmoidf_(float x) { return 1.0f / (1.0f + __expf(-x)); }
__device__ __forceinline__ u32x2 pack4(f32x4 v) { u32x2 w; w.x = cvt_pk_bf16(v[0], v[1]); w.y = cvt_pk_bf16(v[2], v[3]); return w; }

struct EpiProj {
    static constexpr bool PERM = false, AFTER_DRAIN = false;
    bf16_t *Qn, *Qr, *KS, *VS, *KW, *VW, *GRG; float *GATES, *RX, *out; const float* rot;
    __device__ __forceinline__ f32x4 rotate(f32x4 v, int pos, int fq) const {
        const float* tb = rot + pos * 16 + (fq & 1) * 4;
        const f32x4 cs = *(const f32x4*)tb, sn = *(const f32x4*)(tb + 8);
        f32x4 pr;
#pragma unroll
        for (int e = 0; e < 4; ++e) pr[e] = __shfl_xor(v[e], 32);
        const float sg = fq < 2 ? -1.f : 1.f;
        f32x4 w;
#pragma unroll
        for (int e = 0; e < 4; ++e) w[e] = v[e] * cs[e] + sg * pr[e] * sn[e];
        return w;
    }
    __device__ __forceinline__ void operator()(const f32x4 (&acc)[2][2][4][2], const Unit& u, int wr, int wc, int fr, int fq) const {
        asm volatile("" : "+v"(fr), "+v"(fq));
        const int pn = u.pn;
        const bool rotw = (wc & 1) == 0;
#pragma unroll
        for (int ai = 0; ai < 2; ++ai)
#pragma unroll
            for (int m = 0; m < 4; ++m) {
                const int row = u.pm * BM + ai * HALF + wr * 64 + m * 16 + fr;
                const bool samp = row >= MP;
                int t, pos, sq;
                if (!samp) { t = row & (SEQ - 1); pos = t; sq = row >> 11; } else { t = (row - MP) & 3; pos = SEQ + t; sq = (row - MP) >> 2; }
#pragma unroll
                for (int bj = 0; bj < 2; ++bj)
#pragma unroll
                    for (int n = 0; n < 2; ++n) {
                        const f32x4 v = acc[ai][bj][m][n];
                        const int cc = bj * HALF + wc * 32 + n * 16 + fq * 4;
                        if (pn < 2) {
                            const size_t o = (size_t)row * 512 + pn * 256 + cc;
                            *(u32x2*)(Qn + o) = pack4(v);
                            f32x4 w = v; if (n == 0 && rotw) w = rotate(v, pos, fq);
                            *(u32x2*)(Qr + o) = pack4(w);
                        } else if (pn == 2) {
                            *(f32x4*)(out + O_KV + (size_t)row * 512 + cc) = v;
                        } else if (pn == 3) {
                            f32x4 w = v; if (bj == 0 && n == 0 && rotw) w = rotate(v, pos, fq);
                            *(f32x4*)(out + O_KV + (size_t)row * 512 + 256 + cc) = w;
                            bf16_t* dst = (bj == 0 ? KS : VS) + (size_t)row * 128 + (cc & 127);
                            *(u32x2*)dst = pack4(w);
                        } else if (pn == 4) {
                            f32x4 w = v; if (bj == 0 && n == 0 && rotw) w = rotate(v, pos, fq);
                            bf16_t* dst = (bj == 0 ? KW : VW) + (size_t)row * 128 + (cc & 127);
                            *(u32x2*)dst = pack4(w);
                            if (!samp) { if (t >= SEQ - 512) *(f32x4*)(out + O_WINP + ((size_t)sq * 512 + (t - (SEQ - 512))) * 256 + cc) = w; }
                            else *(f32x4*)(out + O_WINS + ((size_t)sq * 512 + 508 + t) * 256 + cc) = w;
                        } else if (pn < 7) {
                            f32x4 g;
#pragma unroll
                            for (int e = 0; e < 4; ++e) g[e] = gelu_tanh(v[e]);
                            *(u32x2*)(GRG + (size_t)row * 512 + (pn - 5) * 256 + cc) = pack4(g);
                        } else if (pn < 9) {
                            const int c2 = (pn - 7) * 256 + cc;
                            *(f32x4*)(RX + (size_t)row * 512 + c2) = v;
                            if (!samp) { if (t >= SEQ - 3) *(f32x4*)(out + O_CONVP + ((size_t)sq * 3 + (t - (SEQ - 3))) * 512 + c2) = v; }
                            else if (t >= 1) *(f32x4*)(out + O_CONVS + ((size_t)sq * 3 + (t - 1)) * 512 + c2) = v;
                        } else {
                            if (cc < 24) { f32x4 g;
#pragma unroll
                                for (int e = 0; e < 4; ++e) g[e] = sigmoidf_(v[e]);
                                *(f32x4*)(GATES + (size_t)row * 24 + cc) = g; }
                        }
                    }
                asm volatile("" ::: "memory");
            }
    }
};

struct EpiOut {
    static constexpr bool PERM = false, AFTER_DRAIN = false;
    const float *xp, *xs; float* X1; bf16_t* XN; float* SS;
    __device__ __forceinline__ void operator()(const f32x4 (&acc)[2][2][4][2], const Unit& u, int wr, int wc, int fr, int fq) const {
#pragma unroll
        for (int ai = 0; ai < 2; ++ai)
#pragma unroll
            for (int m = 0; m < 4; ++m) {
                const int row = u.pm * BM + ai * HALF + wr * 64 + m * 16 + fr;
                const float* xr = row < MP ? xp + (size_t)row * DM : xs + (size_t)(row - MP) * DM;
                float ss = 0.f;
#pragma unroll
                for (int bj = 0; bj < 2; ++bj)
#pragma unroll
                    for (int n = 0; n < 2; ++n) {
                        const int c = u.pn * BM + bj * HALF + wc * 32 + n * 16 + fq * 4;
                        const f32x4 v = *(const f32x4*)(xr + c) + acc[ai][bj][m][n];
                        *(f32x4*)(X1 + (size_t)row * DM + c) = v;
                        *(u32x2*)(XN + (size_t)row * DM + c) = pack4(v);
                        ss += (v[0] * v[0] + v[1] * v[1]) + (v[2] * v[2] + v[3] * v[3]);
                    }
                ss += __shfl_xor(ss, 16); ss += __shfl_xor(ss, 32);
                if (fq == 0) atomicAdd(SS + row, ss);
            }
    }
};
struct EpiUp {
    static constexpr bool PERM = true, AFTER_DRAIN = false;
    bf16_t* H; const float* SS;
    __device__ __forceinline__ void operator()(const f32x4 (&acc)[2][2][4][2], const Unit& u, int wr, int wc, int fr, int fq) const {
#pragma unroll
        for (int ai = 0; ai < 2; ++ai)
#pragma unroll
            for (int m = 0; m < 4; ++m) {
                const int row = u.pm * BM + ai * HALF + wr * 64 + m * 16 + fr;
                const float rs = rsqrtf(SS[row] * (1.0f / DM) + EPSN);
#pragma unroll
                for (int bj = 0; bj < 2; ++bj) {
                    f32x4 v0 = acc[ai][bj][m][0] * rs, v1 = acc[ai][bj][m][1] * rs;
#pragma unroll
                    for (int e = 0; e < 4; ++e) { const float a = fmaxf(v0[e], 0.f), b = fmaxf(v1[e], 0.f); v0[e] = a * a; v1[e] = b * b; }
                    u32x4 w; w.x = cvt_pk_bf16(v0[0], v0[1]); w.y = cvt_pk_bf16(v0[2], v0[3]); w.z = cvt_pk_bf16(v1[0], v1[1]); w.w = cvt_pk_bf16(v1[2], v1[3]);
                    *(u32x4*)(H + (size_t)row * FF + u.pn * BM + bj * HALF + wc * 32 + 8 * fq) = w;
                }
            }
    }
};
struct EpiDown {
    static constexpr bool PERM = false, AFTER_DRAIN = false;
    const float* X1; float* Y; float* SS;
    __device__ __forceinline__ void operator()(const f32x4 (&acc)[2][2][4][2], const Unit& u, int wr, int wc, int fr, int fq) const {
#pragma unroll
        for (int ai = 0; ai < 2; ++ai)
#pragma unroll
            for (int m = 0; m < 4; ++m) {
                const int row = u.pm * BM + ai * HALF + wr * 64 + m * 16 + fr;
                float ss = 0.f;
#pragma unroll
                for (int bj = 0; bj < 2; ++bj)
#pragma unroll
                    for (int n = 0; n < 2; ++n) {
                        const int c = u.pn * BM + bj * HALF + wc * 32 + n * 16 + fq * 4;
                        const f32x4 v = *(const f32x4*)(X1 + (size_t)row * DM + c) + acc[ai][bj][m][n];
                        *(f32x4*)(Y + (size_t)row * DM + c) = v;
                        ss += (v[0] * v[0] + v[1] * v[1]) + (v[2] * v[2] + v[3] * v[3]);
                    }
                ss += __shfl_xor(ss, 16); ss += __shfl_xor(ss, 32);
                if (fq == 0) atomicAdd(SS + row, ss);
            }
    }
};

template <class Epi, class Sched, bool ALIGN_EPI = false, bool SP2 = false>
__device__ __forceinline__ void gemm_phase(PG8_LAS unsigned char* lds, const Gemm g, const Sched& S, const Epi& E) {
    const int tid = threadIdx.x, wid = __builtin_amdgcn_readfirstlane(tid >> 6), lane = tid & 63, wr = wid >> 2, wc = wid & 3, fr = lane & 15, fq = lane >> 4;
    const int K = g.K, nt = K / BK;
    unsigned voffA[2], voffB[2];
#pragma unroll
    for (int i = 0; i < 2; ++i) { int R, C; stage_rc(tid * 16 + i * 8192, R, C); const int Rb = Epi::PERM ? ((R & ~31) + perm32(R & 31)) : R;
        voffA[i] = (unsigned)(R * K + C) * 2u; voffB[i] = (unsigned)(Rb * K + C) * 2u; }
    const size_t kstep = (size_t)(BK * 2);
    const size_t hstep = (size_t)HALF * K * 2;
    const size_t tstep = 2 * hstep;
    const unsigned ldsw = (unsigned)wid * 1024u;
    const int aoff = lds_byte(wr * 64 + fr, fq * 8), boff = lds_byte(wc * 32 + fr, fq * 8);
#define PG8_SA(b, h) (((b) * 2 + (h)) * HTB)
#define PG8_SB(b, h) ((4 + (b) * 2 + (h)) * HTB)
#define PG8_STAGE(bufoff, gbase, voff) do { _Pragma("unroll") for (int _i = 0; _i < 2; ++_i) \
        __builtin_amdgcn_global_load_lds((const unsigned*)((const char*)(gbase) + (voff)[_i]), (PG8_LAS unsigned*)(lds + (bufoff) + ldsw + _i * 8192), 16, 0, 0); } while (0)
#define PG8_LDA(dst, b, h) do { _Pragma("unroll") for (int m = 0; m < 4; ++m) _Pragma("unroll") for (int k = 0; k < 2; ++k) dst[m][k] = *(const PG8_LAS bf16x8*)(lds + PG8_SA(b, h) + aoff + m * 2048 + k * 1024); } while (0)
#define PG8_LDB(dst, b, h) do { _Pragma("unroll") for (int n = 0; n < 2; ++n) _Pragma("unroll") for (int k = 0; k < 2; ++k) dst[n][k] = *(const PG8_LAS bf16x8*)(lds + PG8_SB(b, h) + boff + n * 2048 + k * 1024); } while (0)
#define PG8_MMA(ai, bj, At, Bt) do { __builtin_amdgcn_s_setprio(1); _Pragma("unroll") for (int m = 0; m < 4; ++m) _Pragma("unroll") for (int n = 0; n < 2; ++n) _Pragma("unroll") for (int k = 0; k < 2; ++k) \
        acc[ai][bj][m][n] = __builtin_amdgcn_mfma_f32_16x16x32_bf16(Bt[n][k], At[m][k], acc[ai][bj][m][n], 0, 0, 0); __builtin_amdgcn_s_setprio(0); } while (0)
#define PG8_WAIT_V(n) asm volatile("s_waitcnt vmcnt(" #n ")" ::: "memory")
#define PG8_WAIT_L(n) asm volatile("s_waitcnt lgkmcnt(" #n ")" ::: "memory")
#define PG8_BAR __builtin_amdgcn_s_barrier()
#define PG8_SCHED __builtin_amdgcn_sched_barrier(0)
    Unit cur, nxt; int ui = 0;
    if (!S.next(0, cur)) return;
    f32x4 acc[2][2][4][2];
#pragma unroll
    for (int a = 0; a < 2; ++a)
#pragma unroll
        for (int b = 0; b < 2; ++b)
#pragma unroll
            for (int m = 0; m < 4; ++m)
#pragma unroll
                for (int n = 0; n < 2; ++n) acc[a][b][m][n] = (f32x4){0.f, 0.f, 0.f, 0.f};
    bf16x8 At[4][2], B0[2][2], B1[2][2];
    const char* cA = (const char*)g.A + (size_t)cur.pm * tstep; const char* cB = (const char*)g.Bt + (size_t)cur.pn * tstep;
    S.a_ready(cur);
    if constexpr (SP2) {
        PG8_STAGE(PG8_SB(0, 0), cB, voffB); PG8_STAGE(PG8_SB(0, 1), cB + hstep, voffB); PG8_STAGE(PG8_SA(0, 0), cA, voffA); PG8_STAGE(PG8_SA(0, 1), cA + hstep, voffA);
        if (wr == 1) PG8_BAR;
        PG8_WAIT_V(2); PG8_BAR;
        PG8_STAGE(PG8_SB(1, 0), cB + kstep, voffB); PG8_STAGE(PG8_SA(1, 0), cA + kstep, voffA); PG8_STAGE(PG8_SB(1, 1), cB + hstep + kstep, voffB);
        PG8_WAIT_V(6); PG8_BAR;
    } else {
        PG8_STAGE(PG8_SB(0, 0), cB, voffB); PG8_STAGE(PG8_SA(0, 0), cA, voffA); PG8_STAGE(PG8_SB(0, 1), cB + hstep, voffB); PG8_STAGE(PG8_SA(0, 1), cA + hstep, voffA);
        if (wr == 1) PG8_BAR;
        PG8_WAIT_V(4); PG8_BAR;
        PG8_STAGE(PG8_SB(1, 0), cB + kstep, voffB); PG8_STAGE(PG8_SA(1, 0), cA + kstep, voffA); PG8_STAGE(PG8_SB(1, 1), cB + hstep + kstep, voffB);
        PG8_WAIT_V(6); PG8_BAR;
    }
    for (;;) {
        const bool has_next = S.next(ui + 1, nxt);
        const char* nA = has_next ? (const char*)g.A + (size_t)nxt.pm * tstep : cA; const char* nB = has_next ? (const char*)g.Bt + (size_t)nxt.pn * tstep : cB;
        for (int t = 0; t < nt; t += 2) {
            const bool last = (t == nt - 2);
            const char* a1 = cA + (size_t)(t + 1) * kstep;
            const char* a2 = last ? nA : cA + (size_t)(t + 2) * kstep; const char* b2 = last ? nB : cB + (size_t)(t + 2) * kstep;
            const char* a3 = a2 + kstep; const char* b3 = b2 + kstep;
            if (last && has_next) S.a_ready(nxt);
            if constexpr (SP2) {
            PG8_LDB(B0, 0, 0); PG8_LDB(B1, 0, 1); PG8_SCHED; PG8_LDA(At, 0, 0); PG8_STAGE(PG8_SA(1, 1), a1 + hstep, voffA);
            PG8_WAIT_V(8); PG8_WAIT_L(0); PG8_BAR; PG8_MMA(0, 0, At, B0); PG8_MMA(0, 1, At, B1); PG8_BAR; PG8_SCHED;
            PG8_LDA(At, 0, 1); PG8_STAGE(PG8_SB(0, 0), b2, voffB); PG8_STAGE(PG8_SB(0, 1), b2 + hstep, voffB); PG8_STAGE(PG8_SA(0, 0), a2, voffA);
            PG8_WAIT_V(8); PG8_WAIT_L(0); PG8_BAR; PG8_MMA(1, 0, At, B0); PG8_MMA(1, 1, At, B1); PG8_BAR; PG8_SCHED;
            PG8_LDB(B0, 1, 0); PG8_LDB(B1, 1, 1); PG8_SCHED; PG8_LDA(At, 1, 0); PG8_STAGE(PG8_SA(0, 1), a2 + hstep, voffA);
            PG8_WAIT_V(8); PG8_WAIT_L(0); PG8_BAR; PG8_MMA(0, 0, At, B0); PG8_MMA(0, 1, At, B1); PG8_BAR; PG8_SCHED;
            PG8_LDA(At, 1, 1); PG8_STAGE(PG8_SB(1, 0), b3, voffB); PG8_STAGE(PG8_SB(1, 1), b3 + hstep, voffB); PG8_STAGE(PG8_SA(1, 0), a3, voffA);
            PG8_WAIT_V(8); PG8_WAIT_L(0); PG8_BAR; PG8_MMA(1, 0, At, B0); PG8_MMA(1, 1, At, B1); PG8_BAR; PG8_SCHED;
            } else {
            PG8_LDB(B0, 0, 0); PG8_SCHED; PG8_LDA(At, 0, 0); PG8_STAGE(PG8_SA(1, 1), a1 + hstep, voffA);
            PG8_WAIT_L(8); PG8_BAR; PG8_WAIT_L(0); PG8_MMA(0, 0, At, B0); PG8_BAR; PG8_SCHED;
            PG8_LDB(B1, 0, 1); PG8_STAGE(PG8_SB(0, 0), b2, voffB);
            PG8_BAR; PG8_WAIT_L(0); PG8_MMA(0, 1, At, B1); PG8_BAR;
            PG8_LDA(At, 0, 1); PG8_STAGE(PG8_SA(0, 0), a2, voffA);
            PG8_BAR; PG8_WAIT_L(0); PG8_MMA(1, 0, At, B0); PG8_BAR; PG8_SCHED;
            PG8_STAGE(PG8_SB(0, 1), b2 + hstep, voffB);
            PG8_WAIT_V(6); PG8_BAR; PG8_MMA(1, 1, At, B1); PG8_BAR;
            PG8_LDB(B0, 1, 0); PG8_SCHED; PG8_LDA(At, 1, 0); PG8_STAGE(PG8_SA(0, 1), a2 + hstep, voffA);
            PG8_WAIT_L(8); PG8_BAR; PG8_WAIT_L(0); PG8_MMA(0, 0, At, B0); PG8_BAR; PG8_SCHED;
            PG8_LDB(B1, 1, 1); PG8_STAGE(PG8_SB(1, 0), b3, voffB);
            PG8_BAR; PG8_WAIT_L(0); PG8_MMA(0, 1, At, B1); PG8_BAR;
            PG8_LDA(At, 1, 1); PG8_STAGE(PG8_SA(1, 0), a3, voffA);
            PG8_BAR; PG8_WAIT_L(0); PG8_MMA(1, 0, At, B0); PG8_BAR; PG8_SCHED;
            PG8_STAGE(PG8_SB(1, 1), b3 + hstep, voffB);
            PG8_WAIT_V(6); PG8_BAR; PG8_MMA(1, 1, At, B1); PG8_BAR;
            }
        }
        if constexpr (ALIGN_EPI) { if (wr == 0) PG8_BAR; }
        if constexpr (!Epi::AFTER_DRAIN) { E(acc, cur, wr, wc, fr, fq); S.done(cur); }
        if (!has_next) break;
#pragma unroll
        for (int a = 0; a < 2; ++a)
#pragma unroll
            for (int b = 0; b < 2; ++b)
#pragma unroll
                for (int m = 0; m < 4; ++m)
#pragma unroll
                    for (int n = 0; n < 2; ++n) acc[a][b][m][n] = (f32x4){0.f, 0.f, 0.f, 0.f};
        cur = nxt; cA = nA; cB = nB; ++ui;
        if constexpr (ALIGN_EPI) { if (wr == 1) PG8_BAR; }
    }
    PG8_WAIT_V(0);
    if constexpr (!ALIGN_EPI) { if (wr == 0) PG8_BAR; }
    PG8_BAR;
    if constexpr (Epi::AFTER_DRAIN) { E.fused(acc, cur, wr, wc, fr, fq, lds, wid, lane); S.done(cur); }
#undef PG8_SA
#undef PG8_SB
#undef PG8_STAGE
#undef PG8_LDA
#undef PG8_LDB
#undef PG8_MMA
#undef PG8_WAIT_V
#undef PG8_WAIT_L
#undef PG8_BAR
#undef PG8_SCHED
}
}
constexpr size_t MiB = 1u << 20;
constexpr size_t WS_CTL = 0, CTL_ZERO_BYTES = 1 * MiB;
constexpr int CW_BAR = 4096;
constexpr int CW_Q2 = 8192, CW_Q3 = 8192 + 64;
constexpr size_t CTL_SS1 = 256 * 1024, CTL_SS2 = 384 * 1024, CTL_B1 = 640 * 1024;
constexpr size_t WS_ROT = 1 * MiB;
constexpr size_t WS_WC1 = 2 * MiB;
constexpr size_t WS_WC2 = WS_WC1 + 512 * 1024;
constexpr size_t WS_B1 = WS_WC2 + 32 * 1024;
constexpr size_t WS_WR = WS_B1 + 32 * 1024;
constexpr size_t WS_WIN = 4 * MiB, WS_WOUT = 10 * MiB, WS_WUP = 12 * MiB, WS_WDN = 20 * MiB;
constexpr size_t WS_XN = 32 * MiB;
constexpr size_t WS_QN = 66 * MiB, WS_QR = 83 * MiB;
constexpr size_t WS_KS = 100 * MiB, WS_VS = 105 * MiB, WS_KW = 110 * MiB, WS_VW = 115 * MiB;
constexpr size_t WS_GATES = 120 * MiB;
constexpr size_t WS_GRG = 122 * MiB;
constexpr size_t WS_RX = 139 * MiB;
constexpr size_t WS_HL = 172 * MiB, WS_AC = 205 * MiB;
constexpr size_t WS_SUMM = 238 * MiB;
constexpr size_t WS_KCC = 240 * MiB, WS_VCC = 245 * MiB;
constexpr size_t WS_MIXED = 250 * MiB;
constexpr size_t WS_X1 = 284 * MiB;
constexpr size_t WS_H = 352 * MiB;
constexpr size_t WS_END = 486 * MiB;

constexpr int NWAVES = 8;
constexpr int RING_BYTES = 131072, MISC_OFF = RING_BYTES + 320, LDS_BYTES = 147456;

#define GAS __attribute__((address_space(1)))
#define LAS __attribute__((address_space(3)))
typedef unsigned short bf16;
typedef unsigned v4u __attribute__((ext_vector_type(4)));
typedef unsigned v2u __attribute__((ext_vector_type(2)));
typedef float f32x4 __attribute__((ext_vector_type(4)));
typedef float f32x16 __attribute__((ext_vector_type(16)));
typedef short bf16x8 __attribute__((ext_vector_type(8)));
typedef short s16x4 __attribute__((ext_vector_type(4)));
typedef GAS unsigned gu32;
#define RLX_AGENT __ATOMIC_RELAXED, __HIP_MEMORY_SCOPE_AGENT
#define LDS_WAIT() asm volatile("s_waitcnt lgkmcnt(0)" ::: "memory")
typedef float f32x2_t __attribute__((ext_vector_type(2))); typedef __bf16 bf16x2_t __attribute__((ext_vector_type(2)));
__device__ __forceinline__ unsigned pk2(float lo, float hi) { f32x2_t v = {lo, hi}; bf16x2_t b = __builtin_convertvector(v, bf16x2_t); return __builtin_bit_cast(unsigned, b); }
__device__ __forceinline__ float bf2f(unsigned short h) { return __builtin_bit_cast(float, (unsigned)h << 16); }
__device__ __forceinline__ float bflo(unsigned w) { return __builtin_bit_cast(float, w << 16); }
__device__ __forceinline__ float bfhi(unsigned w) { return __builtin_bit_cast(float, w & 0xffff0000u); }
__device__ __forceinline__ float wave_sum(float v) {
#pragma unroll
    for (int o = 1; o < 64; o <<= 1) v += __shfl_xor(v, o);
    return v;
}

#define XB_TMO      128
#define XB_XCNT(j)  (256  + 64 * (j))
#define XB_XSUB(j)  (1280 + 64 * (j))
#define XB_XGEN(j)  (2304 + 64 * (j))
#define XB_TOP      3328
#define XB_TOPGEN   3392
#define XCD_BAR_WORDS 3456
#define XB_SPIN_CAP (1u << 18)

__device__ __forceinline__ unsigned xb_ld(unsigned* p)              { return __hip_atomic_load(p, __ATOMIC_RELAXED, __HIP_MEMORY_SCOPE_AGENT); }
__device__ __forceinline__ unsigned xb_add(unsigned* p, unsigned v) { return __hip_atomic_fetch_add(p, v, __ATOMIC_RELAXED, __HIP_MEMORY_SCOPE_AGENT); }
__device__ __forceinline__ unsigned xb_xcc_id() { return (unsigned)__builtin_amdgcn_s_getreg((3 << 11) | 20) & 0xFu; }
#define XB_SPIN(cond, bar) do { unsigned _sp = 0; while (cond) { __builtin_amdgcn_s_sleep(1); \
    if ((++_sp & 255u) == 0u) { if (xb_ld(&(bar)[XB_TMO])) break; if (_sp > XB_SPIN_CAP) { atomicAdd(&(bar)[XB_TMO], 1u); break; } } } } while (0)

struct XcdBarrier {
    unsigned* bar; unsigned x;
    volatile LAS unsigned* st;
};

__device__ __forceinline__ XcdBarrier xcd_barrier_post(unsigned* bar, volatile LAS unsigned* st) {
    XcdBarrier b; b.bar = bar; b.x = xb_xcc_id(); b.st = st;
    if (threadIdx.x == 0) (void)xb_add(&bar[XB_XCNT(b.x)], 1u);
    return b;
}
__device__ __forceinline__ void xcd_barrier_complete(unsigned* bar, unsigned x, unsigned& nloc, unsigned& nx) {
    const unsigned G = gridDim.x * gridDim.y * gridDim.z;
    unsigned sum, cnt, mine, sp = 0u;
    for (;;) {
        sum = 0u; cnt = 0u; mine = 0u;
#pragma unroll
        for (unsigned j = 0; j < 16; ++j) { const unsigned c = xb_ld(&bar[XB_XCNT(j)]); sum += c; cnt += (c > 0u) ? 1u : 0u; mine = (j == x) ? c : mine; }
        if (sum == G) break;
        __builtin_amdgcn_s_sleep(1);
        if ((++sp & 255u) == 0u) { if (xb_ld(&bar[XB_TMO])) break; if (sp > XB_SPIN_CAP) { atomicAdd(&bar[XB_TMO], 1u); break; } }
    }
    nloc = mine > 0u ? mine : 1u; nx = cnt > 0u ? cnt : 1u;
}

__device__ __forceinline__ void xcd_barrier(const XcdBarrier& b) {
    asm volatile("s_waitcnt vmcnt(0)" ::: "memory");
    __syncthreads();
    if (threadIdx.x == 0) {
        unsigned* bar = b.bar;
        __builtin_amdgcn_s_waitcnt(0);
        unsigned nloc = b.st[0], nx = b.st[1];
        if (nloc == 0u) { xcd_barrier_complete(bar, b.x, nloc, nx); b.st[0] = nloc; b.st[1] = nx; }
        const unsigned old = xb_add(&bar[XB_XSUB(b.x)], 1u);
        const unsigned gen = old / nloc;
        if (old + 1u == (gen + 1u) * nloc) {
            __builtin_amdgcn_fence(__ATOMIC_RELEASE, "agent");
            asm volatile("s_waitcnt vmcnt(0)" ::: "memory");
            const unsigned og = xb_add(&bar[XB_TOP], 1u);
            const unsigned tg = og / nx;
            if (og + 1u == (tg + 1u) * nx) xb_add(&bar[XB_TOPGEN], 1u);
            else XB_SPIN(xb_ld(&bar[XB_TOPGEN]) == tg, bar);
            __builtin_amdgcn_fence(__ATOMIC_ACQUIRE, "agent");
            xb_add(&bar[XB_XGEN(b.x)], 1u);
            asm volatile("s_waitcnt vmcnt(0)" ::: "memory");
        } else {
            XB_SPIN(xb_ld(&bar[XB_XGEN(b.x)]) == gen, bar);
            __builtin_amdgcn_fence(__ATOMIC_ACQUIRE, "agent");
            asm volatile("s_waitcnt vmcnt(0)" ::: "memory");
        }
    }
    __syncthreads();
}

struct Frame {
    LAS unsigned char* lds;
    int tid, lane, wave, G, vcu;
    const float* const* in; const int* page_table;
    float* out; unsigned char* ws; gu32* ctl;
};
#define WSP(T, off) ((T*)(F.ws + (off)))

template <int MAP>
__device__ __forceinline__ void p0_transpose_item(const float* W, int ldw, int K, int Nphys, bf16* WT, int row_off, LAS float* scr, int item, int lane, const float* kscale) {
    const int nblk = Nphys / 32, kb = item / nblk, nb = item % nblk, k0 = 64 * kb, n0 = 32 * nb;
    const int np = n0 + (lane & 31);
    int ln = np;
    if (MAP == 1) ln = np < 1280 ? np : (np < 2304 ? np + 24 : (np < 2328 ? np - 1024 : -1));
#pragma unroll 8
    for (int i = 0; i < 32; ++i) { const int kk = 2 * i + (lane >> 5);
        float v = ln >= 0 ? W[(size_t)(k0 + kk) * ldw + ln] : 0.f;
        if (kscale) v *= kscale[k0 + kk];
        scr[kk * 33 + (lane & 31)] = v; }
    LDS_WAIT(); asm volatile("" ::: "memory");
    const int c = lane & 7;
#pragma unroll
    for (int j = 0; j < 4; ++j) { const int n = (lane >> 3) + 8 * j; const LAS float* s = scr + (8 * c) * 33 + n;
        v4u o; o.x = pk2(s[0 * 33], s[1 * 33]); o.y = pk2(s[2 * 33], s[3 * 33]); o.z = pk2(s[4 * 33], s[5 * 33]); o.w = pk2(s[6 * 33], s[7 * 33]);
        *(GAS v4u*)(WT + (size_t)(row_off + n0 + n) * K + k0 + 8 * c) = o; }
    LDS_WAIT(); asm volatile("" ::: "memory");
}
__device__ __forceinline__ void rms_row_to_bf16(const float* xrow, const float* g, bf16* orow, int lane) {
    const GAS f32x4* xr = (const GAS f32x4*)xrow + lane; const GAS f32x4* gr = (const GAS f32x4*)g + lane;
    f32x4 v[4]; float s = 0.f;
#pragma unroll
    for (int j = 0; j < 4; ++j) { v[j] = xr[64 * j]; s += (v[j].x * v[j].x + v[j].y * v[j].y) + (v[j].z * v[j].z + v[j].w * v[j].w); }
    const float rs = rsqrtf(wave_sum(s) * (1.f / DM) + EPSN);
    GAS unsigned long long* o8 = (GAS unsigned long long*)orow + lane;
#pragma unroll
    for (int j = 0; j < 4; ++j) { const f32x4 gg = gr[64 * j];
        o8[64 * j] = (unsigned long long)pk2(v[j].x * rs * gg.x, v[j].y * rs * gg.y) | ((unsigned long long)pk2(v[j].z * rs * gg.z, v[j].w * rs * gg.w) << 32); }
}
__device__ __forceinline__ void p0_prologue(Frame& F) {
    LAS float* scr = (LAS float*)(F.lds + F.wave * 16384);
    const int gw = F.vcu * NWAVES + F.wave, NGW = F.G * NWAVES;
    constexpr int I_IN = 16 * (NIN / 32), I_OUT = 16 * 32, I_UP = 16 * (FF / 32), I_DN = 64 * 32, I_C1 = 4 * 32, I_C2 = 2 * 2, I_R = 16 * 2;
    constexpr int NITEMS = I_IN + I_OUT + I_UP + I_DN + I_C1 + I_C2 + I_R;
    for (int it = gw; it < NITEMS; it += NGW) {
        int r = it;
        if (r < I_IN) { p0_transpose_item<1>(F.in[7], 2328, DM, NIN, WSP(bf16, WS_WIN), 0, scr, r, F.lane, nullptr); continue; } r -= I_IN;
        if (r < I_OUT) { p0_transpose_item<0>(F.in[23], DM, DM, DM, WSP(bf16, WS_WOUT), 0, scr, r, F.lane, nullptr); continue; } r -= I_OUT;
        if (r < I_UP) { p0_transpose_item<0>(F.in[26], FF, DM, FF, WSP(bf16, WS_WUP), 0, scr, r, F.lane, F.in[25]); continue; } r -= I_UP;
        if (r < I_DN) { p0_transpose_item<0>(F.in[27], DM, FF, DM, WSP(bf16, WS_WDN), 0, scr, r, F.lane, nullptr); continue; } r -= I_DN;
        if (r < I_C1) { const int q = r / 32, slot = q >> 1, half = q & 1;
            p0_transpose_item<0>(F.in[slot ? 12 : 9] + (size_t)half * 1024 * 64, 64, 1024, 64, WSP(bf16, WS_WC1) + (size_t)slot * 128 * 1024, half * 64, scr, r % 32, F.lane, nullptr); continue; } r -= I_C1;
        if (r < I_C2) { const int slot = r >> 1;
            p0_transpose_item<0>(F.in[slot ? 13 : 10], 64, 64, 64, WSP(bf16, WS_WC2) + (size_t)slot * 4096, 0, scr, r & 1, F.lane, nullptr); continue; } r -= I_C2;
        { const int q = r >> 1, blk = q >> 1, which = q & 1;
            p0_transpose_item<0>(F.in[which ? 20 : 18] + (size_t)blk * 4096, 64, 64, 64, WSP(bf16, WS_WR) + (size_t)blk * 8192, which * 64, scr, r & 1, F.lane, nullptr); }
    }
    { const int gt = gw * 64 + F.lane;
      if (gt < 2052 * 8) { const int pos = gt >> 3, i = gt & 7;
          const double inv = pow(500000.0, -(double)i / 8.0), ang = (double)pos * inv;
          float* rt = WSP(float, WS_ROT) + pos * 16; rt[i] = (float)cos(ang); rt[8 + i] = (float)sin(ang); } }
    if (gw >= NGW - 64) { const int idx = gw - (NGW - 64), slot = idx >> 5, kp = idx & 31; const float* pe = F.in[slot ? 11 : 8] + kp * 64; const float* w1 = F.in[slot ? 12 : 9] + (size_t)kp * 64 * 64;
        float a = 0.f;
#pragma unroll 16
        for (int k = 0; k < 64; ++k) a += pe[k] * w1[(size_t)k * 64 + F.lane];
        atomicAdd((float*)(F.ws + WS_CTL + CTL_B1) + slot * 64 + F.lane, a); }
    for (int m = gw; m < MT; m += NGW) {
        const float* xr = m < MP ? F.in[0] + (size_t)m * DM : F.in[1] + (size_t)(m - MP) * DM;
        rms_row_to_bf16(xr, F.in[24], WSP(bf16, WS_XN) + (size_t)m * DM, F.lane);
    }
}
__device__ __forceinline__ void p7_final(Frame& F) {
    const int gw = F.vcu * NWAVES + F.wave, NGW = F.G * NWAVES;
    const float* ss = (const float*)(F.ws + WS_CTL + CTL_SS2);
    const GAS f32x4* gr = (const GAS f32x4*)F.in[28] + F.lane;
    for (int m = gw; m < MT; m += NGW) {
        const float rs = rsqrtf(ss[m] * (1.f / DM) + EPSN);
        GAS f32x4* yr = (GAS f32x4*)(F.out + (size_t)m * DM) + F.lane;
#pragma unroll
        for (int j = 0; j < 4; ++j) { f32x4 v = yr[64 * j]; const f32x4 g = gr[64 * j]; v = v * rs * g; yr[64 * j] = v; }
    }
}

__device__ __forceinline__ void rnn_unit(Frame& F, int u) {
    const int b = F.wave, lane = F.lane, fr = lane & 15, fq = lane >> 4;
    const bool samp = u >= 256;
    const int rowbase = samp ? MP + 64 * (u - 256) : (u >> 5) * SEQ + (u & 31) * 64;
    const int t0 = samp ? 0 : (u & 31) * 64;
    const float* RX = WSP(float, WS_RX); float* HL = WSP(float, WS_HL); float* AC = WSP(float, WS_AC);
    const float* convw = F.in[16]; const float* convb = F.in[17]; const float* stc = F.in[4]; const float* sth = F.in[5];
    LAS float* xcs = (LAS float*)(F.lds + b * 8704);
    const bf16* wrp = WSP(bf16, WS_WR) + (size_t)b * 8192 + fr * 64 + 8 * fq;
    float hc[4], Ac[4];
#pragma unroll
    for (int nn = 0; nn < 4; ++nn) { hc[nn] = 0.f; Ac[nn] = 1.f; }
    for (int sub = 0; sub < 2; ++sub) {
        bf16x8 af[2][2];
#pragma unroll
        for (int m = 0; m < 2; ++m) {
            const int tau = 32 * sub + 16 * m + fr;
#pragma unroll
            for (int ks = 0; ks < 2; ++ks) {
                const int cbase = 64 * b + 32 * ks + 8 * fq;
                f32x4 xa = *(const f32x4*)(convb + cbase), xb = *(const f32x4*)(convb + cbase + 4);
#pragma unroll
                for (int k = 0; k < 4; ++k) {
                    const float* src; bool ok = true;
                    if (!samp) { const int rr = tau - 3 + k; ok = (t0 + rr) >= 0; src = RX + (size_t)(rowbase + rr) * 512 + cbase; }
                    else { const int r2 = (tau & 3) - 3 + k;
                        if (r2 >= 0) src = RX + (size_t)(rowbase + (tau & ~3) + r2) * 512 + cbase;
                        else src = stc + ((size_t)((u - 256) * 16 + (tau >> 2)) * 3 + (3 + r2)) * 512 + cbase; }
                    f32x4 v0 = (f32x4){0.f, 0.f, 0.f, 0.f}, v1 = v0;
                    if (ok) { v0 = *(const f32x4*)src; v1 = *(const f32x4*)(src + 4); }
                    const f32x4 w0 = *(const f32x4*)(convw + k * 512 + cbase), w1 = *(const f32x4*)(convw + k * 512 + cbase + 4);
                    xa += w0 * v0; xb += w1 * v1;
                }
                v4u pk; pk.x = pk2(xa[0], xa[1]); pk.y = pk2(xa[2], xa[3]); pk.z = pk2(xb[0], xb[1]); pk.w = pk2(xb[2], xb[3]);
                af[m][ks] = __builtin_bit_cast(bf16x8, pk);
                LAS float* xd = xcs + (16 * m + fr) * 68 + 32 * ks + 8 * fq;
                *(LAS f32x4*)xd = xa; *(LAS f32x4*)(xd + 4) = xb;
            }
        }
        LDS_WAIT();
#pragma unroll 1
        for (int nn = 0; nn < 4; ++nn) {
            const int ch = 64 * b + 16 * nn + fr;
            const float bra = F.in[19][ch], bri = F.in[21][ch], sp = log1pf(__expf(-F.in[22][ch]));
            f32x4 acc[2][2];
#pragma unroll
            for (int m = 0; m < 2; ++m) { acc[m][0] = (f32x4){0.f, 0.f, 0.f, 0.f}; acc[m][1] = acc[m][0]; }
#pragma unroll
            for (int g = 0; g < 2; ++g)
#pragma unroll
                for (int ks = 0; ks < 2; ++ks) { const bf16x8 wv = *(const bf16x8*)(wrp + (size_t)(64 * g + 16 * nn) * 64 + 32 * ks);
#pragma unroll
                    for (int m = 0; m < 2; ++m) acc[m][g] = __builtin_amdgcn_mfma_f32_16x16x32_bf16(af[m][ks], wv, acc[m][g], 0, 0, 0); }
            float hcn = 0.f, acn = 1.f;
#pragma unroll
            for (int q = 0; q < 4; ++q) if (q == nn) { hcn = hc[q]; acn = Ac[q]; }
#pragma unroll
            for (int m = 0; m < 2; ++m) {
                float a[4], bb[4];
#pragma unroll
                for (int e = 0; e < 4; ++e) {
                    const float r = 1.f / (1.f + __expf(-(acc[m][0][e] + bra)));
                    const float ig = 1.f / (1.f + __expf(-(acc[m][1][e] + bri)));
                    const float la = -8.0f * r * sp;
                    a[e] = __expf(la);
                    const float xcv = xcs[(16 * m + 4 * fq + e) * 68 + 16 * nn + fr];
                    bb[e] = sqrtf(fmaxf(1.f - a[e] * a[e], 0.f)) * (ig * xcv);
                }
                const int trow = rowbase + 32 * sub + 16 * m + 4 * fq;
                if (!samp) {
                    const float Pl = (a[0] * a[1]) * (a[2] * a[3]);
                    float Hl = bb[0]; Hl = a[1] * Hl + bb[1]; Hl = a[2] * Hl + bb[2]; Hl = a[3] * Hl + bb[3];
                    float cin = hcn, ain = acn;
#pragma unroll
                    for (int k = 0; k < 4; ++k) {
                        const float hend = Pl * cin + Hl, aend = ain * Pl;
                        const float nh = __shfl(hend, fr + 16 * k), na = __shfl(aend, fr + 16 * k);
                        if (k < 3) { if (fq == k + 1) { cin = nh; ain = na; } } else { hcn = nh; acn = na; }
                    }
                    float hv = cin, av = ain;
#pragma unroll
                    for (int e = 0; e < 4; ++e) { hv = a[e] * hv + bb[e]; av *= a[e]; HL[(size_t)(trow + e) * 512 + ch] = hv; AC[(size_t)(trow + e) * 512 + ch] = av; }
                } else {
                    const int s = (u - 256) * 16 + 8 * sub + 4 * m + fq;
                    float hv = sth[(size_t)s * 512 + ch];
#pragma unroll
                    for (int e = 0; e < 4; ++e) { hv = a[e] * hv + bb[e]; HL[(size_t)(trow + e) * 512 + ch] = hv; AC[(size_t)(trow + e) * 512 + ch] = 0.f; }
                    F.out[O_HS + (size_t)s * 512 + ch] = hv;
                }
            }
#pragma unroll
            for (int q = 0; q < 4; ++q) if (q == nn) { hc[q] = hcn; Ac[q] = acn; }
        }
        LDS_WAIT();
    }
    if (!samp && fq == 0) { float* sm = WSP(float, WS_SUMM) + (size_t)u * 1024;
#pragma unroll
        for (int nn = 0; nn < 4; ++nn) { const int ch = 64 * b + 16 * nn + fr; sm[ch] = hc[nn]; sm[512 + ch] = Ac[nn]; } }
}

__device__ __forceinline__ void compress_unit(Frame& F, int cu) {
    const int tid = F.tid, lane = F.lane, w = F.wave, wr = w >> 2, wc = w & 3, fr = lane & 15, fq = lane >> 4;
    const bool samp = cu < 512;
    const int q = samp ? cu : cu - 512, sq = q >> 2, h = (q >> 1) & 1, slot = q & 1;
    const int seqi = samp ? 8 + sq : sq;
    const int li = tid >> 2, qd = tid & 3;
    const float* abase;
    if (samp) { const int page = F.page_table[sq * 16 + (li >> 3)]; abase = F.in[2] + ((size_t)page * 128 + (size_t)((16 * li) & 127)) * 512 + slot * 128 + h * 64 + 16 * qd; }
    else abase = F.out + O_KV + ((size_t)sq * SEQ + 16 * li) * 512 + slot * 128 + h * 64 + 16 * qd;
    const bf16* bbase = WSP(bf16, WS_WC1) + (size_t)slot * 128 * 1024 + (size_t)li * 1024 + 16 * qd;
    LAS unsigned char* lds = F.lds;
    const int wo0 = li * 128 + (((2 * qd) ^ (li & 7)) << 4), wo1 = li * 128 + (((2 * qd + 1) ^ (li & 7)) << 4);
    f32x4 ar[4]; v4u br[2];
    f32x4 acc[4][2];
#pragma unroll
    for (int m = 0; m < 4; ++m)
#pragma unroll
        for (int n = 0; n < 2; ++n) acc[m][n] = (f32x4){0.f, 0.f, 0.f, 0.f};
#define CMP_LOAD(j) do { _Pragma("unroll") for (int i_ = 0; i_ < 4; ++i_) ar[i_] = *(const f32x4*)(abase + (size_t)(j) * 512 + 4 * i_); \
        br[0] = *(const v4u*)(bbase + (j) * 64); br[1] = *(const v4u*)(bbase + (j) * 64 + 8); } while (0)
#define CMP_WRITE(st) do { LAS unsigned char* A_ = lds + (st) * 32768; LAS unsigned char* B_ = A_ + 16384; \
        v4u p0_, p1_; p0_.x = pk2(ar[0][0], ar[0][1]); p0_.y = pk2(ar[0][2], ar[0][3]); p0_.z = pk2(ar[1][0], ar[1][1]); p0_.w = pk2(ar[1][2], ar[1][3]); \
        p1_.x = pk2(ar[2][0], ar[2][1]); p1_.y = pk2(ar[2][2], ar[2][3]); p1_.z = pk2(ar[3][0], ar[3][1]); p1_.w = pk2(ar[3][2], ar[3][3]); \
        *(LAS v4u*)(A_ + wo0) = p0_; *(LAS v4u*)(A_ + wo1) = p1_; *(LAS v4u*)(B_ + wo0) = br[0]; *(LAS v4u*)(B_ + wo1) = br[1]; } while (0)
    CMP_LOAD(0); CMP_WRITE(0);
    __syncthreads();
    for (int j = 0; j < 16; ++j) {
        if (j + 1 < 16) CMP_LOAD(j + 1);
        const LAS unsigned char* A_ = lds + (j & 1) * 32768; const LAS unsigned char* B_ = A_ + 16384;
        bf16x8 af[4][2], bf[2][2];
#pragma unroll
        for (int m = 0; m < 4; ++m)
#pragma unroll
            for (int k = 0; k < 2; ++k) { const int row = 64 * wr + 16 * m + fr; af[m][k] = *(const LAS bf16x8*)(A_ + row * 128 + (((4 * k + fq) ^ (row & 7)) << 4)); }
#pragma unroll
        for (int n = 0; n < 2; ++n)
#pragma unroll
            for (int k = 0; k < 2; ++k) { const int row = 32 * wc + 16 * n + fr; bf[n][k] = *(const LAS bf16x8*)(B_ + row * 128 + (((4 * k + fq) ^ (row & 7)) << 4)); }
#pragma unroll
        for (int m = 0; m < 4; ++m)
#pragma unroll
            for (int n = 0; n < 2; ++n)
#pragma unroll
                for (int k = 0; k < 2; ++k) acc[m][n] = __builtin_amdgcn_mfma_f32_16x16x32_bf16(bf[n][k], af[m][k], acc[m][n], 0, 0, 0);
        if (j + 1 < 16) CMP_WRITE((j + 1) & 1);
        __syncthreads();
    }
#undef CMP_LOAD
#undef CMP_WRITE
    LAS float* Ys = (LAS float*)lds;
#pragma unroll
    for (int m = 0; m < 4; ++m)
#pragma unroll
        for (int n = 0; n < 2; ++n) *(LAS f32x4*)(Ys + (64 * wr + 16 * m + fr) * 132 + 32 * wc + 16 * n + 4 * fq) = acc[m][n];
    __syncthreads();
    LAS unsigned char* Hs = lds + 73728;
    { const int c = tid >> 2, e0 = (tid & 3) * 16; const float* b1 = (const float*)(F.ws + WS_CTL + CTL_B1) + slot * 64;
      float hv[16];
#pragma unroll
      for (int i = 0; i < 16; ++i) { float v = 0.f; if (c < 127) v = pg8::gelu_tanh(Ys[c * 132 + e0 + i] + Ys[(c + 1) * 132 + 64 + e0 + i] + b1[e0 + i]); hv[i] = v; }
      v4u p0, p1; p0.x = pk2(hv[0], hv[1]); p0.y = pk2(hv[2], hv[3]); p0.z = pk2(hv[4], hv[5]); p0.w = pk2(hv[6], hv[7]);
      p1.x = pk2(hv[8], hv[9]); p1.y = pk2(hv[10], hv[11]); p1.z = pk2(hv[12], hv[13]); p1.w = pk2(hv[14], hv[15]);
      const int c8 = (tid & 3) * 2;
      *(LAS v4u*)(Hs + c * 128 + ((c8 ^ (c & 7)) << 4)) = p0; *(LAS v4u*)(Hs + c * 128 + (((c8 + 1) ^ (c & 7)) << 4)) = p1; }
    __syncthreads();
    { const bf16* w2 = WSP(bf16, WS_WC2) + (size_t)slot * 4096;
      f32x4 a2[4];
#pragma unroll
      for (int n = 0; n < 4; ++n) a2[n] = (f32x4){0.f, 0.f, 0.f, 0.f};
      const int row = 16 * w + fr;
#pragma unroll
      for (int k = 0; k < 2; ++k) { const bf16x8 hf = *(const LAS bf16x8*)(Hs + row * 128 + (((4 * k + fq) ^ (row & 7)) << 4));
#pragma unroll
          for (int n = 0; n < 4; ++n) { const bf16x8 wv = *(const bf16x8*)(w2 + (16 * n + fr) * 64 + 32 * k + 8 * fq); a2[n] = __builtin_amdgcn_mfma_f32_16x16x32_bf16(wv, hf, a2[n], 0, 0, 0); } }
      bf16* dst = WSP(bf16, slot ? WS_VCC : WS_KCC) + ((size_t)seqi * 128 + row) * 128 + h * 64;
#pragma unroll
      for (int n = 0; n < 4; ++n) { v2u o; o.x = pk2(a2[n][0], a2[n][1]); o.y = pk2(a2[n][2], a2[n][3]); *(v2u*)(dst + 16 * n + 4 * fq) = o; } }
    __syncthreads();
}

constexpr float C2S = 0.125f * 1.4426950408889634f;
constexpr float NEGB = -1e30f;
constexpr int A_OA = 65536, A_IMP = 98304, A_SEL = 107520, A_GT = 108032, A_WSF = 111104;
__device__ __forceinline__ int crow(int r, int hi) { return (r & 3) + 8 * (r >> 2) + 4 * hi; }
__device__ __forceinline__ float ex2(float x) { return __builtin_amdgcn_exp2f(x); }

__device__ __forceinline__ void qk_tile(f32x16& p0, f32x16& p1, const LAS unsigned char* Kt, const bf16x8 (&qf)[4], int r32, int hi) {
#pragma unroll
    for (int r = 0; r < 16; ++r) { p0[r] = 0.f; p1[r] = 0.f; }
#pragma unroll
    for (int d0 = 0; d0 < 4; ++d0) {
        const int off = r32 * 128 + (((2 * d0 + hi) ^ (r32 & 7)) << 4);
        const bf16x8 ka = *(const LAS bf16x8*)(Kt + off), kb = *(const LAS bf16x8*)(Kt + off + 4096);
        p0 = __builtin_amdgcn_mfma_f32_32x32x16_bf16(ka, qf[d0], p0, 0, 0, 0);
        p1 = __builtin_amdgcn_mfma_f32_32x32x16_bf16(kb, qf[d0], p1, 0, 0, 0);
    }
}
__device__ __forceinline__ void pv_tile(f32x16 (&o)[2], const LAS unsigned char* Vt, const bf16x8 (&pa)[4], int lane) {
    const int g = lane >> 4, i = lane & 15, q = i >> 2, p = i & 3, hg = g >> 1;
#pragma unroll
    for (int d0 = 0; d0 < 2; ++d0)
#pragma unroll
        for (int ks = 0; ks < 4; ++ks) {
            const int row0 = 16 * ks + 4 * hg + q, chunk = 4 * d0 + 2 * (g & 1) + (p >> 1);
            const LAS unsigned char* a0 = Vt + row0 * 128 + ((chunk ^ (row0 & 7)) << 4) + 8 * (p & 1);
            const s16x4 lo = __builtin_bit_cast(s16x4, __builtin_amdgcn_ds_read_tr16_b64_v4i16((LAS s16x4*)a0));
            const s16x4 hi4 = __builtin_bit_cast(s16x4, __builtin_amdgcn_ds_read_tr16_b64_v4i16((LAS s16x4*)(a0 + 1024)));
            const bf16x8 bv = (bf16x8){lo[0], lo[1], lo[2], lo[3], hi4[0], hi4[1], hi4[2], hi4[3]};
            o[d0] = __builtin_amdgcn_mfma_f32_32x32x16_bf16(pa[ks], bv, o[d0], 0, 0, 0);
        }
}
__device__ __forceinline__ void pack_p(bf16x8 (&pa)[4], const f32x16& p0, const f32x16& p1) {
#pragma unroll
    for (int ks = 0; ks < 2; ++ks) {
        v4u a, b;
        a.x = pk2(p0[8 * ks + 0], p0[8 * ks + 1]); a.y = pk2(p0[8 * ks + 2], p0[8 * ks + 3]); a.z = pk2(p0[8 * ks + 4], p0[8 * ks + 5]); a.w = pk2(p0[8 * ks + 6], p0[8 * ks + 7]);
        b.x = pk2(p1[8 * ks + 0], p1[8 * ks + 1]); b.y = pk2(p1[8 * ks + 2], p1[8 * ks + 3]); b.z = pk2(p1[8 * ks + 4], p1[8 * ks + 5]); b.w = pk2(p1[8 * ks + 6], p1[8 * ks + 7]);
        pa[ks] = __builtin_bit_cast(bf16x8, a); pa[2 + ks] = __builtin_bit_cast(bf16x8, b);
    }
}
__device__ __forceinline__ float mask_scale(f32x16& p0, f32x16& p1, int kbase, int klo, int khi, bool rflag, int hi) {
    float mx = NEGB;
#pragma unroll
    for (int r = 0; r < 16; ++r) { const int kv = kbase + crow(r, hi);
        const bool v0 = rflag && kv >= klo && kv <= khi, v1 = rflag && (kv + 32) >= klo && (kv + 32) <= khi;
        p0[r] = v0 ? p0[r] * C2S : NEGB; p1[r] = v1 ? p1[r] * C2S : NEGB;
        mx = fmaxf(mx, fmaxf(p0[r], p1[r])); }
    return fmaxf(mx, __shfl_xor(mx, 32));
}

template <bool SAMP>
__device__ __forceinline__ void attn_unit(Frame& F, int sq, int qb) {
    int tid = F.tid; asm volatile("" : "+v"(tid));
    const int lane = tid & 63, w = F.wave, r32 = lane & 31, hi = lane >> 5, h = w >> 2, wg = w & 3;
    const int q0 = SAMP ? 0 : qb * 32;
    const int rowbase = SAMP ? MP + 4 * sq : sq * SEQ + q0;
    const int tok = SAMP ? (r32 & 3) : r32;
    const int myhead = h * 4 + (SAMP ? ((r32 >> 2) & 3) : wg);
    const int qpos = SAMP ? SEQ + tok : q0 + r32;
    const int cur = SAMP ? 32 : (q0 >> 6);
    const int seqc = SAMP ? 8 + sq : sq;
    constexpr int NT = SAMP ? 4 : 32;
    LAS unsigned char* lds = F.lds;
    LAS float* IMP = (LAS float*)(lds + A_IMP);
    LAS unsigned long long* SEL = (LAS unsigned long long*)(lds + A_SEL);
    LAS float* GT = (LAS float*)(lds + A_GT);
    LAS float* wsf = (LAS float*)(lds + A_WSF) + w * 64;
    LAS unsigned short* OA = (LAS unsigned short*)(lds + A_OA);
    const bf16 *KS = WSP(bf16, WS_KS), *VS = WSP(bf16, WS_VS), *KW = WSP(bf16, WS_KW), *VW = WSP(bf16, WS_VW), *KCC = WSP(bf16, WS_KCC), *VCC = WSP(bf16, WS_VCC);
    const int lrow = tid >> 3, lch = tid & 7;
    const int lwo = lrow * 128 + ((lch ^ (lrow & 7)) << 4);
    v4u rb[4]; f32x4 rf[8]; bool isf32 = false; unsigned ldmask = 0xF;
#define LD_ISSUE(kind, j, hmask) do { isf32 = false; ldmask = 0; \
        _Pragma("unroll") for (int mi = 0; mi < 4; ++mi) { const int hm_ = mi >> 1, isV_ = mi & 1; \
            if (!(((hmask) >> hm_) & 1)) continue; ldmask |= 1u << mi; \
            if ((kind) == 0) { rb[mi] = *(const v4u*)((isV_ ? VCC : KCC) + ((size_t)(seqc * 128 + 64 * (j) + lrow)) * 128 + hm_ * 64 + lch * 8); } \
            else if (!SAMP) { rb[mi] = *(const v4u*)(((kind) == 1 ? (isV_ ? VS : KS) : (isV_ ? VW : KW)) + ((size_t)(sq * SEQ + 64 * (j) + lrow)) * 128 + hm_ * 64 + lch * 8); } \
            else if ((kind) == 1) { \
                if ((j) < 32) { isf32 = true; const float* s_ = F.in[2] + ((size_t)F.page_table[sq * 16 + ((j) >> 1)] * 128 + ((j) & 1) * 64 + lrow) * 512 + (2 + isV_) * 128 + hm_ * 64 + lch * 8; \
                    rf[2 * mi] = *(const f32x4*)s_; rf[2 * mi + 1] = *(const f32x4*)(s_ + 4); } \
                else { rb[mi] = (v4u){0u, 0u, 0u, 0u}; if (lrow < 4) rb[mi] = *(const v4u*)((isV_ ? VS : KS) + ((size_t)(MP + 4 * sq + lrow)) * 128 + hm_ * 64 + lch * 8); } } \
            else { \
                if ((j) < 8) { isf32 = true; const float* s_ = F.in[3] + ((size_t)(sq * 512 + 64 * (j) + lrow)) * 256 + isV_ * 128 + hm_ * 64 + lch * 8; \
                    rf[2 * mi] = *(const f32x4*)s_; rf[2 * mi + 1] = *(const f32x4*)(s_ + 4); } \
                else { rb[mi] = (v4u){0u, 0u, 0u, 0u}; if (lrow < 4) rb[mi] = *(const v4u*)((isV_ ? VW : KW) + ((size_t)(MP + 4 * sq + lrow)) * 128 + hm_ * 64 + lch * 8); } } \
        } } while (0)
#define LD_WRITE(st) do { _Pragma("unroll") for (int mi = 0; mi < 4; ++mi) { if (!((ldmask >> mi) & 1)) continue; v4u v_ = rb[mi]; \
            if (SAMP && isf32) { v_.x = pk2(rf[2 * mi][0], rf[2 * mi][1]); v_.y = pk2(rf[2 * mi][2], rf[2 * mi][3]); v_.z = pk2(rf[2 * mi + 1][0], rf[2 * mi + 1][1]); v_.w = pk2(rf[2 * mi + 1][2], rf[2 * mi + 1][3]); } \
            *(LAS v4u*)(lds + (st) * 32768 + mi * 8192 + lwo) = v_; } } while (0)

    if (SAMP) { const f32x4* src = (const f32x4*)(F.in[3] + ((size_t)sq * 512 + 4) * 256); f32x4* dst = (f32x4*)(F.out + O_WINS + (size_t)sq * 512 * 256);
        for (int i = tid; i < 508 * 64; i += 512) dst[i] = src[i]; }
    for (int i = tid; i < 2 * 32 * 36; i += 512) IMP[i] = 0.f;
    for (int i = tid; i < NT * 24; i += 512) GT[i] = WSP(float, WS_GATES)[(size_t)rowbase * 24 + i];
    LD_ISSUE(0, 0, 3); LD_WRITE(0);
    LD_ISSUE(0, 1, 3); LD_WRITE(1);
    __syncthreads();
    bf16x8 qf[4];
    f32x16 o[2]; float m_run = NEGB, l_run = 0.f;
#pragma unroll
    for (int r = 0; r < 16; ++r) { o[0][r] = 0.f; o[1][r] = 0.f; }
    const size_t qoff = (size_t)(rowbase + tok) * 512 + myhead * 64 + 8 * hi;
#define ATT_TILE(Kt_, Vt_, kbase_, klo_, khi_, rflag_) do { \
        f32x16 p0, p1; \
        qk_tile(p0, p1, (Kt_), qf, r32, hi); \
        const float mx_ = mask_scale(p0, p1, (kbase_), (klo_), (khi_), (rflag_), hi); \
        const float mnew_ = fmaxf(m_run, mx_); \
        const float alpha_ = ex2(m_run - mnew_); \
        const float msub_ = fmaxf(mnew_, -1e20f); \
        float ls_ = 0.f; \
        _Pragma("unroll") for (int r = 0; r < 16; ++r) { p0[r] = ex2(p0[r] - msub_); p1[r] = ex2(p1[r] - msub_); ls_ += p0[r] + p1[r]; } \
        l_run = l_run * alpha_ + ls_; m_run = mnew_; \
        if (!__all(alpha_ == 1.0f)) { \
            if (hi == 0) wsf[r32] = alpha_; \
            LDS_WAIT(); \
            _Pragma("unroll") for (int r = 0; r < 16; ++r) { const float a_ = wsf[crow(r, hi)]; o[0][r] *= a_; o[1][r] *= a_; } \
            LDS_WAIT(); \
        } \
        bf16x8 pa_[4]; \
        pack_p(pa_, p0, p1); \
        pv_tile(o, (Vt_), pa_, lane); } while (0)
#define FINALIZE(br) do { const float l_ = l_run + __shfl_xor(l_run, 32); const float inv_ = l_ > 0.f ? 1.f / l_ : 0.f; \
        if (hi == 0) wsf[r32] = inv_; LDS_WAIT(); \
        if (!SAMP || wg == 0) { \
        _Pragma("unroll") for (int r = 0; r < 16; ++r) { const int q = crow(r, hi); \
            if (!SAMP || q < 16) { const int tk = SAMP ? (q & 3) : q, hd = h * 4 + (SAMP ? (q >> 2) : wg); \
            const float f = wsf[q] * GT[tk * 24 + (br) * 8 + hd]; \
            _Pragma("unroll") for (int d0 = 0; d0 < 2; ++d0) { LAS unsigned short* p_ = OA + tk * 512 + hd * 64 + 32 * d0 + r32; \
                float v_ = o[d0][r] * f; if ((br) != 0) v_ += bf2f(*p_); *p_ = (unsigned short)(pk2(v_, 0.f) & 0xffffu); } } } } \
        LDS_WAIT(); } while (0)
    {
        const bf16* Qn = WSP(bf16, WS_QN);
#pragma unroll
        for (int d0 = 0; d0 < 4; ++d0) qf[d0] = *(const bf16x8*)(Qn + qoff + 16 * d0);
        const LAS unsigned char* K0 = lds + (2 * h) * 8192; const LAS unsigned char* V0 = K0 + 8192;
        const int khi = SAMP ? 126 : (qpos >= 31 ? ((qpos - 31) >> 4) : -1);
        ATT_TILE(K0, V0, 0, 0, khi, true);
        ATT_TILE(K0 + 32768, V0 + 32768, 64, 0, khi, true);
        const float l = l_run + __shfl_xor(l_run, 32);
        const float inv = l > 0.f ? 1.f / l : 0.f;
        const float msub = fmaxf(m_run, -1e20f);
#pragma unroll
        for (int tl = 0; tl < 2; ++tl) {
            f32x16 p0, p1;
            qk_tile(p0, p1, K0 + tl * 32768, qf, r32, hi);
            (void)mask_scale(p0, p1, 64 * tl, 0, khi, true, hi);
            if (!SAMP || (wg == 0 && r32 < 16)) {
                LAS float* ip = IMP + (h * 32 + tok) * 36;
#pragma unroll
                for (int half = 0; half < 2; ++half) {
#pragma unroll
                    for (int rq = 0; rq < 4; ++rq) {
                        const f32x16& X = half == 0 ? p0 : p1;
                        const float e0 = ex2(X[4 * rq] - msub), e1 = ex2(X[4 * rq + 1] - msub), e2 = ex2(X[4 * rq + 2] - msub), e3 = ex2(X[4 * rq + 3] - msub);
                        const float last = e3 * inv;
                        const float G = ((e0 + e1) + (e2 + e3)) * inv;
                        const int jj = 8 * (2 * tl + half) + 2 * rq + hi;
                        (void)__hip_atomic_fetch_add(ip + jj, G, __ATOMIC_RELAXED, __HIP_MEMORY_SCOPE_WORKGROUP); (void)__hip_atomic_fetch_add(ip + jj + 1, last, __ATOMIC_RELAXED, __HIP_MEMORY_SCOPE_WORKGROUP);
                    }
                }
            }
        }
        FINALIZE(0);
    }
    __syncthreads();
    {
        const int nit = SAMP ? 1 : 4;
        for (int it = 0; it < nit; ++it) {
            const int tk = SAMP ? (hi + 2 * (w & 1)) : (wg * 8 + 2 * it + hi);
            const bool act = SAMP ? (wg < 2) : true;
            const int j = r32;
            const LAS float* ip = IMP + (h * 32 + tk) * 36;
            const float my = ip[j];
            const bool valid = j <= cur, forced = (j == 0) || (j == cur) || (j == cur - 1);
            const int nforced = cur == 0 ? 1 : (cur == 1 ? 2 : 3);
            const int quota = 16 - nforced;
            int cnt = 0;
            for (int i = 0; i < 32; ++i) { const float v = ip[i];
                const bool cand = (i <= cur) && !((i == 0) || (i == cur) || (i == cur - 1));
                cnt += (cand && (v > my || (v == my && i < j))) ? 1 : 0; }
            const bool selb = valid && (forced || cnt < quota);
            const unsigned long long bal = __ballot(selb);
            unsigned long long msk = hi ? (bal >> 32) : (bal & 0xffffffffull);
            if (SAMP) msk |= 1ull << 32;
            if (act && r32 == 0) SEL[h * 32 + tk] = msk;
        }
    }
    __syncthreads();
    const unsigned long long mysel = SEL[h * 32 + tok];
    unsigned long long U0 = 0ull, U1 = 0ull;
    if (SAMP) { for (int i = 0; i < NT; ++i) { U0 |= SEL[i]; U1 |= SEL[32 + i]; } }
    const unsigned long long Uall = SAMP ? (U0 | U1) : ((2ull << cur) - 1ull), Uh = SAMP ? (h ? U1 : U0) : ~0ull;
    const int wlo = SAMP ? 0 : ((q0 - 511) > 0 ? ((q0 - 511) >> 6) : 0), whi = SAMP ? 8 : ((q0 + 31) >> 6);
    {
        const bf16* Qr = WSP(bf16, WS_QR);
#pragma unroll
        for (int d0 = 0; d0 < 4; ++d0) qf[d0] = *(const bf16x8*)(Qr + qoff + 16 * d0);
    }
    int skind = 1; m_run = NEGB; l_run = 0.f;
#pragma unroll
    for (int r = 0; r < 16; ++r) { o[0][r] = 0.f; o[1][r] = 0.f; }
#define HM_OF(code) ((code) < 64 ? (SAMP ? (unsigned)(((U0 >> (code)) & 1ull) | (((U1 >> (code)) & 1ull) << 1)) : 3u) : 3u)
    int code = 0, st = 0;
    { const unsigned hm = HM_OF(0); LD_ISSUE(1, 0, hm); LD_WRITE(0); }
    __syncthreads();
    for (;;) {
        int nxt;
        if (code < 64) { const unsigned long long mm = (code >= 63) ? 0ull : (Uall >> (code + 1)); nxt = mm ? code + 1 + __builtin_ctzll(mm) : 64 + wlo; if (nxt < 64 && nxt > cur) nxt = 64 + wlo; }
        else nxt = (code + 1 - 64 <= whi) ? code + 1 : -1;
        if (nxt >= 0) { const unsigned hm = HM_OF(nxt); if (nxt < 64) { LD_ISSUE(1, nxt, hm); } else { LD_ISSUE(2, nxt - 64, hm); } }
        {
            const int kind = code < 64 ? 1 : 2, j = code < 64 ? code : code - 64;
            if (kind != skind) { FINALIZE(1); m_run = NEGB; l_run = 0.f;
#pragma unroll
                for (int r = 0; r < 16; ++r) { o[0][r] = 0.f; o[1][r] = 0.f; }
                skind = kind; }
            const bool need = kind == 2 || ((Uh >> j) & 1ull);
            if (need) {
                const LAS unsigned char* Kt = lds + st * 32768 + (2 * h) * 8192; const LAS unsigned char* Vt = Kt + 8192;
                int kbase, klo, khi; bool rflag;
                if (kind == 1) { kbase = (SAMP && j == 32) ? SEQ : 64 * j; klo = -(1 << 30); khi = qpos; rflag = (mysel >> j) & 1ull; }
                else { kbase = SAMP ? (j < 8 ? 1536 + 64 * j : SEQ) : 64 * j; klo = qpos - 511; khi = qpos; rflag = true; }
                ATT_TILE(Kt, Vt, kbase, klo, khi, rflag);
            }
        }
        if (nxt >= 0) LD_WRITE(st ^ 1);
        __syncthreads();
        if (nxt < 0) break;
        code = nxt; st ^= 1;
    }
    FINALIZE(2);
#undef HM_OF
#undef FINALIZE
#undef ATT_TILE
#undef LD_ISSUE
#undef LD_WRITE
    __syncthreads();
    {
        bf16* MIX = WSP(bf16, WS_MIXED);
        const int ntk = SAMP ? (w < 4 ? 1 : 0) : 4;
        const f32x4 ga0 = *(const f32x4*)(F.in[14] + lane * 8), ga1 = *(const f32x4*)(F.in[14] + lane * 8 + 4);
        const f32x4 gr0 = *(const f32x4*)(F.in[15] + lane * 8), gr1 = *(const f32x4*)(F.in[15] + lane * 8 + 4);
        f32x4 c0 = (f32x4){0.f, 0.f, 0.f, 0.f}, c1 = c0;
        if (!SAMP) { const int cch = q0 >> 6; const float* sm = WSP(float, WS_SUMM) + (size_t)sq * 32 * 1024 + lane * 8;
            for (int cc = 0; cc < cch; ++cc) { const f32x4 h0 = *(const f32x4*)(sm + cc * 1024), h1 = *(const f32x4*)(sm + cc * 1024 + 4), a0 = *(const f32x4*)(sm + cc * 1024 + 512), a1 = *(const f32x4*)(sm + cc * 1024 + 516);
                c0 = a0 * c0 + h0; c1 = a1 * c1 + h1; } }
        for (int it = 0; it < ntk; ++it) {
            const int tk = SAMP ? w : 4 * w + it; const size_t row = (size_t)rowbase + tk;
            { const v4u pk = *(const LAS v4u*)(lds + A_OA + tk * 1024 + lane * 16);
              float v[8] = {bflo(pk.x), bfhi(pk.x), bflo(pk.y), bfhi(pk.y), bflo(pk.z), bfhi(pk.z), bflo(pk.w), bfhi(pk.w)};
              float ss = 0.f;
#pragma unroll
              for (int i = 0; i < 8; ++i) ss += v[i] * v[i];
              const float rs = rsqrtf(wave_sum(ss) * (1.f / 512.f) + EPSN);
              v4u o; o.x = pk2(v[0] * rs * ga0[0], v[1] * rs * ga0[1]); o.y = pk2(v[2] * rs * ga0[2], v[3] * rs * ga0[3]); o.z = pk2(v[4] * rs * ga1[0], v[5] * rs * ga1[1]); o.w = pk2(v[6] * rs * ga1[2], v[7] * rs * ga1[3]);
              *(v4u*)(MIX + row * 1024 + lane * 8) = o; }
            { const float* hl = WSP(float, WS_HL) + row * 512 + lane * 8; const float* ac = WSP(float, WS_AC) + row * 512 + lane * 8;
              const f32x4 h0 = *(const f32x4*)hl + *(const f32x4*)ac * c0, h1 = *(const f32x4*)(hl + 4) + *(const f32x4*)(ac + 4) * c1;
              if (!SAMP && q0 + tk == SEQ - 1) { float* hp = F.out + O_HP + (size_t)sq * 512 + lane * 8; *(f32x4*)hp = h0; *(f32x4*)(hp + 4) = h1; }
              const v4u pk = *(const v4u*)(WSP(bf16, WS_GRG) + row * 512 + lane * 8);
              float v[8] = {bflo(pk.x) * h0[0], bfhi(pk.x) * h0[1], bflo(pk.y) * h0[2], bfhi(pk.y) * h0[3], bflo(pk.z) * h1[0], bfhi(pk.z) * h1[1], bflo(pk.w) * h1[2], bfhi(pk.w) * h1[3]};
              float ss = 0.f;
#pragma unroll
              for (int i = 0; i < 8; ++i) ss += v[i] * v[i];
              const float rs = rsqrtf(wave_sum(ss) * (1.f / 512.f) + EPSN);
              v4u o; o.x = pk2(v[0] * rs * gr0[0], v[1] * rs * gr0[1]); o.y = pk2(v[2] * rs * gr0[2], v[3] * rs * gr0[3]); o.z = pk2(v[4] * rs * gr1[0], v[5] * rs * gr1[1]); o.w = pk2(v[6] * rs * gr1[2], v[7] * rs * gr1[3]);
              *(v4u*)(MIX + row * 1024 + 512 + lane * 8) = o; }
        }
    }
    __syncthreads();
}

#ifndef MK_N_LAUNCHES
#define MK_N_LAUNCHES 1
#endif
constexpr int N_PHASES = 8;
struct Args { const float* in[29]; float* out; unsigned char* ws; int ph_lo, ph_hi; };
__global__ void __launch_bounds__(NWAVES * 64, 2) nsa_fwd(Args args) {
    extern __shared__ __attribute__((aligned(16))) unsigned char lds[];
    Frame F;
    F.lds = (LAS unsigned char*)lds;
    F.tid = threadIdx.x; F.lane = F.tid & 63; F.wave = __builtin_amdgcn_readfirstlane(F.tid >> 6);
    F.G = gridDim.x; { const int bx = blockIdx.x; F.vcu = (F.G % 8 == 0) ? (bx % 8) * (F.G / 8) + bx / 8 : bx; }
    F.in = args.in;
    F.page_table = (const int*)args.in[6];
    F.out = args.out; F.ws = args.ws; F.ctl = (gu32*)(args.ws + WS_CTL);
    volatile LAS unsigned* MISC = (volatile LAS unsigned*)(F.lds + MISC_OFF);
    for (int u = F.tid; u < (LDS_BYTES - RING_BYTES) / 4; u += NWAVES * 64) ((LAS unsigned*)(F.lds + RING_BYTES))[u] = 0u;
    __syncthreads();
    XcdBarrier bar; bar.bar = (unsigned*)(F.ctl + CW_BAR); bar.x = 0; bar.st = nullptr;
    if (MK_N_LAUNCHES == 1) bar = xcd_barrier_post((unsigned*)(F.ctl + CW_BAR), MISC + 8);
    const int lo = args.ph_lo, hi = args.ph_hi;
#ifndef PHASE_MASK
#define PHASE_MASK 0xFF
#endif
#define IN(k) (((PHASE_MASK >> (k)) & 1) && lo <= (k) && (k) < hi)
#define SEAM(k) do { if (IN(k) && IN((k) + 1)) xcd_barrier(bar); FRESH(); } while (0)
#define FRESH() do { int t_ = threadIdx.x; asm volatile("" : "+v"(t_)); F.tid = t_; F.lane = t_ & 63; F.wave = __builtin_amdgcn_readfirstlane(t_ >> 6); } while (0)
    if (IN(0)) { p0_prologue(F); }
    SEAM(0);
    if (IN(1)) {
        pg8::Gemm g{WSP(bf16, WS_XN), WSP(bf16, WS_WIN), MT, NIN, DM}; pg8::StaticOrder S; S.init(MT, NIN, F.G, (int)blockIdx.x);
        pg8::EpiProj E{WSP(bf16, WS_QN), WSP(bf16, WS_QR), WSP(bf16, WS_KS), WSP(bf16, WS_VS), WSP(bf16, WS_KW), WSP(bf16, WS_VW), WSP(bf16, WS_GRG), WSP(float, WS_GATES), WSP(float, WS_RX), F.out, WSP(float, WS_ROT)};
        pg8::gemm_phase<pg8::EpiProj, pg8::StaticOrder, true, true>(F.lds, g, S, E);
    }
    SEAM(1);
    if (IN(2)) {
        for (;;) {
            if (F.tid == 0) MISC[0] = __hip_atomic_fetch_add((unsigned*)(F.ctl + CW_Q2), 1u, RLX_AGENT);
            __syncthreads();
            const int id = (int)MISC[0];
            __syncthreads();
            if (id >= 264 + 544) break;
            if (id < 264) { rnn_unit(F, id); __syncthreads(); } else compress_unit(F, id - 264);
        }
    }
    SEAM(2);
    if (IN(3)) {
        for (;;) {
            if (F.tid == 0) MISC[0] = __hip_atomic_fetch_add((unsigned*)(F.ctl + CW_Q3), 1u, RLX_AGENT);
            __syncthreads();
            const int id = (int)MISC[0];
            __syncthreads();
            if (id >= 128) break;
            attn_unit<true>(F, id, 0);
        }
        for (;;) {
            if (F.tid == 0) MISC[0] = __hip_atomic_fetch_add((unsigned*)(F.ctl + CW_Q3 + 64), 1u, RLX_AGENT);
            __syncthreads();
            const int k = (int)MISC[0];
            __syncthreads();
            if (k >= 512) break;
            attn_unit<false>(F, k & 7, 63 - (k >> 3));
        }
    }
    SEAM(3);
    if (IN(4)) {
        pg8::Gemm g{WSP(bf16, WS_MIXED), WSP(bf16, WS_WOUT), MT, DM, DM}; pg8::StaticOrder S; S.init(MT, DM, F.G, (int)blockIdx.x);
        pg8::EpiOut E{F.in[0], F.in[1], WSP(float, WS_X1), WSP(bf16, WS_XN), (float*)(F.ws + WS_CTL + CTL_SS1)};
        pg8::gemm_phase<pg8::EpiOut, pg8::StaticOrder, true, true>(F.lds, g, S, E);
    }
    SEAM(4);
    if (IN(5)) {
        pg8::Gemm g{WSP(bf16, WS_XN), WSP(bf16, WS_WUP), MT, FF, DM}; pg8::StaticOrder S; S.init(MT, FF, F.G, (int)blockIdx.x);
        pg8::EpiUp E{WSP(bf16, WS_H), (const float*)(F.ws + WS_CTL + CTL_SS1)};
        pg8::gemm_phase<pg8::EpiUp, pg8::StaticOrder, true, true>(F.lds, g, S, E);
    }
    SEAM(5);
    if (IN(6)) {
        pg8::Gemm g{WSP(bf16, WS_H), WSP(bf16, WS_WDN), MT, DM, FF}; pg8::StaticOrder S; S.init(MT, DM, F.G, (int)blockIdx.x);
        pg8::EpiDown E{WSP(float, WS_X1), F.out, (float*)(F.ws + WS_CTL + CTL_SS2)};
        pg8::gemm_phase<pg8::EpiDown, pg8::StaticOrder, true, true>(F.lds, g, S, E);
    }
    SEAM(6);
    if (IN(7)) p7_final(F);
#undef IN
#undef SEAM
#undef FRESH
}

extern "C" void kernel_launch(void* const* d_in, const int* in_sizes, int n_in, void* d_out, int out_size, void* d_ws, size_t ws_size, hipStream_t stream) {
    static int grid = 0;
    if (grid == 0) {
        if (n_in != 29 || out_size != 44056576 || ws_size < WS_END) { fprintf(stderr, "kernel_launch: unexpected sizes (n_in %d, out %d, ws %zu)\n", n_in, out_size, ws_size); grid = -1; return; }
        int dev = 0, cus = 0, per_cu = 0;
        if (hipGetDevice(&dev) != hipSuccess || hipDeviceGetAttribute(&cus, hipDeviceAttributeMultiprocessorCount, dev) != hipSuccess) { grid = -1; return; }
        if (hipFuncSetAttribute((const void*)nsa_fwd, hipFuncAttributeMaxDynamicSharedMemorySize, LDS_BYTES) != hipSuccess) { fprintf(stderr, "kernel_launch: hipFuncSetAttribute failed\n"); grid = -1; return; }
        if (hipOccupancyMaxActiveBlocksPerMultiprocessor(&per_cu, (const void*)nsa_fwd, NWAVES * 64, LDS_BYTES) != hipSuccess || per_cu < 1) fprintf(stderr, "kernel_launch: occupancy query reports %d\n", per_cu);
        (void)hipGetLastError();
        grid = cus;
    }
    if (grid < 0) return;
    if (hipMemsetAsync((char*)d_ws + WS_CTL, 0, CTL_ZERO_BYTES, stream) != hipSuccess) return;
    Args a{};
    for (int i = 0; i < 29; ++i) a.in[i] = (const float*)d_in[i];
    a.out = (float*)d_out; a.ws = (unsigned char*)d_ws;
#if MK_N_LAUNCHES == 1
    a.ph_lo = 0; a.ph_hi = N_PHASES;
    hipLaunchKernelGGL(nsa_fwd, dim3(grid), dim3(NWAVES * 64), LDS_BYTES, stream, a);
#else
    for (int p = 0; p < N_PHASES; ++p) { a.ph_lo = p; a.ph_hi = p + 1; hipLaunchKernelGGL(nsa_fwd, dim3(grid), dim3(NWAVES * 64), LDS_BYTES, stream, a); }
#endif
}
```

```cpp
#include <hip/hip_runtime.h>
#include <cstdio>
#include <cstdint>

constexpr int DM = 1024, NB = 8, SEQ = 2048, NS = 128, DT = 4;
constexpr int MP = NB * SEQ, MS = NS * DT, MT = MP + MS;
constexpr int NIN = 2560, FF = 4096;
constexpr float EPSN = 1e-6f;
constexpr size_t O_YP = 0, O_KV = 17301504, O_WINP = 25952256, O_WINS = 27000832, O_CONVP = 43778048, O_CONVS = 43790336, O_HP = 43986944, O_HS = 43991040;

namespace pg8 {
#define PG8_LAS __attribute__((address_space(3)))
typedef unsigned short bf16_t;
typedef short bf16x8 __attribute__((ext_vector_type(8)));
typedef float f32x4 __attribute__((ext_vector_type(4)));
typedef unsigned u32x4 __attribute__((ext_vector_type(4)));
constexpr int BM = 256, BK = 64, HALF = 128, HTB = HALF * BK * 2  , STAGE_BYTES = 8 * HTB, NXCD = 8, WGM = 8;

__host__ __device__ __forceinline__ int lds_byte(int r, int c) { const int st = (r >> 4) * 2 + (c >> 5), rr = r & 15, cc = c & 31, ob = rr * 64 + cc * 2; return st * 1024 + (ob ^ (((ob >> 9) & 1) << 5)); }
__host__ __device__ __forceinline__ void stage_rc(int b, int& R, int& C) { const int st = b / 1024, sb = b % 1024, swz = sb ^ (((sb >> 9) & 1) << 5); R = (st >> 1) * 16 + swz / 64; C = (st & 1) * 32 + (swz % 64) / 2; }
__host__ __device__ __forceinline__ int perm32(int rho) { const int n = rho >> 4, i = rho & 15; return 8 * (i >> 2) + 4 * n + (i & 3); }

struct Unit { int pm, pn; };
struct Gemm { const bf16_t* A; const bf16_t* Bt; int M, N, K; };

struct StaticOrder {
    int nM, nN, nwg, G, c;
    __host__ __device__ void init(int M, int N, int G_, int c_) { nM = M / BM; nN = N / BM; nwg = nM * nN; G = G_; c = c_; }
    __host__ __device__ bool next(int i, Unit& u) const {
        const long L = (long)i * G + c; if (L >= nwg) return false;
        int wgid = (int)L; { const int q = nwg / NXCD, r = nwg % NXCD, xcd = wgid % NXCD, off = wgid / NXCD; wgid = (xcd < r ? xcd * (q + 1) : r * (q + 1) + (xcd - r) * q) + off; }
        const int nig = WGM * nN, gid = wgid / nig, fm = gid * WGM, gsz = (nM - fm) < WGM ? (nM - fm) : WGM;
        u.pm = fm + ((wgid % nig) % gsz); u.pn = (wgid % nig) / gsz; return true;
    }
    __device__ __forceinline__ void a_ready(const Unit&) const {}
    __device__ __forceinline__ void done(const Unit&) const {}
};

__device__ __forceinline__ unsigned cvt_pk_bf16(float lo, float hi) { unsigned r; asm volatile("v_cvt_pk_bf16_f32 %0, %1, %2" : "=v"(r) : "v"(lo), "v"(hi)); return r; }
typedef unsigned u32x2 __attribute__((ext_vector_type(2)));
typedef float f32x2 __attribute__((ext_vector_type(2)));
__device__ __forceinline__ float gelu_tanh(float x) {
    const float y = 1.5957691216f * (x + 0.044715f * x * x * x);
    return x / (1.0f + __expf(-y));
}
__device__ __forceinline__ float sigmoidf_(float x) { return 1.0f / (1.0f + __expf(-x)); }
__device__ __forceinline__ u32x2 pack4(f32x4 v) { u32x2 w; w.x = cvt_pk_bf16(v[0], v[1]); w.y = cvt_pk_bf16(v[2], v[3]); return w; }

struct EpiProj {
    static constexpr bool PERM = false, AFTER_DRAIN = false;
    bf16_t *Qn, *Qr, *KS, *VS, *KW, *VW, *GRG; float *GATES, *RX, *out; const float* rot;
    __device__ __forceinline__ f32x4 rotate(f32x4 v, int pos, int fq) const {
        const float* tb = rot + pos * 16 + (fq & 1) * 4;
        const f32x4 cs = *(const f32x4*)tb, sn = *(const f32x4*)(tb + 8);
        f32x4 pr;
#pragma unroll
        for (int e = 0; e < 4; ++e) pr[e] = __shfl_xor(v[e], 32);
        const float sg = fq < 2 ? -1.f : 1.f;
        f32x4 w;
#pragma unroll
        for (int e = 0; e < 4; ++e) w[e] = v[e] * cs[e] + sg * pr[e] * sn[e];
        return w;
    }
    __device__ __forceinline__ void operator()(const f32x4 (&acc)[2][2][4][2], const Unit& u, int wr, int wc, int fr, int fq) const {
        asm volatile("" : "+v"(fr), "+v"(fq));
        const int pn = u.pn;
        const bool rotw = (wc & 1) == 0;
#pragma unroll
        for (int ai = 0; ai < 2; ++ai)
#pragma unroll
            for (int m = 0; m < 4; ++m) {
                const int row = u.pm * BM + ai * HALF + wr * 64 + m * 16 + fr;
                const bool samp = row >= MP;
                int t, pos, sq;
                if (!samp) { t = row & (SEQ - 1); pos = t; sq = row >> 11; } else { t = (row - MP) & 3; pos = SEQ + t; sq = (row - MP) >> 2; }
#pragma unroll
                for (int bj = 0; bj < 2; ++bj)
#pragma unroll
                    for (int n = 0; n < 2; ++n) {
                        const f32x4 v = acc[ai][bj][m][n];
                        const int cc = bj * HALF + wc * 32 + n * 16 + fq * 4;
                        if (pn < 2) {
                            const size_t o = (size_t)row * 512 + pn * 256 + cc;
                            *(u32x2*)(Qn + o) = pack4(v);
                            f32x4 w = v; if (n == 0 && rotw) w = rotate(v, pos, fq);
                            *(u32x2*)(Qr + o) = pack4(w);
                        } else if (pn == 2) {
                            *(f32x4*)(out + O_KV + (size_t)row * 512 + cc) = v;
                        } else if (pn == 3) {
                            f32x4 w = v; if (bj == 0 && n == 0 && rotw) w = rotate(v, pos, fq);
                            *(f32x4*)(out + O_KV + (size_t)row * 512 + 256 + cc) = w;
                            bf16_t* dst = (bj == 0 ? KS : VS) + (size_t)row * 128 + (cc & 127);
                            *(u32x2*)dst = pack4(w);
                        } else if (pn == 4) {
                            f32x4 w = v; if (bj == 0 && n == 0 && rotw) w = rotate(v, pos, fq);
                            bf16_t* dst = (bj == 0 ? KW : VW) + (size_t)row * 128 + (cc & 127);
                            *(u32x2*)dst = pack4(w);
                            if (!samp) { if (t >= SEQ - 512) *(f32x4*)(out + O_WINP + ((size_t)sq * 512 + (t - (SEQ - 512))) * 256 + cc) = w; }
                            else *(f32x4*)(out + O_WINS + ((size_t)sq * 512 + 508 + t) * 256 + cc) = w;
                        } else if (pn < 7) {
                            f32x4 g;
#pragma unroll
                            for (int e = 0; e < 4; ++e) g[e] = gelu_tanh(v[e]);
                            *(u32x2*)(GRG + (size_t)row * 512 + (pn - 5) * 256 + cc) = pack4(g);
                        } else if (pn < 9) {
                            const int c2 = (pn - 7) * 256 + cc;
                            *(f32x4*)(RX + (size_t)row * 512 + c2) = v;
                            if (!samp) { if (t >= SEQ - 3) *(f32x4*)(out + O_CONVP + ((size_t)sq * 3 + (t - (SEQ - 3))) * 512 + c2) = v; }
                            else if (t >= 1) *(f32x4*)(out + O_CONVS + ((size_t)sq * 3 + (t - 1)) * 512 + c2) = v;
                        } else {
                            if (cc < 24) { f32x4 g;
#pragma unroll
                                for (int e = 0; e < 4; ++e) g[e] = sigmoidf_(v[e]);
                                *(f32x4*)(GATES + (size_t)row * 24 + cc) = g; }
                        }
                    }
                asm volatile("" ::: "memory");
            }
    }
};

struct EpiOut {
    static constexpr bool PERM = false, AFTER_DRAIN = false;
    const float *xp, *xs; float* X1; bf16_t* XN; float* SS;
    __device__ __forceinline__ void operator()(const f32x4 (&acc)[2][2][4][2], const Unit& u, int wr, int wc, int fr, int fq) const {
#pragma unroll
        for (int ai = 0; ai < 2; ++ai)
#pragma unroll
            for (int m = 0; m < 4; ++m) {
                const int row = u.pm * BM + ai * HALF + wr * 64 + m * 16 + fr;
                const float* xr = row < MP ? xp + (size_t)row * DM : xs + (size_t)(row - MP) * DM;
                float ss = 0.f;
#pragma unroll
                for (int bj = 0; bj < 2; ++bj)
#pragma unroll
                    for (int n = 0; n < 2; ++n) {
                        const int c = u.pn * BM + bj * HALF + wc * 32 + n * 16 + fq * 4;
                        const f32x4 v = *(const f32x4*)(xr + c) + acc[ai][bj][m][n];
                        *(f32x4*)(X1 + (size_t)row * DM + c) = v;
                        *(u32x2*)(XN + (size_t)row * DM + c) = pack4(v);
                        ss += (v[0] * v[0] + v[1] * v[1]) + (v[2] * v[2] + v[3] * v[3]);
                    }
                ss += __shfl_xor(ss, 16); ss += __shfl_xor(ss, 32);
                if (fq == 0) atomicAdd(SS + row, ss);
            }
    }
};
struct EpiUp {
    static constexpr bool PERM = true, AFTER_DRAIN = false;
    bf16_t* H; const float* SS;
    __device__ __forceinline__ void operator()(const f32x4 (&acc)[2][2][4][2], const Unit& u, int wr, int wc, int fr, int fq) const {
#pragma unroll
        for (int ai = 0; ai < 2; ++ai)
#pragma unroll
            for (int m = 0; m < 4; ++m) {
                const int row = u.pm * BM + ai * HALF + wr * 64 + m * 16 + fr;
                const float rs = rsqrtf(SS[row] * (1.0f / DM) + EPSN);
#pragma unroll
                for (int bj = 0; bj < 2; ++bj) {
                    f32x4 v0 = acc[ai][bj][m][0] * rs, v1 = acc[ai][bj][m][1] * rs;
#pragma unroll
                    for (int e = 0; e < 4; ++e) { const float a = fmaxf(v0[e], 0.f), b = fmaxf(v1[e], 0.f); v0[e] = a * a; v1[e] = b * b; }
                    u32x4 w; w.x = cvt_pk_bf16(v0[0], v0[1]); w.y = cvt_pk_bf16(v0[2], v0[3]); w.z = cvt_pk_bf16(v1[0], v1[1]); w.w = cvt_pk_bf16(v1[2], v1[3]);
                    *(u32x4*)(H + (size_t)row * FF + u.pn * BM + bj * HALF + wc * 32 + 8 * fq) = w;
                }
            }
    }
};
struct EpiDown {
    static constexpr bool PERM = false, AFTER_DRAIN = false;
    const float* X1; float* Y;
    __device__ __forceinline__ void operator()(const f32x4 (&acc)[2][2][4][2], const Unit& u, int wr, int wc, int fr, int fq) const {
#pragma unroll
        for (int ai = 0; ai < 2; ++ai)
#pragma unroll
            for (int m = 0; m < 4; ++m) {
                const int row = u.pm * BM + ai * HALF + wr * 64 + m * 16 + fr;
#pragma unroll
                for (int bj = 0; bj < 2; ++bj)
#pragma unroll
                    for (int n = 0; n < 2; ++n) {
                        const int c = u.pn * BM + bj * HALF + wc * 32 + n * 16 + fq * 4;
                        *(f32x4*)(Y + (size_t)row * DM + c) = *(const f32x4*)(X1 + (size_t)row * DM + c) + acc[ai][bj][m][n];
                    }
            }
    }
};

template <class Epi, class Sched, bool ALIGN_EPI = false, bool SP2 = false>
__device__ __forceinline__ void gemm_phase(PG8_LAS unsigned char* lds, const Gemm g, const Sched& S, const Epi& E) {
    const int tid = threadIdx.x, wid = __builtin_amdgcn_readfirstlane(tid >> 6), lane = tid & 63, wr = wid >> 2, wc = wid & 3, fr = lane & 15, fq = lane >> 4;
    const int K = g.K, nt = K / BK;
    unsigned voffA[2], voffB[2];
#pragma unroll
    for (int i = 0; i < 2; ++i) { int R, C; stage_rc(tid * 16 + i * 8192, R, C); const int Rb = Epi::PERM ? ((R & ~31) + perm32(R & 31)) : R;
        voffA[i] = (unsigned)(R * K + C) * 2u; voffB[i] = (unsigned)(Rb * K + C) * 2u; }
    const size_t kstep = (size_t)(BK * 2);
    const size_t hstep = (size_t)HALF * K * 2;
    const size_t tstep = 2 * hstep;
    const unsigned ldsw = (unsigned)wid * 1024u;
    const int aoff = lds_byte(wr * 64 + fr, fq * 8), boff = lds_byte(wc * 32 + fr, fq * 8);
#define PG8_SA(b, h) (((b) * 2 + (h)) * HTB)
#define PG8_SB(b, h) ((4 + (b) * 2 + (h)) * HTB)
#define PG8_STAGE(bufoff, gbase, voff) do { _Pragma("unroll") for (int _i = 0; _i < 2; ++_i) \
        __builtin_amdgcn_global_load_lds((const unsigned*)((const char*)(gbase) + (voff)[_i]), (PG8_LAS unsigned*)(lds + (bufoff) + ldsw + _i * 8192), 16, 0, 0); } while (0)
#define PG8_LDA(dst, b, h) do { _Pragma("unroll") for (int m = 0; m < 4; ++m) _Pragma("unroll") for (int k = 0; k < 2; ++k) dst[m][k] = *(const PG8_LAS bf16x8*)(lds + PG8_SA(b, h) + aoff + m * 2048 + k * 1024); } while (0)
#define PG8_LDB(dst, b, h) do { _Pragma("unroll") for (int n = 0; n < 2; ++n) _Pragma("unroll") for (int k = 0; k < 2; ++k) dst[n][k] = *(const PG8_LAS bf16x8*)(lds + PG8_SB(b, h) + boff + n * 2048 + k * 1024); } while (0)
#define PG8_MMA(ai, bj, At, Bt) do { __builtin_amdgcn_s_setprio(1); _Pragma("unroll") for (int m = 0; m < 4; ++m) _Pragma("unroll") for (int n = 0; n < 2; ++n) _Pragma("unroll") for (int k = 0; k < 2; ++k) \
        acc[ai][bj][m][n] = __builtin_amdgcn_mfma_f32_16x16x32_bf16(Bt[n][k], At[m][k], acc[ai][bj][m][n], 0, 0, 0); __builtin_amdgcn_s_setprio(0); } while (0)
#define PG8_WAIT_V(n) asm volatile("s_waitcnt vmcnt(" #n ")" ::: "memory")
#define PG8_WAIT_L(n) asm volatile("s_waitcnt lgkmcnt(" #n ")" ::: "memory")
#define PG8_BAR __builtin_amdgcn_s_barrier()
#define PG8_SCHED __builtin_amdgcn_sched_barrier(0)
    Unit cur, nxt; int ui = 0;
    if (!S.next(0, cur)) return;
    f32x4 acc[2][2][4][2];
#pragma unroll
    for (int a = 0; a < 2; ++a)
#pragma unroll
        for (int b = 0; b < 2; ++b)
#pragma unroll
            for (int m = 0; m < 4; ++m)
#pragma unroll
                for (int n = 0; n < 2; ++n) acc[a][b][m][n] = (f32x4){0.f, 0.f, 0.f, 0.f};
    bf16x8 At[4][2], B0[2][2], B1[2][2];
    const char* cA = (const char*)g.A + (size_t)cur.pm * tstep; const char* cB = (const char*)g.Bt + (size_t)cur.pn * tstep;
    S.a_ready(cur);
    if constexpr (SP2) {
        PG8_STAGE(PG8_SB(0, 0), cB, voffB); PG8_STAGE(PG8_SB(0, 1), cB + hstep, voffB); PG8_STAGE(PG8_SA(0, 0), cA, voffA); PG8_STAGE(PG8_SA(0, 1), cA + hstep, voffA);
        if (wr == 1) PG8_BAR;
        PG8_WAIT_V(2); PG8_BAR;
        PG8_STAGE(PG8_SB(1, 0), cB + kstep, voffB); PG8_STAGE(PG8_SA(1, 0), cA + kstep, voffA); PG8_STAGE(PG8_SB(1, 1), cB + hstep + kstep, voffB);
        PG8_WAIT_V(6); PG8_BAR;
    } else {
        PG8_STAGE(PG8_SB(0, 0), cB, voffB); PG8_STAGE(PG8_SA(0, 0), cA, voffA); PG8_STAGE(PG8_SB(0, 1), cB + hstep, voffB); PG8_STAGE(PG8_SA(0, 1), cA + hstep, voffA);
        if (wr == 1) PG8_BAR;
        PG8_WAIT_V(4); PG8_BAR;
        PG8_STAGE(PG8_SB(1, 0), cB + kstep, voffB); PG8_STAGE(PG8_SA(1, 0), cA + kstep, voffA); PG8_STAGE(PG8_SB(1, 1), cB + hstep + kstep, voffB);
        PG8_WAIT_V(6); PG8_BAR;
    }
    for (;;) {
        const bool has_next = S.next(ui + 1, nxt);
        const char* nA = has_next ? (const char*)g.A + (size_t)nxt.pm * tstep : cA; const char* nB = has_next ? (const char*)g.Bt + (size_t)nxt.pn * tstep : cB;
        for (int t = 0; t < nt; t += 2) {
            const bool last = (t == nt - 2);
            const char* a1 = cA + (size_t)(t + 1) * kstep;
            const char* a2 = last ? nA : cA + (size_t)(t + 2) * kstep; const char* b2 = last ? nB : cB + (size_t)(t + 2) * kstep;
            const char* a3 = a2 + kstep; const char* b3 = b2 + kstep;
            if (last && has_next) S.a_ready(nxt);
            if constexpr (SP2) {
            PG8_LDB(B0, 0, 0); PG8_LDB(B1, 0, 1); PG8_SCHED; PG8_LDA(At, 0, 0); PG8_STAGE(PG8_SA(1, 1), a1 + hstep, voffA);
            PG8_WAIT_V(8); PG8_WAIT_L(0); PG8_BAR; PG8_MMA(0, 0, At, B0); PG8_MMA(0, 1, At, B1); PG8_BAR; PG8_SCHED;
            PG8_LDA(At, 0, 1); PG8_STAGE(PG8_SB(0, 0), b2, voffB); PG8_STAGE(PG8_SB(0, 1), b2 + hstep, voffB); PG8_STAGE(PG8_SA(0, 0), a2, voffA);
            PG8_WAIT_V(8); PG8_WAIT_L(0); PG8_BAR; PG8_MMA(1, 0, At, B0); PG8_MMA(1, 1, At, B1); PG8_BAR; PG8_SCHED;
            PG8_LDB(B0, 1, 0); PG8_LDB(B1, 1, 1); PG8_SCHED; PG8_LDA(At, 1, 0); PG8_STAGE(PG8_SA(0, 1), a2 + hstep, voffA);
            PG8_WAIT_V(8); PG8_WAIT_L(0); PG8_BAR; PG8_MMA(0, 0, At, B0); PG8_MMA(0, 1, At, B1); PG8_BAR; PG8_SCHED;
            PG8_LDA(At, 1, 1); PG8_STAGE(PG8_SB(1, 0), b3, voffB); PG8_STAGE(PG8_SB(1, 1), b3 + hstep, voffB); PG8_STAGE(PG8_SA(1, 0), a3, voffA);
            PG8_WAIT_V(8); PG8_WAIT_L(0); PG8_BAR; PG8_MMA(1, 0, At, B0); PG8_MMA(1, 1, At, B1); PG8_BAR; PG8_SCHED;
            } else {
            PG8_LDB(B0, 0, 0); PG8_SCHED; PG8_LDA(At, 0, 0); PG8_STAGE(PG8_SA(1, 1), a1 + hstep, voffA);
            PG8_WAIT_L(8); PG8_BAR; PG8_WAIT_L(0); PG8_MMA(0, 0, At, B0); PG8_BAR; PG8_SCHED;
            PG8_LDB(B1, 0, 1); PG8_STAGE(PG8_SB(0, 0), b2, voffB);
            PG8_BAR; PG8_WAIT_L(0); PG8_MMA(0, 1, At, B1); PG8_BAR;
            PG8_LDA(At, 0, 1); PG8_STAGE(PG8_SA(0, 0), a2, voffA);
            PG8_BAR; PG8_WAIT_L(0); PG8_MMA(1, 0, At, B0); PG8_BAR; PG8_SCHED;
            PG8_STAGE(PG8_SB(0, 1), b2 + hstep, voffB);
            PG8_WAIT_V(6); PG8_BAR; PG8_MMA(1, 1, At, B1); PG8_BAR;
            PG8_LDB(B0, 1, 0); PG8_SCHED; PG8_LDA(At, 1, 0); PG8_STAGE(PG8_SA(0, 1), a2 + hstep, voffA);
            PG8_WAIT_L(8); PG8_BAR; PG8_WAIT_L(0); PG8_MMA(0, 0, At, B0); PG8_BAR; PG8_SCHED;
            PG8_LDB(B1, 1, 1); PG8_STAGE(PG8_SB(1, 0), b3, voffB);
            PG8_BAR; PG8_WAIT_L(0); PG8_MMA(0, 1, At, B1); PG8_BAR;
            PG8_LDA(At, 1, 1); PG8_STAGE(PG8_SA(1, 0), a3, voffA);
            PG8_BAR; PG8_WAIT_L(0); PG8_MMA(1, 0, At, B0); PG8_BAR; PG8_SCHED;
            PG8_STAGE(PG8_SB(1, 1), b3 + hstep, voffB);
            PG8_WAIT_V(6); PG8_BAR; PG8_MMA(1, 1, At, B1); PG8_BAR;
            }
        }
        if constexpr (ALIGN_EPI) { if (wr == 0) PG8_BAR; }
        if constexpr (!Epi::AFTER_DRAIN) { E(acc, cur, wr, wc, fr, fq); S.done(cur); }
        if (!has_next) break;
#pragma unroll
        for (int a = 0; a < 2; ++a)
#pragma unroll
            for (int b = 0; b < 2; ++b)
#pragma unroll
                for (int m = 0; m < 4; ++m)
#pragma unroll
                    for (int n = 0; n < 2; ++n) acc[a][b][m][n] = (f32x4){0.f, 0.f, 0.f, 0.f};
        cur = nxt; cA = nA; cB = nB; ++ui;
        if constexpr (ALIGN_EPI) { if (wr == 1) PG8_BAR; }
    }
    PG8_WAIT_V(0);
    if constexpr (!ALIGN_EPI) { if (wr == 0) PG8_BAR; }
    PG8_BAR;
    if constexpr (Epi::AFTER_DRAIN) { E.fused(acc, cur, wr, wc, fr, fq, lds, wid, lane); S.done(cur); }
#undef PG8_SA
#undef PG8_SB
#undef PG8_STAGE
#undef PG8_LDA
#undef PG8_LDB
#undef PG8_MMA
#undef PG8_WAIT_V
#undef PG8_WAIT_L
#undef PG8_BAR
#undef PG8_SCHED
}
}
constexpr size_t MiB = 1u << 20;
constexpr size_t WS_CTL = 0, CTL_ZERO_BYTES = 1 * MiB;
constexpr int CW_BAR = 4096;
constexpr int CW_RNN = 12288;
constexpr int CW_Q2 = 8192, CW_Q3 = 8192 + 64;
constexpr size_t CTL_SS1 = 256 * 1024, CTL_SS2 = 384 * 1024, CTL_B1 = 640 * 1024, CTL_DUMMY = 768 * 1024;
constexpr size_t WS_ROT = 1 * MiB;
constexpr size_t WS_WC1 = 2 * MiB;
constexpr size_t WS_WC2 = WS_WC1 + 512 * 1024;
constexpr size_t WS_B1 = WS_WC2 + 32 * 1024;
constexpr size_t WS_WR = WS_B1 + 32 * 1024;
constexpr size_t WS_WIN = 4 * MiB, WS_WOUT = 10 * MiB, WS_WUP = 12 * MiB, WS_WDN = 20 * MiB;
constexpr size_t WS_XN = 32 * MiB;
constexpr size_t WS_QN = 66 * MiB, WS_QR = 83 * MiB;
constexpr size_t WS_KS = 100 * MiB, WS_VS = 105 * MiB, WS_KW = 110 * MiB, WS_VW = 115 * MiB;
constexpr size_t WS_GATES = 120 * MiB;
constexpr size_t WS_GRG = 122 * MiB;
constexpr size_t WS_RX = 139 * MiB;
constexpr size_t WS_HL = 172 * MiB, WS_AC = 205 * MiB;
constexpr size_t WS_CARRY = 239 * MiB;
constexpr size_t WS_SSA = 239 * MiB + 512 * 1024;
constexpr size_t WS_SUMM = 238 * MiB;
constexpr size_t WS_KCC = 240 * MiB, WS_VCC = 245 * MiB;
constexpr size_t WS_MIXED = 250 * MiB;
constexpr size_t WS_X1 = 284 * MiB;
constexpr size_t WS_H = 352 * MiB;
constexpr size_t WS_END = 486 * MiB;

constexpr int NWAVES = 8;
constexpr int RING_BYTES = 131072, LDS_BYTES = 147456, MISC_OFF = LDS_BYTES - 64;

#define GAS __attribute__((address_space(1)))
#define LAS __attribute__((address_space(3)))
typedef unsigned short bf16;
typedef unsigned v4u __attribute__((ext_vector_type(4)));
typedef unsigned v2u __attribute__((ext_vector_type(2)));
typedef float f32x4 __attribute__((ext_vector_type(4)));
typedef float f32x16 __attribute__((ext_vector_type(16)));
typedef short bf16x8 __attribute__((ext_vector_type(8)));
typedef short s16x4 __attribute__((ext_vector_type(4)));
typedef GAS unsigned gu32;
#define RLX_AGENT __ATOMIC_RELAXED, __HIP_MEMORY_SCOPE_AGENT
#define LDS_WAIT() asm volatile("s_waitcnt lgkmcnt(0)" ::: "memory")
typedef float f32x2_t __attribute__((ext_vector_type(2))); typedef __bf16 bf16x2_t __attribute__((ext_vector_type(2)));
__device__ __forceinline__ unsigned pk2(float lo, float hi) { f32x2_t v = {lo, hi}; bf16x2_t b = __builtin_convertvector(v, bf16x2_t); return __builtin_bit_cast(unsigned, b); }
__device__ __forceinline__ float bf2f(unsigned short h) { return __builtin_bit_cast(float, (unsigned)h << 16); }
__device__ __forceinline__ float bflo(unsigned w) { return __builtin_bit_cast(float, w << 16); }
__device__ __forceinline__ float bfhi(unsigned w) { return __builtin_bit_cast(float, w & 0xffff0000u); }
__device__ __forceinline__ float wave_sum(float v) {
#pragma unroll
    for (int o = 1; o < 64; o <<= 1) v += __shfl_xor(v, o);
    return v;
}

#define XB_TMO      128
#define XB_XCNT(j)  (256  + 64 * (j))
#define XB_XSUB(j)  (1280 + 64 * (j))
#define XB_XGEN(j)  (2304 + 64 * (j))
#define XB_TOP      3328
#define XB_TOPGEN   3392
#define XCD_BAR_WORDS 3456
#define XB_SPIN_CAP (1u << 18)

__device__ __forceinline__ unsigned xb_ld(unsigned* p)              { return __hip_atomic_load(p, __ATOMIC_RELAXED, __HIP_MEMORY_SCOPE_AGENT); }
__device__ __forceinline__ unsigned xb_add(unsigned* p, unsigned v) { return __hip_atomic_fetch_add(p, v, __ATOMIC_RELAXED, __HIP_MEMORY_SCOPE_AGENT); }
__device__ __forceinline__ unsigned xb_xcc_id() { return (unsigned)__builtin_amdgcn_s_getreg((3 << 11) | 20) & 0xFu; }
#define XB_SPIN(cond, bar) do { unsigned _sp = 0; while (cond) { __builtin_amdgcn_s_sleep(1); \
    if ((++_sp & 255u) == 0u) { if (xb_ld(&(bar)[XB_TMO])) break; if (_sp > XB_SPIN_CAP) { atomicAdd(&(bar)[XB_TMO], 1u); break; } } } } while (0)

struct XcdBarrier {
    unsigned* bar; unsigned x;
    volatile LAS unsigned* st;
};

__device__ __forceinline__ XcdBarrier xcd_barrier_post(unsigned* bar, volatile LAS unsigned* st) {
    XcdBarrier b; b.bar = bar; b.x = xb_xcc_id(); b.st = st;
    if (threadIdx.x == 0) (void)xb_add(&bar[XB_XCNT(b.x)], 1u);
    return b;
}
__device__ __forceinline__ void xcd_barrier_complete(unsigned* bar, unsigned x, unsigned& nloc, unsigned& nx) {
    const unsigned G = gridDim.x * gridDim.y * gridDim.z;
    unsigned sum, cnt, mine, sp = 0u;
    for (;;) {
        sum = 0u; cnt = 0u; mine = 0u;
#pragma unroll
        for (unsigned j = 0; j < 16; ++j) { const unsigned c = xb_ld(&bar[XB_XCNT(j)]); sum += c; cnt += (c > 0u) ? 1u : 0u; mine = (j == x) ? c : mine; }
        if (sum == G) break;
        __builtin_amdgcn_s_sleep(1);
        if ((++sp & 255u) == 0u) { if (xb_ld(&bar[XB_TMO])) break; if (sp > XB_SPIN_CAP) { atomicAdd(&bar[XB_TMO], 1u); break; } }
    }
    nloc = mine > 0u ? mine : 1u; nx = cnt > 0u ? cnt : 1u;
}

__device__ __forceinline__ void xcd_barrier(const XcdBarrier& b) {
    asm volatile("s_waitcnt vmcnt(0)" ::: "memory");
    __syncthreads();
    if (threadIdx.x == 0) {
        unsigned* bar = b.bar;
        __builtin_amdgcn_s_waitcnt(0);
        unsigned nloc = b.st[0], nx = b.st[1];
        if (nloc == 0u) { xcd_barrier_complete(bar, b.x, nloc, nx); b.st[0] = nloc; b.st[1] = nx; }
        const unsigned old = xb_add(&bar[XB_XSUB(b.x)], 1u);
        const unsigned gen = old / nloc;
        if (old + 1u == (gen + 1u) * nloc) {
            __builtin_amdgcn_fence(__ATOMIC_RELEASE, "agent");
            asm volatile("s_waitcnt vmcnt(0)" ::: "memory");
            const unsigned og = xb_add(&bar[XB_TOP], 1u);
            const unsigned tg = og / nx;
            if (og + 1u == (tg + 1u) * nx) xb_add(&bar[XB_TOPGEN], 1u);
            else XB_SPIN(xb_ld(&bar[XB_TOPGEN]) == tg, bar);
            __builtin_amdgcn_fence(__ATOMIC_ACQUIRE, "agent");
            xb_add(&bar[XB_XGEN(b.x)], 1u);
            asm volatile("s_waitcnt vmcnt(0)" ::: "memory");
        } else {
            XB_SPIN(xb_ld(&bar[XB_XGEN(b.x)]) == gen, bar);
            __builtin_amdgcn_fence(__ATOMIC_ACQUIRE, "agent");
            asm volatile("s_waitcnt vmcnt(0)" ::: "memory");
        }
    }
    __syncthreads();
}

struct Frame {
    LAS unsigned char* lds;
    int tid, lane, wave, G, vcu;
    const float* const* in; const int* page_table;
    float* out; unsigned char* ws; gu32* ctl;
};
#define WSP(T, off) ((T*)(F.ws + (off)))

template <int MAP>
__device__ __forceinline__ void p0_transpose_item(const float* W, int ldw, int K, int Nphys, bf16* WT, int row_off, LAS float* scr, int item, int lane, const float* kscale) {
    const int nblk = Nphys / 32, kb = item / nblk, nb = item % nblk, k0 = 64 * kb, n0 = 32 * nb;
    const int np = n0 + (lane & 31);
    int ln = np;
    if (MAP == 1) ln = np < 1280 ? np : (np < 2304 ? np + 24 : (np < 2328 ? np - 1024 : -1));
#pragma unroll 8
    for (int i = 0; i < 32; ++i) { const int kk = 2 * i + (lane >> 5);
        float v = ln >= 0 ? W[(size_t)(k0 + kk) * ldw + ln] : 0.f;
        if (kscale) v *= kscale[k0 + kk];
        scr[kk * 33 + (lane & 31)] = v; }
    LDS_WAIT(); asm volatile("" ::: "memory");
    const int c = lane & 7;
#pragma unroll
    for (int j = 0; j < 4; ++j) { const int n = (lane >> 3) + 8 * j; const LAS float* s = scr + (8 * c) * 33 + n;
        v4u o; o.x = pk2(s[0 * 33], s[1 * 33]); o.y = pk2(s[2 * 33], s[3 * 33]); o.z = pk2(s[4 * 33], s[5 * 33]); o.w = pk2(s[6 * 33], s[7 * 33]);
        *(GAS v4u*)(WT + (size_t)(row_off + n0 + n) * K + k0 + 8 * c) = o; }
    LDS_WAIT(); asm volatile("" ::: "memory");
}
__device__ __forceinline__ void rms_row_to_bf16(const float* xrow, const float* g, bf16* orow, int lane) {
    const GAS f32x4* xr = (const GAS f32x4*)xrow + lane; const GAS f32x4* gr = (const GAS f32x4*)g + lane;
    f32x4 v[4]; float s = 0.f;
#pragma unroll
    for (int j = 0; j < 4; ++j) { v[j] = xr[64 * j]; s += (v[j].x * v[j].x + v[j].y * v[j].y) + (v[j].z * v[j].z + v[j].w * v[j].w); }
    const float rs = rsqrtf(wave_sum(s) * (1.f / DM) + EPSN);
    GAS unsigned long long* o8 = (GAS unsigned long long*)orow + lane;
#pragma unroll
    for (int j = 0; j < 4; ++j) { const f32x4 gg = gr[64 * j];
        o8[64 * j] = (unsigned long long)pk2(v[j].x * rs * gg.x, v[j].y * rs * gg.y) | ((unsigned long long)pk2(v[j].z * rs * gg.z, v[j].w * rs * gg.w) << 32); }
}
__device__ __forceinline__ void p0_prologue(Frame& F) {
    LAS float* scr = (LAS float*)(F.lds + F.wave * 16384);
    const int gw = F.vcu * NWAVES + F.wave, NGW = F.G * NWAVES;
    constexpr int I_IN = 16 * (NIN / 32), I_OUT = 16 * 32, I_UP = 16 * (FF / 32), I_DN = 64 * 32, I_C1 = 4 * 32, I_C2 = 2 * 2, I_R = 16 * 2;
    constexpr int NITEMS = I_IN + I_OUT + I_UP + I_DN + I_C1 + I_C2 + I_R;
    for (int it = gw; it < NITEMS; it += NGW) {
        int r = it;
        if (r < I_IN) { p0_transpose_item<1>(F.in[7], 2328, DM, NIN, WSP(bf16, WS_WIN), 0, scr, r, F.lane, nullptr); continue; } r -= I_IN;
        if (r < I_OUT) { p0_transpose_item<0>(F.in[23], DM, DM, DM, WSP(bf16, WS_WOUT), 0, scr, r, F.lane, nullptr); continue; } r -= I_OUT;
        if (r < I_UP) { p0_transpose_item<0>(F.in[26], FF, DM, FF, WSP(bf16, WS_WUP), 0, scr, r, F.lane, F.in[25]); continue; } r -= I_UP;
        if (r < I_DN) { p0_transpose_item<0>(F.in[27], DM, FF, DM, WSP(bf16, WS_WDN), 0, scr, r, F.lane, nullptr); continue; } r -= I_DN;
        if (r < I_C1) { const int q = r / 32, slot = q >> 1, half = q & 1;
            p0_transpose_item<0>(F.in[slot ? 12 : 9] + (size_t)half * 1024 * 64, 64, 1024, 64, WSP(bf16, WS_WC1) + (size_t)slot * 128 * 1024, half * 64, scr, r % 32, F.lane, nullptr); continue; } r -= I_C1;
        if (r < I_C2) { const int slot = r >> 1;
            p0_transpose_item<0>(F.in[slot ? 13 : 10], 64, 64, 64, WSP(bf16, WS_WC2) + (size_t)slot * 4096, 0, scr, r & 1, F.lane, nullptr); continue; } r -= I_C2;
        { const int q = r >> 1, blk = q >> 1, which = q & 1;
            p0_transpose_item<0>(F.in[which ? 20 : 18] + (size_t)blk * 4096, 64, 64, 64, WSP(bf16, WS_WR) + (size_t)blk * 8192, which * 64, scr, r & 1, F.lane, nullptr); }
    }
    { const int gt = gw * 64 + F.lane;
      if (gt < 2052 * 8) { const int pos = gt >> 3, i = gt & 7;
          const double inv = pow(500000.0, -(double)i / 8.0), ang = (double)pos * inv;
          float* rt = WSP(float, WS_ROT) + pos * 16; rt[i] = (float)cos(ang); rt[8 + i] = (float)sin(ang); } }
    if (gw >= NGW - 64) { const int idx = gw - (NGW - 64), slot = idx >> 5, kp = idx & 31; const float* pe = F.in[slot ? 11 : 8] + kp * 64; const float* w1 = F.in[slot ? 12 : 9] + (size_t)kp * 64 * 64;
        float a = 0.f;
#pragma unroll 16
        for (int k = 0; k < 64; ++k) a += pe[k] * w1[(size_t)k * 64 + F.lane];
        atomicAdd((float*)(F.ws + WS_CTL + CTL_B1) + slot * 64 + F.lane, a); }
    for (int m = gw; m < MT; m += NGW) {
        const float* xr = m < MP ? F.in[0] + (size_t)m * DM : F.in[1] + (size_t)(m - MP) * DM;
        rms_row_to_bf16(xr, F.in[24], WSP(bf16, WS_XN) + (size_t)m * DM, F.lane);
    }
}
__device__ __forceinline__ void p7_final(Frame& F) {
    const int gw = F.vcu * NWAVES + F.wave, NGW = F.G * NWAVES;
    const GAS f32x4* gr = (const GAS f32x4*)F.in[28] + F.lane;
    for (int m = gw; m < MT; m += NGW) {
        GAS f32x4* yr = (GAS f32x4*)(F.out + (size_t)m * DM) + F.lane;
        f32x4 v[4]; float s = 0.f;
#pragma unroll
        for (int j = 0; j < 4; ++j) { v[j] = yr[64 * j]; s += (v[j].x * v[j].x + v[j].y * v[j].y) + (v[j].z * v[j].z + v[j].w * v[j].w); }
        const float rs = rsqrtf(wave_sum(s) * (1.f / DM) + EPSN);
#pragma unroll
        for (int j = 0; j < 4; ++j) yr[64 * j] = v[j] * rs * gr[64 * j];
    }
}

__device__ __forceinline__ void rnn_unit(Frame& F, int u) {
    const int b = F.wave, lane = F.lane, fr = lane & 15, fq = lane >> 4;
    const bool samp = u >= 256;
    const int rowbase = samp ? MP + 64 * (u - 256) : (u >> 5) * SEQ + (u & 31) * 64;
    const int t0 = samp ? 0 : (u & 31) * 64;
    const float* RX = WSP(float, WS_RX); float* HL = WSP(float, WS_HL); float* AC = WSP(float, WS_AC);
    const float* convw = F.in[16]; const float* convb = F.in[17]; const float* stc = F.in[4]; const float* sth = F.in[5];
    LAS float* xcs = (LAS float*)(F.lds + b * 8704);
    const bf16* wrp = WSP(bf16, WS_WR) + (size_t)b * 8192 + fr * 64 + 8 * fq;
    float hc[4], Ac[4];
#pragma unroll
    for (int nn = 0; nn < 4; ++nn) { hc[nn] = 0.f; Ac[nn] = 1.f; }
    for (int sub = 0; sub < 2; ++sub) {
        bf16x8 af[2][2];
#pragma unroll
        for (int m = 0; m < 2; ++m) {
            const int tau = 32 * sub + 16 * m + fr;
#pragma unroll
            for (int ks = 0; ks < 2; ++ks) {
                const int cbase = 64 * b + 32 * ks + 8 * fq;
                f32x4 xa = *(const f32x4*)(convb + cbase), xb = *(const f32x4*)(convb + cbase + 4);
#pragma unroll
                for (int k = 0; k < 4; ++k) {
                    const float* src; bool ok = true;
                    if (!samp) { const int rr = tau - 3 + k; ok = (t0 + rr) >= 0; src = RX + (size_t)(rowbase + rr) * 512 + cbase; }
                    else { const int r2 = (tau & 3) - 3 + k;
                        if (r2 >= 0) src = RX + (size_t)(rowbase + (tau & ~3) + r2) * 512 + cbase;
                        else src = stc + ((size_t)((u - 256) * 16 + (tau >> 2)) * 3 + (3 + r2)) * 512 + cbase; }
                    f32x4 v0 = (f32x4){0.f, 0.f, 0.f, 0.f}, v1 = v0;
                    if (ok) { v0 = *(const f32x4*)src; v1 = *(const f32x4*)(src + 4); }
                    const f32x4 w0 = *(const f32x4*)(convw + k * 512 + cbase), w1 = *(const f32x4*)(convw + k * 512 + cbase + 4);
                    xa += w0 * v0; xb += w1 * v1;
                }
                v4u pk; pk.x = pk2(xa[0], xa[1]); pk.y = pk2(xa[2], xa[3]); pk.z = pk2(xb[0], xb[1]); pk.w = pk2(xb[2], xb[3]);
                af[m][ks] = __builtin_bit_cast(bf16x8, pk);
                LAS float* xd = xcs + (16 * m + fr) * 68 + 32 * ks + 8 * fq;
                *(LAS f32x4*)xd = xa; *(LAS f32x4*)(xd + 4) = xb;
            }
        }
        LDS_WAIT();
#pragma unroll 1
        for (int nn = 0; nn < 4; ++nn) {
            const int ch = 64 * b + 16 * nn + fr;
            const float bra = F.in[19][ch], bri = F.in[21][ch], sp = log1pf(__expf(-F.in[22][ch]));
            f32x4 acc[2][2];
#pragma unroll
            for (int m = 0; m < 2; ++m) { acc[m][0] = (f32x4){0.f, 0.f, 0.f, 0.f}; acc[m][1] = acc[m][0]; }
#pragma unroll
            for (int g = 0; g < 2; ++g)
#pragma unroll
                for (int ks = 0; ks < 2; ++ks) { const bf16x8 wv = *(const bf16x8*)(wrp + (size_t)(64 * g + 16 * nn) * 64 + 32 * ks);
#pragma unroll
                    for (int m = 0; m < 2; ++m) acc[m][g] = __builtin_amdgcn_mfma_f32_16x16x32_bf16(af[m][ks], wv, acc[m][g], 0, 0, 0); }
            float hcn = 0.f, acn = 1.f;
#pragma unroll
            for (int q = 0; q < 4; ++q) if (q == nn) { hcn = hc[q]; acn = Ac[q]; }
#pragma unroll
            for (int m = 0; m < 2; ++m) {
                float a[4], bb[4];
#pragma unroll
                for (int e = 0; e < 4; ++e) {
                    const float r = 1.f / (1.f + __expf(-(acc[m][0][e] + bra)));
                    const float ig = 1.f / (1.f + __expf(-(acc[m][1][e] + bri)));
                    const float la = -8.0f * r * sp;
                    a[e] = __expf(la);
                    const float xcv = xcs[(16 * m + 4 * fq + e) * 68 + 16 * nn + fr];
                    bb[e] = sqrtf(fmaxf(1.f - a[e] * a[e], 0.f)) * (ig * xcv);
                }
                const int trow = rowbase + 32 * sub + 16 * m + 4 * fq;
                if (!samp) {
                    const float Pl = (a[0] * a[1]) * (a[2] * a[3]);
                    float Hl = bb[0]; Hl = a[1] * Hl + bb[1]; Hl = a[2] * Hl + bb[2]; Hl = a[3] * Hl + bb[3];
                    float cin = hcn, ain = acn;
#pragma unroll
                    for (int k = 0; k < 4; ++k) {
                        const float hend = Pl * cin + Hl, aend = ain * Pl;
                        const float nh = __shfl(hend, fr + 16 * k), na = __shfl(aend, fr + 16 * k);
                        if (k < 3) { if (fq == k + 1) { cin = nh; ain = na; } } else { hcn = nh; acn = na; }
                    }
                    float hv = cin, av = ain;
#pragma unroll
                    for (int e = 0; e < 4; ++e) { hv = a[e] * hv + bb[e]; av *= a[e]; HL[(size_t)(trow + e) * 512 + ch] = hv; AC[(size_t)(trow + e) * 512 + ch] = av; }
                } else {
                    const int s = (u - 256) * 16 + 8 * sub + 4 * m + fq;
                    float hv = sth[(size_t)s * 512 + ch];
#pragma unroll
                    for (int e = 0; e < 4; ++e) { hv = a[e] * hv + bb[e]; HL[(size_t)(trow + e) * 512 + ch] = hv; AC[(size_t)(trow + e) * 512 + ch] = 0.f; }
                    F.out[O_HS + (size_t)s * 512 + ch] = hv;
                }
            }
#pragma unroll
            for (int q = 0; q < 4; ++q) if (q == nn) { hc[q] = hcn; Ac[q] = acn; }
        }
        LDS_WAIT();
    }
    if (!samp && fq == 0) { float* sm = WSP(float, WS_SUMM) + (size_t)u * 1024;
#pragma unroll
        for (int nn = 0; nn < 4; ++nn) { const int ch = 64 * b + 16 * nn + fr; sm[ch] = hc[nn]; sm[512 + ch] = Ac[nn]; } }
    if (!samp) {
        asm volatile("s_waitcnt vmcnt(0)" ::: "memory");
        __syncthreads();
        volatile LAS unsigned* MISC = (volatile LAS unsigned*)(F.lds + MISC_OFF);
        const int n = u >> 5;
        if (F.tid == 0) {
            __builtin_amdgcn_fence(__ATOMIC_RELEASE, "agent");
            asm volatile("s_waitcnt vmcnt(0)" ::: "memory");
            const unsigned old = __hip_atomic_fetch_add((unsigned*)(F.ctl + CW_RNN + 64 * n), 1u, RLX_AGENT);
            if (old == 31u) { __builtin_amdgcn_fence(__ATOMIC_ACQUIRE, "agent"); asm volatile("s_waitcnt vmcnt(0)" ::: "memory"); }
            MISC[1] = old;
        }
        __syncthreads();
        const bool last = MISC[1] == 31u;
        if (last) {
            const float* sm = WSP(float, WS_SUMM) + (size_t)n * 32 * 1024 + F.tid; float* cr = WSP(float, WS_CARRY) + (size_t)n * 32 * 512 + F.tid;
            float hv[32], av[32];
#pragma unroll
            for (int c = 0; c < 32; ++c) { hv[c] = __builtin_nontemporal_load(sm + c * 1024); av[c] = __builtin_nontemporal_load(sm + c * 1024 + 512); }
            float carry = 0.f;
#pragma unroll
            for (int c = 0; c < 32; ++c) { cr[c * 512] = carry; carry = av[c] * carry + hv[c]; }
        }
    }
}

__device__ __forceinline__ void compress_unit(Frame& F, int cu) {
    const int tid = F.tid, lane = F.lane, w = F.wave, wr = w >> 2, wc = w & 3, fr = lane & 15, fq = lane >> 4;
    const bool samp = cu < 512;
    const int q = samp ? cu : cu - 512, sq = q >> 2, h = (q >> 1) & 1, slot = q & 1;
    const int seqi = samp ? 8 + sq : sq;
    const int li = tid >> 2, qd = tid & 3;
    const float* abase;
    if (samp) { const int page = F.page_table[sq * 16 + (li >> 3)]; abase = F.in[2] + ((size_t)page * 128 + (size_t)((16 * li) & 127)) * 512 + slot * 128 + h * 64 + 16 * qd; }
    else abase = F.out + O_KV + ((size_t)sq * SEQ + 16 * li) * 512 + slot * 128 + h * 64 + 16 * qd;
    const bf16* bbase = WSP(bf16, WS_WC1) + (size_t)slot * 128 * 1024 + (size_t)li * 1024 + 16 * qd;
    LAS unsigned char* lds = F.lds;
    const int wo0 = li * 128 + (((2 * qd) ^ (li & 7)) << 4), wo1 = li * 128 + (((2 * qd + 1) ^ (li & 7)) << 4);
    f32x4 ar[2][4]; v4u br[2][2];
    f32x4 acc[4][2];
#pragma unroll
    for (int m = 0; m < 4; ++m)
#pragma unroll
        for (int n = 0; n < 2; ++n) acc[m][n] = (f32x4){0.f, 0.f, 0.f, 0.f};
#define CMP_LOAD(s_, j) do { _Pragma("unroll") for (int i_ = 0; i_ < 4; ++i_) ar[s_][i_] = *(const f32x4*)(abase + (size_t)(j) * 512 + 4 * i_); \
        br[s_][0] = *(const v4u*)(bbase + (j) * 64); br[s_][1] = *(const v4u*)(bbase + (j) * 64 + 8); } while (0)
#define CMP_WRITE(s_, st) do { LAS unsigned char* A_ = lds + (st) * 32768; LAS unsigned char* B_ = A_ + 16384; \
        v4u p0_, p1_; p0_.x = pk2(ar[s_][0][0], ar[s_][0][1]); p0_.y = pk2(ar[s_][0][2], ar[s_][0][3]); p0_.z = pk2(ar[s_][1][0], ar[s_][1][1]); p0_.w = pk2(ar[s_][1][2], ar[s_][1][3]); \
        p1_.x = pk2(ar[s_][2][0], ar[s_][2][1]); p1_.y = pk2(ar[s_][2][2], ar[s_][2][3]); p1_.z = pk2(ar[s_][3][0], ar[s_][3][1]); p1_.w = pk2(ar[s_][3][2], ar[s_][3][3]); \
        *(LAS v4u*)(A_ + wo0) = p0_; *(LAS v4u*)(A_ + wo1) = p1_; *(LAS v4u*)(B_ + wo0) = br[s_][0]; *(LAS v4u*)(B_ + wo1) = br[s_][1]; } while (0)
#define CMP_COMPUTE(st) do { const LAS unsigned char* A_ = lds + (st) * 32768; const LAS unsigned char* B_ = A_ + 16384; \
        bf16x8 af[4][2], bf[2][2]; \
        _Pragma("unroll") for (int m = 0; m < 4; ++m) _Pragma("unroll") for (int k = 0; k < 2; ++k) { const int row = 64 * wr + 16 * m + fr; af[m][k] = *(const LAS bf16x8*)(A_ + row * 128 + (((4 * k + fq) ^ (row & 7)) << 4)); } \
        _Pragma("unroll") for (int n = 0; n < 2; ++n) _Pragma("unroll") for (int k = 0; k < 2; ++k) { const int row = 32 * wc + 16 * n + fr; bf[n][k] = *(const LAS bf16x8*)(B_ + row * 128 + (((4 * k + fq) ^ (row & 7)) << 4)); } \
        _Pragma("unroll") for (int m = 0; m < 4; ++m) _Pragma("unroll") for (int n = 0; n < 2; ++n) _Pragma("unroll") for (int k = 0; k < 2; ++k) \
            acc[m][n] = __builtin_amdgcn_mfma_f32_16x16x32_bf16(bf[n][k], af[m][k], acc[m][n], 0, 0, 0); } while (0)
    CMP_LOAD(0, 0); CMP_LOAD(1, 1); CMP_WRITE(0, 0);
    __syncthreads();
    for (int j = 0; j < 16; j += 2) {
        if (j + 2 < 16) CMP_LOAD(0, j + 2);
        CMP_COMPUTE(0);
        CMP_WRITE(1, 1);
        __syncthreads();
        if (j + 3 < 16) CMP_LOAD(1, j + 3);
        CMP_COMPUTE(1);
        if (j + 2 < 16) CMP_WRITE(0, 0);
        __syncthreads();
    }
#undef CMP_COMPUTE
#undef CMP_LOAD
#undef CMP_WRITE
    LAS float* Ys = (LAS float*)lds;
#pragma unroll
    for (int m = 0; m < 4; ++m)
#pragma unroll
        for (int n = 0; n < 2; ++n) *(LAS f32x4*)(Ys + (64 * wr + 16 * m + fr) * 132 + 32 * wc + 16 * n + 4 * fq) = acc[m][n];
    __syncthreads();
    LAS unsigned char* Hs = lds + 73728;
    { const int c = tid >> 2, e0 = (tid & 3) * 16; const float* b1 = (const float*)(F.ws + WS_CTL + CTL_B1) + slot * 64;
      float hv[16];
#pragma unroll
      for (int i = 0; i < 16; ++i) { float v = 0.f; if (c < 127) v = pg8::gelu_tanh(Ys[c * 132 + e0 + i] + Ys[(c + 1) * 132 + 64 + e0 + i] + b1[e0 + i]); hv[i] = v; }
      v4u p0, p1; p0.x = pk2(hv[0], hv[1]); p0.y = pk2(hv[2], hv[3]); p0.z = pk2(hv[4], hv[5]); p0.w = pk2(hv[6], hv[7]);
      p1.x = pk2(hv[8], hv[9]); p1.y = pk2(hv[10], hv[11]); p1.z = pk2(hv[12], hv[13]); p1.w = pk2(hv[14], hv[15]);
      const int c8 = (tid & 3) * 2;
      *(LAS v4u*)(Hs + c * 128 + ((c8 ^ (c & 7)) << 4)) = p0; *(LAS v4u*)(Hs + c * 128 + (((c8 + 1) ^ (c & 7)) << 4)) = p1; }
    __syncthreads();
    { const bf16* w2 = WSP(bf16, WS_WC2) + (size_t)slot * 4096;
      f32x4 a2[4];
#pragma unroll
      for (int n = 0; n < 4; ++n) a2[n] = (f32x4){0.f, 0.f, 0.f, 0.f};
      const int row = 16 * w + fr;
#pragma unroll
      for (int k = 0; k < 2; ++k) { const bf16x8 hf = *(const LAS bf16x8*)(Hs + row * 128 + (((4 * k + fq) ^ (row & 7)) << 4));
#pragma unroll
          for (int n = 0; n < 4; ++n) { const bf16x8 wv = *(const bf16x8*)(w2 + (16 * n + fr) * 64 + 32 * k + 8 * fq); a2[n] = __builtin_amdgcn_mfma_f32_16x16x32_bf16(wv, hf, a2[n], 0, 0, 0); } }
      bf16* dst = WSP(bf16, slot ? WS_VCC : WS_KCC) + ((size_t)seqi * 128 + row) * 128 + h * 64;
#pragma unroll
      for (int n = 0; n < 4; ++n) { v2u o; o.x = pk2(a2[n][0], a2[n][1]); o.y = pk2(a2[n][2], a2[n][3]); *(v2u*)(dst + 16 * n + 4 * fq) = o; } }
    __syncthreads();
}

constexpr float C2S = 0.125f * 1.4426950408889634f;
constexpr float NEGB = -1e30f;
constexpr int A_OA = 65536, A_IMP = 98304, A_SEL = 107520, A_GT = 108032, A_WSF = 111104;
__device__ __forceinline__ int crow(int r, int hi) { return (r & 3) + 8 * (r >> 2) + 4 * hi; }
__device__ __forceinline__ float ex2(float x) { return __builtin_amdgcn_exp2f(x); }

__device__ __forceinline__ void qk_tile(f32x16& p0, f32x16& p1, const LAS unsigned char* Kt, const bf16x8 (&qf)[4], int r32, int hi) {
#pragma unroll
    for (int r = 0; r < 16; ++r) { p0[r] = 0.f; p1[r] = 0.f; }
#pragma unroll
    for (int d0 = 0; d0 < 4; ++d0) {
        const int off = r32 * 128 + (((2 * d0 + hi) ^ (r32 & 7)) << 4);
        const bf16x8 ka = *(const LAS bf16x8*)(Kt + off), kb = *(const LAS bf16x8*)(Kt + off + 4096);
        p0 = __builtin_amdgcn_mfma_f32_32x32x16_bf16(ka, qf[d0], p0, 0, 0, 0);
        p1 = __builtin_amdgcn_mfma_f32_32x32x16_bf16(kb, qf[d0], p1, 0, 0, 0);
    }
}
__device__ __forceinline__ void pv_tile(f32x16 (&o)[2], const LAS unsigned char* Vt, const bf16x8 (&pa)[4], int lane) {
    const int g = lane >> 4, i = lane & 15, q = i >> 2, p = i & 3, hg = g >> 1;
#pragma unroll
    for (int d0 = 0; d0 < 2; ++d0)
#pragma unroll
        for (int ks = 0; ks < 4; ++ks) {
            const int row0 = 16 * ks + 4 * hg + q, chunk = 4 * d0 + 2 * (g & 1) + (p >> 1);
            const LAS unsigned char* a0 = Vt + row0 * 128 + ((chunk ^ (row0 & 7)) << 4) + 8 * (p & 1);
            const s16x4 lo = __builtin_bit_cast(s16x4, __builtin_amdgcn_ds_read_tr16_b64_v4i16((LAS s16x4*)a0));
            const s16x4 hi4 = __builtin_bit_cast(s16x4, __builtin_amdgcn_ds_read_tr16_b64_v4i16((LAS s16x4*)(a0 + 1024)));
            const bf16x8 bv = (bf16x8){lo[0], lo[1], lo[2], lo[3], hi4[0], hi4[1], hi4[2], hi4[3]};
            o[d0] = __builtin_amdgcn_mfma_f32_32x32x16_bf16(pa[ks], bv, o[d0], 0, 0, 0);
        }
}
__device__ __forceinline__ void pack_p(bf16x8 (&pa)[4], const f32x16& p0, const f32x16& p1) {
#pragma unroll
    for (int ks = 0; ks < 2; ++ks) {
        v4u a, b;
        a.x = pk2(p0[8 * ks + 0], p0[8 * ks + 1]); a.y = pk2(p0[8 * ks + 2], p0[8 * ks + 3]); a.z = pk2(p0[8 * ks + 4], p0[8 * ks + 5]); a.w = pk2(p0[8 * ks + 6], p0[8 * ks + 7]);
        b.x = pk2(p1[8 * ks + 0], p1[8 * ks + 1]); b.y = pk2(p1[8 * ks + 2], p1[8 * ks + 3]); b.z = pk2(p1[8 * ks + 4], p1[8 * ks + 5]); b.w = pk2(p1[8 * ks + 6], p1[8 * ks + 7]);
        pa[ks] = __builtin_bit_cast(bf16x8, a); pa[2 + ks] = __builtin_bit_cast(bf16x8, b);
    }
}
__device__ __forceinline__ float mask_scale(f32x16& p0, f32x16& p1, int kbase, int klo, int khi, bool rflag, int hi) {
    float mx = NEGB;
#pragma unroll
    for (int r = 0; r < 16; ++r) { const int kv = kbase + crow(r, hi);
        const bool v0 = rflag && kv >= klo && kv <= khi, v1 = rflag && (kv + 32) >= klo && (kv + 32) <= khi;
        p0[r] = v0 ? p0[r] * C2S : NEGB; p1[r] = v1 ? p1[r] * C2S : NEGB;
        mx = fmaxf(mx, fmaxf(p0[r], p1[r])); }
    return fmaxf(mx, __shfl_xor(mx, 32));
}

template <bool SAMP>
__device__ __forceinline__ void attn_unit(Frame& F, int sq, int qb) {
    int tid = F.tid; asm volatile("" : "+v"(tid));
    const int lane = tid & 63, w = F.wave, r32 = lane & 31, hi = lane >> 5, h = w >> 2, wg = w & 3;
    const int q0 = SAMP ? 0 : qb * 32;
    const int rowbase = SAMP ? MP + 4 * sq : sq * SEQ + q0;
    const int tok = SAMP ? (r32 & 3) : r32;
    const int myhead = h * 4 + (SAMP ? ((r32 >> 2) & 3) : wg);
    const int qpos = SAMP ? SEQ + tok : q0 + r32;
    const int cur = SAMP ? 32 : (q0 >> 6);
    const int seqc = SAMP ? 8 + sq : sq;
    constexpr int NT = SAMP ? 4 : 32;
    LAS unsigned char* lds = F.lds;
    LAS float* IMP = (LAS float*)(lds + A_IMP);
    LAS unsigned long long* SEL = (LAS unsigned long long*)(lds + A_SEL);
    LAS float* GT = (LAS float*)(lds + A_GT);
    LAS float* wsf = (LAS float*)(lds + A_WSF) + w * 64;
    LAS unsigned short* OA = (LAS unsigned short*)(lds + A_OA);
    const bf16 *KS = WSP(bf16, WS_KS), *VS = WSP(bf16, WS_VS), *KW = WSP(bf16, WS_KW), *VW = WSP(bf16, WS_VW), *KCC = WSP(bf16, WS_KCC), *VCC = WSP(bf16, WS_VCC);
    const int lrow = tid >> 3, lch = tid & 7;
    const int lwo = lrow * 128 + ((lch ^ (lrow & 7)) << 4);
    v4u rb[4]; f32x4 rf[8]; bool isf32 = false; unsigned ldmask = 0xF;
#define LD_ISSUE(kind, j, hmask) do { isf32 = false; ldmask = 0; \
        _Pragma("unroll") for (int mi = 0; mi < 4; ++mi) { const int hm_ = mi >> 1, isV_ = mi & 1; \
            if (!(((hmask) >> hm_) & 1)) continue; ldmask |= 1u << mi; \
            if ((kind) == 0) { rb[mi] = *(const v4u*)((isV_ ? VCC : KCC) + ((size_t)(seqc * 128 + 64 * (j) + lrow)) * 128 + hm_ * 64 + lch * 8); } \
            else if (!SAMP) { rb[mi] = *(const v4u*)(((kind) == 1 ? (isV_ ? VS : KS) : (isV_ ? VW : KW)) + ((size_t)(sq * SEQ + 64 * (j) + lrow)) * 128 + hm_ * 64 + lch * 8); } \
            else if ((kind) == 1) { \
                if ((j) < 32) { isf32 = true; const float* s_ = F.in[2] + ((size_t)F.page_table[sq * 16 + ((j) >> 1)] * 128 + ((j) & 1) * 64 + lrow) * 512 + (2 + isV_) * 128 + hm_ * 64 + lch * 8; \
                    rf[2 * mi] = *(const f32x4*)s_; rf[2 * mi + 1] = *(const f32x4*)(s_ + 4); } \
                else { rb[mi] = (v4u){0u, 0u, 0u, 0u}; if (lrow < 4) rb[mi] = *(const v4u*)((isV_ ? VS : KS) + ((size_t)(MP + 4 * sq + lrow)) * 128 + hm_ * 64 + lch * 8); } } \
            else { \
                if ((j) < 8) { isf32 = true; const float* s_ = F.in[3] + ((size_t)(sq * 512 + 64 * (j) + lrow)) * 256 + isV_ * 128 + hm_ * 64 + lch * 8; \
                    rf[2 * mi] = *(const f32x4*)s_; rf[2 * mi + 1] = *(const f32x4*)(s_ + 4); } \
                else { rb[mi] = (v4u){0u, 0u, 0u, 0u}; if (lrow < 4) rb[mi] = *(const v4u*)((isV_ ? VW : KW) + ((size_t)(MP + 4 * sq + lrow)) * 128 + hm_ * 64 + lch * 8); } } \
        } } while (0)
#define LD_WRITE(st) do { _Pragma("unroll") for (int mi = 0; mi < 4; ++mi) { if (!((ldmask >> mi) & 1)) continue; v4u v_ = rb[mi]; \
            if (SAMP && isf32) { v_.x = pk2(rf[2 * mi][0], rf[2 * mi][1]); v_.y = pk2(rf[2 * mi][2], rf[2 * mi][3]); v_.z = pk2(rf[2 * mi + 1][0], rf[2 * mi + 1][1]); v_.w = pk2(rf[2 * mi + 1][2], rf[2 * mi + 1][3]); } \
            *(LAS v4u*)(lds + (st) * 32768 + mi * 8192 + lwo) = v_; } } while (0)

    if (SAMP) { const f32x4* src = (const f32x4*)(F.in[3] + ((size_t)sq * 512 + 4) * 256); f32x4* dst = (f32x4*)(F.out + O_WINS + (size_t)sq * 512 * 256);
        for (int i = tid; i < 508 * 64; i += 512) dst[i] = src[i]; }
    for (int i = tid; i < 2 * 32 * 36; i += 512) IMP[i] = 0.f;
    for (int i = tid; i < NT * 24; i += 512) GT[i] = WSP(float, WS_GATES)[(size_t)rowbase * 24 + i];
    LD_ISSUE(0, 0, 3); LD_WRITE(0);
    LD_ISSUE(0, 1, 3); LD_WRITE(1);
    __syncthreads();
    bf16x8 qf[4];
    f32x16 o[2]; float m_run = NEGB, l_run = 0.f;
#pragma unroll
    for (int r = 0; r < 16; ++r) { o[0][r] = 0.f; o[1][r] = 0.f; }
    const size_t qoff = (size_t)(rowbase + tok) * 512 + myhead * 64 + 8 * hi;
#define ATT_TILE(Kt_, Vt_, kbase_, klo_, khi_, rflag_, fast_) do { \
        f32x16 p0, p1; \
        qk_tile(p0, p1, (Kt_), qf, r32, hi); \
        float mx_; \
        if (fast_) {     \
            float mr_ = fmaxf(p0[0], p1[0]); \
            _Pragma("unroll") for (int r = 1; r < 16; ++r) mr_ = fmaxf(mr_, fmaxf(p0[r], p1[r])); \
            mr_ = fmaxf(mr_, __shfl_xor(mr_, 32)); \
            mx_ = (rflag_) ? mr_ * C2S : NEGB; \
        } else mx_ = mask_scale(p0, p1, (kbase_), (klo_), (khi_), (rflag_), hi); \
        const float mnew_ = fmaxf(m_run, mx_); \
        const float alpha_ = ex2(m_run - mnew_); \
        const float msub_ = fmaxf(mnew_, -1e20f); \
        float ls_ = 0.f; \
        if (fast_) { const float nb_ = (rflag_) ? -msub_ : -1e30f; \
            _Pragma("unroll") for (int r = 0; r < 16; ++r) { p0[r] = ex2(fmaf(p0[r], C2S, nb_)); p1[r] = ex2(fmaf(p1[r], C2S, nb_)); ls_ += p0[r] + p1[r]; } } \
        else { _Pragma("unroll") for (int r = 0; r < 16; ++r) { p0[r] = ex2(p0[r] - msub_); p1[r] = ex2(p1[r] - msub_); ls_ += p0[r] + p1[r]; } } \
        l_run = l_run * alpha_ + ls_; m_run = mnew_; \
        if (!__all(alpha_ == 1.0f)) { \
            if (hi == 0) wsf[r32] = alpha_; \
            LDS_WAIT(); \
            _Pragma("unroll") for (int r = 0; r < 16; ++r) { const float a_ = wsf[crow(r, hi)]; o[0][r] *= a_; o[1][r] *= a_; } \
            LDS_WAIT(); \
        } \
        bf16x8 pa_[4]; \
        pack_p(pa_, p0, p1); \
        pv_tile(o, (Vt_), pa_, lane); } while (0)
#define FINALIZE(br) do { const float l_ = l_run + __shfl_xor(l_run, 32); const float inv_ = l_ > 0.f ? 1.f / l_ : 0.f; \
        if (hi == 0) wsf[r32] = inv_; LDS_WAIT(); \
        if (!SAMP || wg == 0) { \
        _Pragma("unroll") for (int r = 0; r < 16; ++r) { const int q = crow(r, hi); \
            if (!SAMP || q < 16) { const int tk = SAMP ? (q & 3) : q, hd = h * 4 + (SAMP ? (q >> 2) : wg); \
            const float f = wsf[q] * GT[tk * 24 + (br) * 8 + hd]; \
            _Pragma("unroll") for (int d0 = 0; d0 < 2; ++d0) { LAS unsigned short* p_ = OA + tk * 512 + hd * 64 + 32 * d0 + r32; \
                float v_ = o[d0][r] * f; if ((br) != 0) v_ += bf2f(*p_); *p_ = (unsigned short)(pk2(v_, 0.f) & 0xffffu); } } } } \
        LDS_WAIT(); } while (0)
    {
        const bf16* Qn = WSP(bf16, WS_QN);
#pragma unroll
        for (int d0 = 0; d0 < 4; ++d0) qf[d0] = *(const bf16x8*)(Qn + qoff + 16 * d0);
        const LAS unsigned char* K0 = lds + (2 * h) * 8192; const LAS unsigned char* V0 = K0 + 8192;
        const int khi = SAMP ? 126 : (qpos >= 31 ? ((qpos - 31) >> 4) : -1);
        ATT_TILE(K0, V0, 0, 0, khi, true, false);
        ATT_TILE(K0 + 32768, V0 + 32768, 64, 0, khi, true, false);
        const float l = l_run + __shfl_xor(l_run, 32);
        const float inv = l > 0.f ? 1.f / l : 0.f;
        const float msub = fmaxf(m_run, -1e20f);
#pragma unroll
        for (int tl = 0; tl < 2; ++tl) {
            f32x16 p0, p1;
            qk_tile(p0, p1, K0 + tl * 32768, qf, r32, hi);
            (void)mask_scale(p0, p1, 64 * tl, 0, khi, true, hi);
            if (!SAMP || (wg == 0 && r32 < 16)) {
                LAS float* ip = IMP + (h * 32 + tok) * 36;
#pragma unroll
                for (int half = 0; half < 2; ++half) {
#pragma unroll
                    for (int rq = 0; rq < 4; ++rq) {
                        const f32x16& X = half == 0 ? p0 : p1;
                        const float e0 = ex2(X[4 * rq] - msub), e1 = ex2(X[4 * rq + 1] - msub), e2 = ex2(X[4 * rq + 2] - msub), e3 = ex2(X[4 * rq + 3] - msub);
                        const float last = e3 * inv;
                        const float G = ((e0 + e1) + (e2 + e3)) * inv;
                        const int jj = 8 * (2 * tl + half) + 2 * rq + hi;
                        [[clang::atomic(ignore_denormal_mode)]] { (void)__hip_atomic_fetch_add(ip + jj, G, __ATOMIC_RELAXED, __HIP_MEMORY_SCOPE_WORKGROUP); (void)__hip_atomic_fetch_add(ip + jj + 1, last, __ATOMIC_RELAXED, __HIP_MEMORY_SCOPE_WORKGROUP); }
                    }
                }
            }
        }
        FINALIZE(0);
    }
    __syncthreads();
    {
        const bf16* Qr = WSP(bf16, WS_QR);
#pragma unroll
        for (int d0 = 0; d0 < 4; ++d0) qf[d0] = *(const bf16x8*)(Qr + qoff + 16 * d0);
        LD_ISSUE(1, 0, 3);
    }
    {
        const int nit = SAMP ? 1 : 4;
        for (int it = 0; it < nit; ++it) {
            const int tk = SAMP ? (hi + 2 * (w & 1)) : (wg * 8 + 2 * it + hi);
            const bool act = SAMP ? (wg < 2) : true;
            const int j = r32;
            const LAS float* ip = IMP + (h * 32 + tk) * 36;
            const float my = ip[j];
            const bool valid = j <= cur, forced = (j == 0) || (j == cur) || (j == cur - 1);
            const int nforced = cur == 0 ? 1 : (cur == 1 ? 2 : 3);
            const int quota = 16 - nforced;
            int cnt = 0;
            for (int i = 0; i < 32; ++i) { const float v = ip[i];
                const bool cand = (i <= cur) && !((i == 0) || (i == cur) || (i == cur - 1));
                cnt += (cand && (v > my || (v == my && i < j))) ? 1 : 0; }
            const bool selb = valid && (forced || cnt < quota);
            const unsigned long long bal = __ballot(selb);
            unsigned long long msk = hi ? (bal >> 32) : (bal & 0xffffffffull);
            if (SAMP) msk |= 1ull << 32;
            if (act && r32 == 0) SEL[h * 32 + tk] = msk;
        }
    }
    __syncthreads();
    const unsigned long long mysel = SEL[h * 32 + tok];
    unsigned long long U0 = 0ull, U1 = 0ull;
    if (SAMP) { for (int i = 0; i < NT; ++i) { U0 |= SEL[i]; U1 |= SEL[32 + i]; } }
    const unsigned long long Uall = SAMP ? (U0 | U1) : ((2ull << cur) - 1ull), Uh = SAMP ? (h ? U1 : U0) : ~0ull;
    const int wlo = SAMP ? 0 : ((q0 - 511) > 0 ? ((q0 - 511) >> 6) : 0), whi = SAMP ? 8 : ((q0 + 31) >> 6);
    int skind = 1; m_run = NEGB; l_run = 0.f;
#pragma unroll
    for (int r = 0; r < 16; ++r) { o[0][r] = 0.f; o[1][r] = 0.f; }
#define HM_OF(code) ((code) < 64 ? (SAMP ? (unsigned)(((U0 >> (code)) & 1ull) | (((U1 >> (code)) & 1ull) << 1)) : 3u) : 3u)
    int code = 0, st = 0;
    LD_WRITE(0);
    __syncthreads();
    for (;;) {
        int nxt;
        if (code < 64) { const unsigned long long mm = (code >= 63) ? 0ull : (Uall >> (code + 1)); nxt = mm ? code + 1 + __builtin_ctzll(mm) : 64 + wlo; if (nxt < 64 && nxt > cur) nxt = 64 + wlo; }
        else nxt = (code + 1 - 64 <= whi) ? code + 1 : -1;
        if (nxt >= 0) { const unsigned hm = HM_OF(nxt); if (nxt < 64) { LD_ISSUE(1, nxt, hm); } else { LD_ISSUE(2, nxt - 64, hm); } }
        {
            const int kind = code < 64 ? 1 : 2, j = code < 64 ? code : code - 64;
            if (kind != skind) { FINALIZE(1); m_run = NEGB; l_run = 0.f;
#pragma unroll
                for (int r = 0; r < 16; ++r) { o[0][r] = 0.f; o[1][r] = 0.f; }
                skind = kind; }
            const bool need = kind == 2 || ((Uh >> j) & 1ull);
            if (need) {
                const LAS unsigned char* Kt = lds + st * 32768 + (2 * h) * 8192; const LAS unsigned char* Vt = Kt + 8192;
                int kbase, klo, khi; bool rflag;
                if (kind == 1) { kbase = (SAMP && j == 32) ? SEQ : 64 * j; klo = -(1 << 30); khi = qpos; rflag = (mysel >> j) & 1ull; }
                else { kbase = SAMP ? (j < 8 ? 1536 + 64 * j : SEQ) : 64 * j; klo = qpos - 511; khi = qpos; rflag = true; }
                bool fast;
                if (kind == 1) fast = j < cur;
                else fast = SAMP ? (j >= 1 && j < 8) : (kbase >= q0 + 31 - 511 && kbase + 63 <= q0);
                ATT_TILE(Kt, Vt, kbase, klo, khi, rflag, fast);
            }
        }
        if (nxt >= 0) LD_WRITE(st ^ 1);
        __syncthreads();
        if (nxt < 0) break;
        code = nxt; st ^= 1;
    }
    FINALIZE(2);
#undef HM_OF
#undef FINALIZE
#undef ATT_TILE
#undef LD_ISSUE
#undef LD_WRITE
    __syncthreads();
    {
        bf16* MIX = WSP(bf16, WS_MIXED);
        const int ntk = SAMP ? (w < 4 ? 1 : 0) : 4;
        const f32x4 ga0 = *(const f32x4*)(F.in[14] + lane * 8), ga1 = *(const f32x4*)(F.in[14] + lane * 8 + 4);
        const f32x4 gr0 = *(const f32x4*)(F.in[15] + lane * 8), gr1 = *(const f32x4*)(F.in[15] + lane * 8 + 4);
        f32x4 c0 = (f32x4){0.f, 0.f, 0.f, 0.f}, c1 = c0;
        if (!SAMP) { const int cch = q0 >> 6; const float* sm = WSP(float, WS_SUMM) + (size_t)sq * 32 * 1024 + lane * 8;
#pragma unroll 4
            for (int cc = 0; cc < cch; ++cc) { const f32x4 h0 = *(const f32x4*)(sm + cc * 1024), h1 = *(const f32x4*)(sm + cc * 1024 + 4), a0 = *(const f32x4*)(sm + cc * 1024 + 512), a1 = *(const f32x4*)(sm + cc * 1024 + 516);
                c0 = a0 * c0 + h0; c1 = a1 * c1 + h1; } }
#pragma unroll
        for (int it = 0; it < (SAMP ? 1 : 4); ++it) { if (it >= ntk) break;
            const int tk = SAMP ? w : 4 * w + it; const size_t row = (size_t)rowbase + tk;
            { const v4u pk = *(const LAS v4u*)(lds + A_OA + tk * 1024 + lane * 16);
              float v[8] = {bflo(pk.x), bfhi(pk.x), bflo(pk.y), bfhi(pk.y), bflo(pk.z), bfhi(pk.z), bflo(pk.w), bfhi(pk.w)};
              float ss = 0.f;
#pragma unroll
              for (int i = 0; i < 8; ++i) ss += v[i] * v[i];
              const float rs = rsqrtf(wave_sum(ss) * (1.f / 512.f) + EPSN);
              v4u o; o.x = pk2(v[0] * rs * ga0[0], v[1] * rs * ga0[1]); o.y = pk2(v[2] * rs * ga0[2], v[3] * rs * ga0[3]); o.z = pk2(v[4] * rs * ga1[0], v[5] * rs * ga1[1]); o.w = pk2(v[6] * rs * ga1[2], v[7] * rs * ga1[3]);
              *(v4u*)(MIX + row * 1024 + lane * 8) = o; }
            { const float* hl = WSP(float, WS_HL) + row * 512 + lane * 8; const float* ac = WSP(float, WS_AC) + row * 512 + lane * 8;
              const f32x4 h0 = *(const f32x4*)hl + *(const f32x4*)ac * c0, h1 = *(const f32x4*)(hl + 4) + *(const f32x4*)(ac + 4) * c1;
              if (!SAMP && q0 + tk == SEQ - 1) { float* hp = F.out + O_HP + (size_t)sq * 512 + lane * 8; *(f32x4*)hp = h0; *(f32x4*)(hp + 4) = h1; }
              const v4u pk = *(const v4u*)(WSP(bf16, WS_GRG) + row * 512 + lane * 8);
              float v[8] = {bflo(pk.x) * h0[0], bfhi(pk.x) * h0[1], bflo(pk.y) * h0[2], bfhi(pk.y) * h0[3], bflo(pk.z) * h1[0], bfhi(pk.z) * h1[1], bflo(pk.w) * h1[2], bfhi(pk.w) * h1[3]};
              float ss = 0.f;
#pragma unroll
              for (int i = 0; i < 8; ++i) ss += v[i] * v[i];
              const float rs = rsqrtf(wave_sum(ss) * (1.f / 512.f) + EPSN);
              v4u o; o.x = pk2(v[0] * rs * gr0[0], v[1] * rs * gr0[1]); o.y = pk2(v[2] * rs * gr0[2], v[3] * rs * gr0[3]); o.z = pk2(v[4] * rs * gr1[0], v[5] * rs * gr1[1]); o.w = pk2(v[6] * rs * gr1[2], v[7] * rs * gr1[3]);
              *(v4u*)(MIX + row * 1024 + 512 + lane * 8) = o; }
        }
    }
    __syncthreads();
}

constexpr int P_OA = 98304, P_IMP = 131072, P_SEL = 140288, P_GT = 140800, P_WSF = 143872;
__device__ __forceinline__ void attn_unit_p(Frame& F, int sq, int qb) {
    int tid = F.tid; asm volatile("" : "+v"(tid));
    const int lane = tid & 63, w = F.wave, r32 = lane & 31, hi = lane >> 5, h = w >> 2, wg = w & 3;
    const int q0 = qb * 32, rowbase = sq * SEQ + q0, qpos = q0 + r32, cur = q0 >> 6;
    LAS unsigned char* lds = F.lds;
    LAS float* IMP = (LAS float*)(lds + P_IMP);
    LAS unsigned long long* SEL = (LAS unsigned long long*)(lds + P_SEL);
    LAS float* GT = (LAS float*)(lds + P_GT);
    LAS float* wsf = (LAS float*)(lds + P_WSF) + w * 64;
    LAS unsigned short* OA = (LAS unsigned short*)(lds + P_OA);
    const int drow = 8 * w + (lane >> 3);
    const int dsrc = drow * 128 + (((lane & 7) ^ (lane >> 3)) << 3);
    const bf16* kcc = WSP(bf16, WS_KCC) + (size_t)sq * 128 * 128 + dsrc; const bf16* vcc = WSP(bf16, WS_VCC) + (size_t)sq * 128 * 128 + dsrc;
    const bf16* ksb = WSP(bf16, WS_KS) + (size_t)sq * SEQ * 128 + dsrc; const bf16* vsb = WSP(bf16, WS_VS) + (size_t)sq * SEQ * 128 + dsrc;
    const bf16* kwb = WSP(bf16, WS_KW) + (size_t)sq * SEQ * 128 + dsrc; const bf16* vwb = WSP(bf16, WS_VW) + (size_t)sq * SEQ * 128 + dsrc;
#define DMA_TILE(kp_, vp_, j_, st_) do { const bf16* k_ = (kp_) + (size_t)(j_) * 8192; const bf16* v_ = (vp_) + (size_t)(j_) * 8192; LAS unsigned char* d_ = lds + (st_) * 32768 + w * 1024; \
        __builtin_amdgcn_global_load_lds((const unsigned*)k_, (LAS unsigned*)d_, 16, 0, 0); \
        __builtin_amdgcn_global_load_lds((const unsigned*)v_, (LAS unsigned*)(d_ + 8192), 16, 0, 0); \
        __builtin_amdgcn_global_load_lds((const unsigned*)(k_ + 64), (LAS unsigned*)(d_ + 16384), 16, 0, 0); \
        __builtin_amdgcn_global_load_lds((const unsigned*)(v_ + 64), (LAS unsigned*)(d_ + 24576), 16, 0, 0); } while (0)
#define DMA_CODE(code_, st_) do { if ((code_) < 64) DMA_TILE(ksb, vsb, (code_), (st_)); else DMA_TILE(kwb, vwb, (code_) - 64, (st_)); } while (0)
#define WAITV(n) asm volatile("s_waitcnt vmcnt(" #n ")" ::: "memory")
#define RAWBAR() do { asm volatile("s_waitcnt lgkmcnt(0)" ::: "memory"); __builtin_amdgcn_s_barrier(); asm volatile("" ::: "memory"); } while (0)
    for (int i = tid; i < 2 * 32 * 36; i += 512) IMP[i] = 0.f;
    for (int i = tid; i < 32 * 24; i += 512) GT[i] = WSP(float, WS_GATES)[(size_t)rowbase * 24 + i];
    DMA_TILE(kcc, vcc, 0, 0); DMA_TILE(kcc, vcc, 1, 1);
    bf16x8 qf[4];
    const size_t qoff = (size_t)(rowbase + r32) * 512 + (h * 4 + wg) * 64 + 8 * hi;
    { const bf16* Qn = WSP(bf16, WS_QN);
#pragma unroll
      for (int d0 = 0; d0 < 4; ++d0) qf[d0] = *(const bf16x8*)(Qn + qoff + 16 * d0); }
    WAITV(0); RAWBAR();
    f32x16 o[2]; float m_run = NEGB, l_run = 0.f;
#pragma unroll
    for (int r = 0; r < 16; ++r) { o[0][r] = 0.f; o[1][r] = 0.f; }
#define ATT_TILE(Kt_, Vt_, kbase_, klo_, khi_, rflag_, fast_) do { \
        f32x16 p0, p1; \
        qk_tile(p0, p1, (Kt_), qf, r32, hi); \
        float mx_; \
        if (fast_) { \
            float mr_ = fmaxf(p0[0], p1[0]); \
            _Pragma("unroll") for (int r = 1; r < 16; ++r) mr_ = fmaxf(mr_, fmaxf(p0[r], p1[r])); \
            mr_ = fmaxf(mr_, __shfl_xor(mr_, 32)); \
            mx_ = (rflag_) ? mr_ * C2S : NEGB; \
        } else mx_ = mask_scale(p0, p1, (kbase_), (klo_), (khi_), (rflag_), hi); \
        const float mnew_ = fmaxf(m_run, mx_); \
        const float alpha_ = ex2(m_run - mnew_); \
        const float msub_ = fmaxf(mnew_, -1e20f); \
        float ls_ = 0.f; \
        if (fast_) { const float nb_ = (rflag_) ? -msub_ : -1e30f; \
            _Pragma("unroll") for (int r = 0; r < 16; ++r) { p0[r] = ex2(fmaf(p0[r], C2S, nb_)); p1[r] = ex2(fmaf(p1[r], C2S, nb_)); ls_ += p0[r] + p1[r]; } } \
        else { _Pragma("unroll") for (int r = 0; r < 16; ++r) { p0[r] = ex2(p0[r] - msub_); p1[r] = ex2(p1[r] - msub_); ls_ += p0[r] + p1[r]; } } \
        l_run = l_run * alpha_ + ls_; m_run = mnew_; \
        if (!__all(alpha_ == 1.0f)) { \
            if (hi == 0) wsf[r32] = alpha_; \
            LDS_WAIT(); \
            _Pragma("unroll") for (int r = 0; r < 16; ++r) { const float a_ = wsf[crow(r, hi)]; o[0][r] *= a_; o[1][r] *= a_; } \
            LDS_WAIT(); \
        } \
        bf16x8 pa_[4]; \
        pack_p(pa_, p0, p1); \
        pv_tile(o, (Vt_), pa_, lane); } while (0)
#define FINALIZE(br) do { const float l_ = l_run + __shfl_xor(l_run, 32); const float inv_ = l_ > 0.f ? 1.f / l_ : 0.f; \
        if (hi == 0) wsf[r32] = inv_; LDS_WAIT(); \
        _Pragma("unroll") for (int r = 0; r < 16; ++r) { const int q = crow(r, hi); const int hd = h * 4 + wg; \
            const float f = wsf[q] * GT[q * 24 + (br) * 8 + hd]; \
            _Pragma("unroll") for (int d0 = 0; d0 < 2; ++d0) { LAS unsigned short* p_ = OA + q * 512 + hd * 64 + 32 * d0 + r32; \
                float v_ = o[d0][r] * f; if ((br) != 0) v_ += bf2f(*p_); *p_ = (unsigned short)(pk2(v_, 0.f) & 0xffffu); } } \
        LDS_WAIT(); } while (0)
#ifndef CMP_PASSES
#define CMP_PASSES 1
#endif
    for (int cpass = 0; cpass < CMP_PASSES; ++cpass) { m_run = NEGB; l_run = 0.f;
#pragma unroll
    for (int r = 0; r < 16; ++r) { o[0][r] = 0.f; o[1][r] = 0.f; }
    {
        const LAS unsigned char* K0 = lds + (2 * h) * 8192; const LAS unsigned char* V0 = K0 + 8192;
        const int khi = qpos >= 31 ? ((qpos - 31) >> 4) : -1;
        ATT_TILE(K0, V0, 0, 0, khi, true, false);
        ATT_TILE(K0 + 32768, V0 + 32768, 64, 0, khi, true, false);
        const float l = l_run + __shfl_xor(l_run, 32);
        const float inv = l > 0.f ? 1.f / l : 0.f;
        const float msub = fmaxf(m_run, -1e20f);
        float Gv[16], Lv[16];
#pragma unroll
        for (int tl = 0; tl < 2; ++tl) {
            f32x16 p0, p1;
            qk_tile(p0, p1, K0 + tl * 32768, qf, r32, hi);
            (void)mask_scale(p0, p1, 64 * tl, 0, khi, true, hi);
#pragma unroll
            for (int half = 0; half < 2; ++half) {
#pragma unroll
                for (int rq = 0; rq < 4; ++rq) {
                    const f32x16& X = half == 0 ? p0 : p1;
                    const float e0 = ex2(X[4 * rq] - msub), e1 = ex2(X[4 * rq + 1] - msub), e2 = ex2(X[4 * rq + 2] - msub), e3 = ex2(X[4 * rq + 3] - msub);
                    Lv[4 * (2 * tl + half) + rq] = e3 * inv;
                    Gv[4 * (2 * tl + half) + rq] = ((e0 + e1) + (e2 + e3)) * inv;
                }
            }
        }
        {
            LAS float* R = (LAS float*)(lds + 65536) + (h * 4 + wg) * 1024 + r32;
            float prev = 0.f;
#pragma unroll
            for (int jl = 0; jl < 16; ++jl) {
                const float pl = __shfl_xor(Lv[jl], 32);
                const float add = hi ? pl : prev;
                R[(2 * jl + hi) * 32] = Gv[jl] + add;
                prev = pl;
            }
        }
        FINALIZE(0);
    }
    }
    RAWBAR();
    const int wlo = (q0 - 511) > 0 ? ((q0 - 511) >> 6) : 0, whi = (q0 + 31) >> 6;
#define NEXT_CODE(c_) ((c_) < 0 ? -1 : ((c_) < 64 ? ((c_) < cur ? (c_) + 1 : 64 + wlo) : ((c_) - 64 < whi ? (c_) + 1 : -1)))
    int code = 0, n1 = NEXT_CODE(0), n2;
    DMA_CODE(0, 0);
    DMA_CODE(n1, 1);
    {   const bf16* Qr = WSP(bf16, WS_QR);
#pragma unroll
        for (int d0 = 0; d0 < 4; ++d0) qf[d0] = *(const bf16x8*)(Qr + qoff + 16 * d0); }
    {   const int tk = tid & 31, jg = (tid >> 5) & 7, hh = tid >> 8;
        const LAS float* R = (const LAS float*)(lds + 65536) + hh * 4096 + tk;
#pragma unroll
        for (int k = 0; k < 4; ++k) { const int j = 4 * jg + k;
            IMP[(hh * 32 + tk) * 36 + j] = (R[j * 32] + R[1024 + j * 32]) + (R[2048 + j * 32] + R[3072 + j * 32]); } }
    RAWBAR();
    for (int it = 0; it < 4; ++it) {
        const int tk = wg * 8 + 2 * it + hi, j = r32;
        const LAS float* ip = IMP + (h * 32 + tk) * 36;
        const float my = ip[j];
        const bool valid = j <= cur, forced = (j == 0) || (j == cur) || (j == cur - 1);
        const int quota = 16 - (cur == 0 ? 1 : (cur == 1 ? 2 : 3));
        int cnt = 0;
        for (int i = 0; i < 32; ++i) { const float v = ip[i];
            const bool cand = (i <= cur) && !((i == 0) || (i == cur) || (i == cur - 1));
            cnt += (cand && (v > my || (v == my && i < j))) ? 1 : 0; }
        const bool selb = valid && (forced || cnt < quota);
        const unsigned long long bal = __ballot(selb);
        if (r32 == 0) SEL[h * 32 + tk] = hi ? (bal >> 32) : (bal & 0xffffffffull);
    }
    WAITV(4); RAWBAR();
    const unsigned mysel = (unsigned)SEL[h * 32 + r32];
#ifndef LOOP_PASSES
#define LOOP_PASSES 1
#endif
    for (int pass = 0; pass < LOOP_PASSES; ++pass) {
    if (pass > 0) { code = 0; n1 = NEXT_CODE(0); DMA_CODE(0, 0); DMA_CODE(n1, 1); WAITV(4); RAWBAR(); }
    int skind = 1, st = 0; m_run = NEGB; l_run = 0.f;
#pragma unroll
    for (int r = 0; r < 16; ++r) { o[0][r] = 0.f; o[1][r] = 0.f; }
    for (;;) {
        n2 = NEXT_CODE(n1);
        const int st2 = st >= 1 ? st - 1 : 2;
        if (n2 >= 0) DMA_CODE(n2, st2);
        {
            const int kind = code < 64 ? 1 : 2, j = code < 64 ? code : code - 64;
            if (kind != skind) { if (pass == LOOP_PASSES - 1) FINALIZE(1); m_run = NEGB; l_run = 0.f;
#pragma unroll
                for (int r = 0; r < 16; ++r) { o[0][r] = 0.f; o[1][r] = 0.f; }
                skind = kind; }
            const LAS unsigned char* Kt = lds + st * 32768 + (2 * h) * 8192; const LAS unsigned char* Vt = Kt + 8192;
            const int kbase = 64 * j, khi = qpos;
            int klo; bool rflag, fast;
            if (kind == 1) { klo = -(1 << 30); rflag = (mysel >> j) & 1u; fast = j < cur; }
            else { klo = qpos - 511; rflag = true; fast = (kbase >= q0 + 31 - 511 && kbase + 63 <= q0); }
            ATT_TILE(Kt, Vt, kbase, klo, khi, rflag, fast);
        }
        if (n1 < 0) break;
        if (n2 >= 0) WAITV(4); else WAITV(0);
        RAWBAR();
        code = n1; n1 = n2; st = st == 2 ? 0 : st + 1;
    }
    if (pass == LOOP_PASSES - 1) FINALIZE(2);
    RAWBAR();
    }
#undef NEXT_CODE
#undef FINALIZE
#undef ATT_TILE
#undef DMA_CODE
#undef DMA_TILE
    RAWBAR();
#ifndef NORM_PASSES
#define NORM_PASSES 1
#endif
    for (int npass = 0; npass < NORM_PASSES; ++npass) {
        bf16* MIX = WSP(bf16, WS_MIXED);
        const f32x4 ga0 = *(const f32x4*)(F.in[14] + lane * 8), ga1 = *(const f32x4*)(F.in[14] + lane * 8 + 4);
        const f32x4 gr0 = *(const f32x4*)(F.in[15] + lane * 8), gr1 = *(const f32x4*)(F.in[15] + lane * 8 + 4);
        f32x4 c0 = (f32x4){0.f, 0.f, 0.f, 0.f}, c1 = c0;
        { const float* cr = WSP(float, WS_CARRY) + ((size_t)sq * 32 + cur) * 512 + lane * 8; c0 = *(const f32x4*)cr; c1 = *(const f32x4*)(cr + 4); }
#pragma unroll
        for (int it = 0; it < 4; ++it) {
            const int tk = 4 * w + it; const size_t row = (size_t)rowbase + tk;
            { const v4u pk = *(const LAS v4u*)(lds + P_OA + tk * 1024 + lane * 16);
              float v[8] = {bflo(pk.x), bfhi(pk.x), bflo(pk.y), bfhi(pk.y), bflo(pk.z), bfhi(pk.z), bflo(pk.w), bfhi(pk.w)};
              float ss = 0.f;
#pragma unroll
              for (int i = 0; i < 8; ++i) ss += v[i] * v[i];
              const float rs = rsqrtf(wave_sum(ss) * (1.f / 512.f) + EPSN);
              v4u ov; ov.x = pk2(v[0] * rs * ga0[0], v[1] * rs * ga0[1]); ov.y = pk2(v[2] * rs * ga0[2], v[3] * rs * ga0[3]); ov.z = pk2(v[4] * rs * ga1[0], v[5] * rs * ga1[1]); ov.w = pk2(v[6] * rs * ga1[2], v[7] * rs * ga1[3]);
              *(v4u*)(MIX + row * 1024 + lane * 8) = ov; }
            { const float* hl = WSP(float, WS_HL) + row * 512 + lane * 8; const float* ac = WSP(float, WS_AC) + row * 512 + lane * 8;
              const f32x4 h0 = *(const f32x4*)hl + *(const f32x4*)ac * c0, h1 = *(const f32x4*)(hl + 4) + *(const f32x4*)(ac + 4) * c1;
              if (q0 + tk == SEQ - 1) { float* hp = F.out + O_HP + (size_t)sq * 512 + lane * 8; *(f32x4*)hp = h0; *(f32x4*)(hp + 4) = h1; }
              const v4u pk = *(const v4u*)(WSP(bf16, WS_GRG) + row * 512 + lane * 8);
              float v[8] = {bflo(pk.x) * h0[0], bfhi(pk.x) * h0[1], bflo(pk.y) * h0[2], bfhi(pk.y) * h0[3], bflo(pk.z) * h1[0], bfhi(pk.z) * h1[1], bflo(pk.w) * h1[2], bfhi(pk.w) * h1[3]};
              float ss = 0.f;
#pragma unroll
              for (int i = 0; i < 8; ++i) ss += v[i] * v[i];
              const float rs = rsqrtf(wave_sum(ss) * (1.f / 512.f) + EPSN);
              v4u ov; ov.x = pk2(v[0] * rs * gr0[0], v[1] * rs * gr0[1]); ov.y = pk2(v[2] * rs * gr0[2], v[3] * rs * gr0[3]); ov.z = pk2(v[4] * rs * gr1[0], v[5] * rs * gr1[1]); ov.w = pk2(v[6] * rs * gr1[2], v[7] * rs * gr1[3]);
              *(v4u*)(MIX + row * 1024 + 512 + lane * 8) = ov; }
        }
    }
    WAITV(0); RAWBAR();
#undef WAITV
#undef RAWBAR
}

constexpr int S_PART = 65536, S_IMPG = 117760, S_IMPL = 118336, S_SEL = 118912, S_GT = 118960, S_WSF = 119344, S_OA = 121664;
__device__ __forceinline__ void attn_unit_s(Frame& F, int s, int h) {
    int tid = F.tid; asm volatile("" : "+v"(tid));
    const int lane = tid & 63, w = F.wave, r32 = lane & 31, hi = lane >> 5, grp = w >> 2;
    const bool cw = (w & 3) == 0;
    const int tok = r32 & 3, g = (r32 >> 2) & 3, qpos = SEQ + tok;
    LAS unsigned char* lds = F.lds;
    LAS float* IMPG = (LAS float*)(lds + S_IMPG); LAS float* IMPL = (LAS float*)(lds + S_IMPL);
    LAS unsigned long long* SEL = (LAS unsigned long long*)(lds + S_SEL);
    LAS float* GT = (LAS float*)(lds + S_GT);
    LAS float* wsf = (LAS float*)(lds + S_WSF) + w * 64;
    LAS float* OA = (LAS float*)(lds + S_OA);
    const int lrow = tid >> 3, lch = tid & 7, lwo = lrow * 128 + ((lch ^ (lrow & 7)) << 4);
    const float* cache = F.in[2]; const float* cwin = F.in[3]; const int* pt = F.page_table + s * 16;
    const int colo = h * 64 + lch * 8;
    v4u rb[4]; f32x4 rf[8]; unsigned fmask = 0, ldm = 0; int cpA = -1, cpB = -1;
#define S_ISSUE1(mi_, code_) do { const int isV_ = (mi_) & 1; const int c_ = (code_); \
        if (c_ >= 0) { ldm |= 1u << (mi_); \
            if (c_ >= 100) { rb[mi_] = *(const v4u*)((isV_ ? WSP(bf16, WS_VCC) : WSP(bf16, WS_KCC)) + ((size_t)((8 + s) * 128 + 64 * (c_ - 100) + lrow)) * 128 + colo); } \
            else if (c_ < 32) { fmask |= 1u << (mi_); const float* s_ = cache + ((size_t)pt[c_ >> 1] * 128 + (c_ & 1) * 64 + lrow) * 512 + (2 + isV_) * 128 + colo; \
                rf[2 * (mi_)] = *(const f32x4*)s_; rf[2 * (mi_) + 1] = *(const f32x4*)(s_ + 4); } \
            else if (c_ == 32) { rb[mi_] = (v4u){0u, 0u, 0u, 0u}; if (lrow < 4) rb[mi_] = *(const v4u*)((isV_ ? WSP(bf16, WS_VS) : WSP(bf16, WS_KS)) + ((size_t)(MP + 4 * s + lrow)) * 128 + colo); } \
            else if (c_ < 72) { fmask |= 1u << (mi_); const float* s_ = cwin + ((size_t)(s * 512 + 64 * (c_ - 64) + lrow)) * 256 + isV_ * 128 + colo; \
                rf[2 * (mi_)] = *(const f32x4*)s_; rf[2 * (mi_) + 1] = *(const f32x4*)(s_ + 4); } \
            else { rb[mi_] = (v4u){0u, 0u, 0u, 0u}; if (lrow < 4) rb[mi_] = *(const v4u*)((isV_ ? WSP(bf16, WS_VW) : WSP(bf16, WS_KW)) + ((size_t)(MP + 4 * s + lrow)) * 128 + colo); } \
        } } while (0)
#define S_ISSUE(cA_, cB_) do { fmask = 0; ldm = 0; cpA = ((cA_) >= 64 && (cA_) < 72) ? (cA_) - 64 : -1; cpB = ((cB_) >= 64 && (cB_) < 72) ? (cB_) - 64 : -1; \
        S_ISSUE1(0, (cA_)); S_ISSUE1(1, (cA_)); S_ISSUE1(2, (cB_)); S_ISSUE1(3, (cB_)); } while (0)
#define S_WRITE(st_) do { _Pragma("unroll") for (int mi = 0; mi < 4; ++mi) { if (!((ldm >> mi) & 1u)) continue; v4u v_ = rb[mi]; \
            if ((fmask >> mi) & 1u) { v_.x = pk2(rf[2 * mi][0], rf[2 * mi][1]); v_.y = pk2(rf[2 * mi][2], rf[2 * mi][3]); v_.z = pk2(rf[2 * mi + 1][0], rf[2 * mi + 1][1]); v_.w = pk2(rf[2 * mi + 1][2], rf[2 * mi + 1][3]); \
                const int cp_ = mi < 2 ? cpA : cpB; \
                if (cp_ >= 0) { const int jr_ = 64 * cp_ + lrow; if (jr_ >= 4) { float* d_ = F.out + O_WINS + ((size_t)(s * 512 + jr_ - 4)) * 256 + (mi & 1) * 128 + colo; *(f32x4*)d_ = rf[2 * mi]; *(f32x4*)(d_ + 4) = rf[2 * mi + 1]; } } } \
            *(LAS v4u*)(lds + (st_) * 32768 + mi * 8192 + lwo) = v_; } } while (0)
    if (tid < 96) GT[tid] = WSP(float, WS_GATES)[(size_t)(MP + 4 * s) * 24 + tid];
    if (tid < 4 * 36) { IMPG[tid] = 0.f; IMPL[tid] = 0.f; }
    S_ISSUE(100, 101); S_WRITE(0);
    bf16x8 qf[4];
    const size_t qoff = (size_t)(MP + 4 * s + tok) * 512 + (h * 4 + g) * 64 + 8 * hi;
    { const bf16* Qn = WSP(bf16, WS_QN);
#pragma unroll
      for (int d0 = 0; d0 < 4; ++d0) qf[d0] = *(const bf16x8*)(Qn + qoff + 16 * d0); }
    __syncthreads();
    f32x16 o[2]; float m_run = NEGB, l_run = 0.f;
#pragma unroll
    for (int r = 0; r < 16; ++r) { o[0][r] = 0.f; o[1][r] = 0.f; }
#define ATT_TILE(Kt_, Vt_, kbase_, klo_, khi_, rflag_, fast_) do { \
        f32x16 p0, p1; \
        qk_tile(p0, p1, (Kt_), qf, r32, hi); \
        float mx_; \
        if (fast_) { \
            float mr_ = fmaxf(p0[0], p1[0]); \
            _Pragma("unroll") for (int r = 1; r < 16; ++r) mr_ = fmaxf(mr_, fmaxf(p0[r], p1[r])); \
            mr_ = fmaxf(mr_, __shfl_xor(mr_, 32)); \
            mx_ = (rflag_) ? mr_ * C2S : NEGB; \
        } else mx_ = mask_scale(p0, p1, (kbase_), (klo_), (khi_), (rflag_), hi); \
        const float mnew_ = fmaxf(m_run, mx_); \
        const float alpha_ = ex2(m_run - mnew_); \
        const float msub_ = fmaxf(mnew_, -1e20f); \
        float ls_ = 0.f; \
        if (fast_) { const float nb_ = (rflag_) ? -msub_ : -1e30f; \
            _Pragma("unroll") for (int r = 0; r < 16; ++r) { p0[r] = ex2(fmaf(p0[r], C2S, nb_)); p1[r] = ex2(fmaf(p1[r], C2S, nb_)); ls_ += p0[r] + p1[r]; } } \
        else { _Pragma("unroll") for (int r = 0; r < 16; ++r) { p0[r] = ex2(p0[r] - msub_); p1[r] = ex2(p1[r] - msub_); ls_ += p0[r] + p1[r]; } } \
        l_run = l_run * alpha_ + ls_; m_run = mnew_; \
        if (!__all(alpha_ == 1.0f)) { \
            if (hi == 0) wsf[r32] = alpha_; \
            LDS_WAIT(); \
            _Pragma("unroll") for (int r = 0; r < 16; ++r) { const float a_ = wsf[crow(r, hi)]; o[0][r] *= a_; o[1][r] *= a_; } \
            LDS_WAIT(); \
        } \
        bf16x8 pa_[4]; \
        pack_p(pa_, p0, p1); \
        pv_tile(o, (Vt_), pa_, lane); } while (0)
#define PUT_PART(br) do { if (cw) { LAS float* P_ = (LAS float*)(lds + S_PART) + ((br) * 2 + grp) * 2176; \
        _Pragma("unroll") for (int d0 = 0; d0 < 2; ++d0) _Pragma("unroll") for (int r = 0; r < 16; ++r) P_[(d0 * 16 + r) * 64 + lane] = o[d0][r]; \
        P_[2048 + lane] = m_run; P_[2112 + lane] = l_run + __shfl_xor(l_run, 32); } } while (0)
    const LAS unsigned char* Kg = lds + (2 * grp) * 8192;
    if (cw) { ATT_TILE(Kg, Kg + 8192, 64 * grp, 0, 126, true, false); }
    PUT_PART(0);
    __syncthreads();
    {
        const LAS float* PA = (const LAS float*)(lds + S_PART); const LAS float* PB = PA + 2176;
        const float mA = PA[2048 + lane], mB = PB[2048 + lane], mm = fmaxf(mA, mB);
        const float ll = PA[2112 + lane] * ex2(mA - mm) + PB[2112 + lane] * ex2(mB - mm);
        const float inv = ll > 0.f ? 1.f / ll : 0.f, msub = fmaxf(mm, -1e20f);
        if (cw) {
            f32x16 p0, p1;
            qk_tile(p0, p1, Kg, qf, r32, hi);
            (void)mask_scale(p0, p1, 64 * grp, 0, 126, true, hi);
#pragma unroll
            for (int half = 0; half < 2; ++half)
#pragma unroll
                for (int rq = 0; rq < 4; ++rq) {
                    const f32x16& X = half == 0 ? p0 : p1;
                    const float e0 = ex2(X[4 * rq] - msub), e1 = ex2(X[4 * rq + 1] - msub), e2 = ex2(X[4 * rq + 2] - msub), e3 = ex2(X[4 * rq + 3] - msub);
                    float Lq = e3 * inv, Gq = ((e0 + e1) + (e2 + e3)) * inv;
                    Lq += __shfl_xor(Lq, 4); Lq += __shfl_xor(Lq, 8); Gq += __shfl_xor(Gq, 4); Gq += __shfl_xor(Gq, 8);
                    const int jj = 16 * grp + 8 * half + 2 * rq + hi;
                    if (r32 < 4) { IMPG[tok * 36 + jj] = Gq; IMPL[tok * 36 + jj + 1] = Lq; }
                }
        }
    }
    __syncthreads();
    if (w == 0) {
#pragma unroll
        for (int it = 0; it < 2; ++it) {
            const int tk = 2 * it + hi, j = r32;
            const float my = IMPG[tk * 36 + j] + IMPL[tk * 36 + j];
            int cnt = 0;
            for (int i = 1; i < 31; ++i) { const float v = IMPG[tk * 36 + i] + IMPL[tk * 36 + i]; cnt += (v > my || (v == my && i < j)) ? 1 : 0; }
            const bool selb = (j == 0) || (j == 31) || cnt < 13;
            const unsigned long long bal = __ballot(selb);
            if (r32 == 0) SEL[tk] = (hi ? (bal >> 32) : (bal & 0xffffffffull)) | (1ull << 32);
        }
    }
    __syncthreads();
    const unsigned long long mysel = SEL[tok];
    unsigned long long rem = SEL[0] | SEL[1] | SEL[2] | SEL[3];
    { const bf16* Qr = WSP(bf16, WS_QR);
#pragma unroll
      for (int d0 = 0; d0 < 4; ++d0) qf[d0] = *(const bf16x8*)(Qr + qoff + 16 * d0); }
    m_run = NEGB; l_run = 0.f;
#pragma unroll
    for (int r = 0; r < 16; ++r) { o[0][r] = 0.f; o[1][r] = 0.f; }
#define NEXT_PAIR(cA_, cB_) do { if (rem) { cA_ = __builtin_ctzll(rem); rem &= rem - 1; if (rem) { cB_ = __builtin_ctzll(rem); rem &= rem - 1; } else cB_ = -1; } \
        else if (wnext <= 72) { cA_ = wnext; cB_ = wnext + 1 <= 72 ? wnext + 1 : -1; wnext += 2; } else { cA_ = -1; cB_ = -1; } } while (0)
    int wnext = 64, cA, cB, nA, nB, st = 0;
    NEXT_PAIR(cA, cB);
    S_ISSUE(cA, cB); S_WRITE(0);
    __syncthreads();
    for (;;) {
        NEXT_PAIR(nA, nB);
        if (nA >= 0) S_ISSUE(nA, nB);
        {
            const int code = grp ? cB : cA;
            if (cw && code >= 0) {
                const LAS unsigned char* Kt = lds + st * 32768 + (2 * grp) * 8192;
                int kbase, klo; bool rflag, fast;
                if (code < 64) { kbase = code == 32 ? SEQ : 64 * code; klo = -(1 << 30); rflag = (mysel >> code) & 1ull; fast = code < 32; }
                else { const int j = code - 64; kbase = j < 8 ? 1536 + 64 * j : SEQ; klo = qpos - 511; rflag = true; fast = (j >= 1 && j < 8); }
                ATT_TILE(Kt, Kt + 8192, kbase, klo, qpos, rflag, fast);
            }
        }
        if (cA < 64 && (nA >= 64 || nA < 0)) { PUT_PART(1); m_run = NEGB; l_run = 0.f;
#pragma unroll
            for (int r = 0; r < 16; ++r) { o[0][r] = 0.f; o[1][r] = 0.f; } }
        if (nA >= 0) S_WRITE(st ^ 1);
        __syncthreads();
        if (nA < 0) break;
        cA = nA; cB = nB; st ^= 1;
    }
    PUT_PART(2);
#undef NEXT_PAIR
#undef PUT_PART
#undef ATT_TILE
#undef S_WRITE
#undef S_ISSUE
#undef S_ISSUE1
    __syncthreads();
    if (w == 0) {
        float oc[2][16];
#pragma unroll
        for (int r = 0; r < 16; ++r) { oc[0][r] = 0.f; oc[1][r] = 0.f; }
#pragma unroll
        for (int br = 0; br < 3; ++br) {
            const LAS float* PA = (const LAS float*)(lds + S_PART) + (br * 2) * 2176; const LAS float* PB = PA + 2176;
            const float mA = PA[2048 + lane], mB = PB[2048 + lane], mm = fmaxf(mA, mB);
            const float fA = ex2(mA - mm), fB = ex2(mB - mm);
            const float ll = PA[2112 + lane] * fA + PB[2112 + lane] * fB;
            const float inv = ll > 0.f ? 1.f / ll : 0.f;
            if (hi == 0) { wsf[r32] = fA * inv; wsf[32 + r32] = fB * inv; }
            LDS_WAIT();
#pragma unroll
            for (int r = 0; r < 16; ++r) { const int q = crow(r, hi);
                const float ga = wsf[q], gb = wsf[32 + q], gt = GT[(q & 3) * 24 + br * 8 + h * 4 + ((q >> 2) & 3)];
#pragma unroll
                for (int d0 = 0; d0 < 2; ++d0) oc[d0][r] += (PA[(d0 * 16 + r) * 64 + lane] * ga + PB[(d0 * 16 + r) * 64 + lane] * gb) * gt; }
            LDS_WAIT();
        }
#pragma unroll
        for (int r = 0; r < 16; ++r) { const int q = crow(r, hi);
            if (q < 16) { OA[(q & 3) * 256 + (q >> 2) * 64 + r32] = oc[0][r]; OA[(q & 3) * 256 + (q >> 2) * 64 + 32 + r32] = oc[1][r]; } }
    }
    __syncthreads();
    if (w < 4) {
        const size_t row = (size_t)MP + 4 * s + w;
        const f32x4 v = *(const LAS f32x4*)(OA + w * 256 + lane * 4);
        const f32x4 ga = *(const f32x4*)(F.in[14] + h * 256 + lane * 4);
        const float ss = wave_sum((v[0] * v[0] + v[1] * v[1]) + (v[2] * v[2] + v[3] * v[3]));
        if (lane == 0) WSP(float, WS_SSA)[(4 * s + w) * 2 + h] = ss;
        v2u ov; ov.x = pk2(v[0] * ga[0], v[1] * ga[1]); ov.y = pk2(v[2] * ga[2], v[3] * ga[3]);
        *(v2u*)(WSP(bf16, WS_MIXED) + row * 1024 + h * 256 + lane * 4) = ov;
    } else if (h == 0) {
        const size_t row = (size_t)MP + 4 * s + (w - 4);
        const f32x4 gr0 = *(const f32x4*)(F.in[15] + lane * 8), gr1 = *(const f32x4*)(F.in[15] + lane * 8 + 4);
        const float* hl = WSP(float, WS_HL) + row * 512 + lane * 8;
        const f32x4 h0 = *(const f32x4*)hl, h1 = *(const f32x4*)(hl + 4);
        const v4u pk = *(const v4u*)(WSP(bf16, WS_GRG) + row * 512 + lane * 8);
        float v[8] = {bflo(pk.x) * h0[0], bfhi(pk.x) * h0[1], bflo(pk.y) * h0[2], bfhi(pk.y) * h0[3], bflo(pk.z) * h1[0], bfhi(pk.z) * h1[1], bflo(pk.w) * h1[2], bfhi(pk.w) * h1[3]};
        float ss = 0.f;
#pragma unroll
        for (int i = 0; i < 8; ++i) ss += v[i] * v[i];
        const float rs = rsqrtf(wave_sum(ss) * (1.f / 512.f) + EPSN);
        v4u ov; ov.x = pk2(v[0] * rs * gr0[0], v[1] * rs * gr0[1]); ov.y = pk2(v[2] * rs * gr0[2], v[3] * rs * gr0[3]); ov.z = pk2(v[4] * rs * gr1[0], v[5] * rs * gr1[1]); ov.w = pk2(v[6] * rs * gr1[2], v[7] * rs * gr1[3]);
        *(v4u*)(WSP(bf16, WS_MIXED) + row * 1024 + 512 + lane * 8) = ov;
    }
    __syncthreads();
}

template <int MODE>
__device__ __forceinline__ void skinny_piece(Frame& F, int pc) {
    constexpr int K = MODE == 2 ? FF : DM, N = MODE == 1 ? FF : DM, NTN = N / 32, KW = K / 8;
    int tid = F.tid; asm volatile("" : "+v"(tid));
    const int lane = tid & 63, w = F.wave, fr = lane & 15, fq = lane >> 4;
    const bf16* A = MODE == 0 ? WSP(bf16, WS_MIXED) : (MODE == 1 ? WSP(bf16, WS_XN) : WSP(bf16, WS_H));
    const bf16* Bt = MODE == 0 ? WSP(bf16, WS_WOUT) : (MODE == 1 ? WSP(bf16, WS_WUP) : WSP(bf16, WS_WDN));
    const int rt = pc / NTN, ct = pc % NTN, row0 = MP + 64 * rt, col0 = 32 * ct;
    f32x4 acc[4][2];
#pragma unroll
    for (int m = 0; m < 4; ++m) { acc[m][0] = (f32x4){0.f, 0.f, 0.f, 0.f}; acc[m][1] = acc[m][0]; }
    const bf16* ap = A + (size_t)(row0 + fr) * K + w * KW + 8 * fq;
    const bf16* bp = Bt + (size_t)(col0 + fr) * K + w * KW + 8 * fq;
#pragma unroll 4
    for (int ks = 0; ks < KW / 32; ++ks) {
        bf16x8 af[4], bf[2];
#pragma unroll
        for (int m = 0; m < 4; ++m) af[m] = *(const bf16x8*)(ap + (size_t)(16 * m) * K + 32 * ks);
#pragma unroll
        for (int n = 0; n < 2; ++n) bf[n] = *(const bf16x8*)(bp + (size_t)(16 * n) * K + 32 * ks);
#pragma unroll
        for (int m = 0; m < 4; ++m)
#pragma unroll
            for (int n = 0; n < 2; ++n) acc[m][n] = __builtin_amdgcn_mfma_f32_16x16x32_bf16(bf[n], af[m], acc[m][n], 0, 0, 0);
    }
    if (MODE == 0 && w < 4) {
        const float* ssa = WSP(float, WS_SSA) + (size_t)(row0 - MP + fr) * 2;
#pragma unroll
        for (int m = 0; m < 4; ++m) { const float rs = rsqrtf((ssa[32 * m] + ssa[32 * m + 1]) * (1.f / 512.f) + EPSN); acc[m][0] *= rs; acc[m][1] *= rs; }
    }
    LAS float* red = (LAS float*)F.lds;
#pragma unroll
    for (int m = 0; m < 4; ++m)
#pragma unroll
        for (int n = 0; n < 2; ++n) *(LAS f32x4*)(red + w * 2048 + (16 * m + fr) * 32 + 16 * n + 4 * fq) = acc[m][n];
    __syncthreads();
    const int r = tid >> 3, c4 = (tid & 7) * 4;
    f32x4 v = (f32x4){0.f, 0.f, 0.f, 0.f};
#pragma unroll
    for (int ww = 0; ww < 8; ++ww) v += *(const LAS f32x4*)(red + ww * 2048 + r * 32 + c4);
    const int row = row0 + r, col = col0 + c4;
    if (MODE == 0) {
        const f32x4 x1 = *(const f32x4*)(F.in[1] + (size_t)(row - MP) * DM + col) + v;
        *(f32x4*)(WSP(float, WS_X1) + (size_t)row * DM + col) = x1;
        v2u p; p.x = pk2(x1[0], x1[1]); p.y = pk2(x1[2], x1[3]);
        *(v2u*)(WSP(bf16, WS_XN) + (size_t)row * DM + col) = p;
        float ss = (x1[0] * x1[0] + x1[1] * x1[1]) + (x1[2] * x1[2] + x1[3] * x1[3]);
        ss += __shfl_xor(ss, 1); ss += __shfl_xor(ss, 2); ss += __shfl_xor(ss, 4);
        if ((tid & 7) == 0) atomicAdd((float*)(F.ws + WS_CTL + CTL_SS1) + row, ss);
    } else if (MODE == 1) {
        const float rs = rsqrtf(((const float*)(F.ws + WS_CTL + CTL_SS1))[row] * (1.0f / DM) + EPSN);
        f32x4 hv;
#pragma unroll
        for (int e = 0; e < 4; ++e) { const float a = fmaxf(v[e] * rs, 0.f); hv[e] = a * a; }
        v2u p; p.x = pk2(hv[0], hv[1]); p.y = pk2(hv[2], hv[3]);
        *(v2u*)(WSP(bf16, WS_H) + (size_t)row * FF + col) = p;
    } else {
        const f32x4 x2 = *(const f32x4*)(WSP(float, WS_X1) + (size_t)row * DM + col) + v;
        *(f32x4*)(F.out + (size_t)row * DM + col) = x2;
    }
    __syncthreads();
}

#ifndef MK_N_LAUNCHES
#define MK_N_LAUNCHES 1
#endif
constexpr int N_PHASES = 8;
struct Args { const float* in[29]; float* out; unsigned char* ws; int ph_lo, ph_hi; };
__global__ void __launch_bounds__(NWAVES * 64, 2) nsa_fwd(Args args) {
    extern __shared__ __attribute__((aligned(16))) unsigned char lds[];
    Frame F;
    F.lds = (LAS unsigned char*)lds;
    F.tid = threadIdx.x; F.lane = F.tid & 63; F.wave = __builtin_amdgcn_readfirstlane(F.tid >> 6);
    F.G = gridDim.x; { const int bx = blockIdx.x; F.vcu = (F.G % 8 == 0) ? (bx % 8) * (F.G / 8) + bx / 8 : bx; }
    F.in = args.in;
    F.page_table = (const int*)args.in[6];
    F.out = args.out; F.ws = args.ws; F.ctl = (gu32*)(args.ws + WS_CTL);
    volatile LAS unsigned* MISC = (volatile LAS unsigned*)(F.lds + MISC_OFF);
    for (int u = F.tid; u < (LDS_BYTES - RING_BYTES) / 4; u += NWAVES * 64) ((LAS unsigned*)(F.lds + RING_BYTES))[u] = 0u;
    __syncthreads();
    XcdBarrier bar; bar.bar = (unsigned*)(F.ctl + CW_BAR); bar.x = 0; bar.st = nullptr;
    if (MK_N_LAUNCHES == 1) bar = xcd_barrier_post((unsigned*)(F.ctl + CW_BAR), MISC + 8);
    const int lo = args.ph_lo, hi = args.ph_hi;
#ifndef PHASE_MASK
#define PHASE_MASK 0xFF
#endif
#define IN(k) (((PHASE_MASK >> (k)) & 1) && lo <= (k) && (k) < hi)
#ifndef REPEAT_MASK
#define REPEAT_MASK 0
#endif
#define NREP(k) (1 + ((REPEAT_MASK >> (k)) & 1))
#define REPSEAM(k, rep) do { if ((rep) + 1 < NREP(k)) { xcd_barrier(bar); FRESH(); } } while (0)
#define SEAM(k) do { if (IN(k) && IN((k) + 1)) xcd_barrier(bar); FRESH(); } while (0)
#define FRESH() do { int t_ = threadIdx.x; asm volatile("" : "+v"(t_)); F.tid = t_; F.lane = t_ & 63; F.wave = __builtin_amdgcn_readfirstlane(t_ >> 6); } while (0)
    if (IN(0)) { p0_prologue(F); }
    SEAM(0);
    if (IN(1)) for (int rep = 0; rep < NREP(1); ++rep) {
        pg8::Gemm g{WSP(bf16, WS_XN), WSP(bf16, WS_WIN), MT, NIN, DM}; pg8::StaticOrder S; S.init(MT, NIN, F.G, (int)blockIdx.x);
        pg8::EpiProj E{WSP(bf16, WS_QN), WSP(bf16, WS_QR), WSP(bf16, WS_KS), WSP(bf16, WS_VS), WSP(bf16, WS_KW), WSP(bf16, WS_VW), WSP(bf16, WS_GRG), WSP(float, WS_GATES), WSP(float, WS_RX), F.out, WSP(float, WS_ROT)};
        pg8::gemm_phase<pg8::EpiProj, pg8::StaticOrder, true, true>(F.lds, g, S, E);
        REPSEAM(1, rep);
    }
    SEAM(1);
    if (IN(2)) for (int rep = 0; rep < NREP(2); ++rep) {
        for (;;) {
            if (F.tid == 0) MISC[0] = __hip_atomic_fetch_add((unsigned*)(F.ctl + CW_Q2 + 256 * rep), 1u, RLX_AGENT);
            __syncthreads();
            const int id = (int)MISC[0];
            __syncthreads();
            if (id >= 264 + 544) break;
            if (id < 264) { rnn_unit(F, id); __syncthreads(); } else compress_unit(F, id - 264);
        }
        REPSEAM(2, rep);
    }
    SEAM(2);
#ifndef REP_P3S
#define REP_P3S 1
#endif
#ifndef REP_P3P
#define REP_P3P 1
#endif
    if (IN(3)) for (int rep = 0; rep < NREP(3); ++rep) {
        for (int r2 = 0; r2 < REP_P3S; ++r2)
        for (;;) {
            if (F.tid == 0) MISC[0] = __hip_atomic_fetch_add((unsigned*)(F.ctl + CW_Q3 + 256 * rep + 512 * r2), 1u, RLX_AGENT);
            __syncthreads();
            const int id = (int)MISC[0];
            __syncthreads();
            if (id >= 256) break;
            attn_unit_s(F, id >> 1, id & 1);
        }
        for (int r2 = 0; r2 < REP_P3P; ++r2)
        for (;;) {
            if (F.tid == 0) MISC[0] = __hip_atomic_fetch_add((unsigned*)(F.ctl + CW_Q3 + 64 + 256 * rep + 512 * r2), 1u, RLX_AGENT);
            __syncthreads();
            const int k = (int)MISC[0];
            __syncthreads();
            if (k >= 512) break;
            attn_unit_p(F, k & 7, 63 - (k >> 3));
        }
        REPSEAM(3, rep);
    }
    SEAM(3);
    if (IN(4)) for (int rep = 0; rep < NREP(4); ++rep) {
        pg8::Gemm g{WSP(bf16, WS_MIXED), WSP(bf16, WS_WOUT), MP, DM, DM}; pg8::StaticOrder S; S.init(MP, DM, F.G, (int)blockIdx.x);
        pg8::EpiOut E{F.in[0], F.in[1], WSP(float, WS_X1), WSP(bf16, WS_XN), (float*)(F.ws + WS_CTL + (rep ? CTL_DUMMY : CTL_SS1))};
        pg8::gemm_phase<pg8::EpiOut, pg8::StaticOrder, true, true>(F.lds, g, S, E);
        if (rep == 0) for (int pc = blockIdx.x; pc < 8 * (DM / 32); pc += F.G) skinny_piece<0>(F, pc);
        REPSEAM(4, rep);
    }
    SEAM(4);
    if (IN(5)) for (int rep = 0; rep < NREP(5); ++rep) {
        pg8::Gemm g{WSP(bf16, WS_XN), WSP(bf16, WS_WUP), MP, FF, DM}; pg8::StaticOrder S; S.init(MP, FF, F.G, (int)blockIdx.x);
        pg8::EpiUp E{WSP(bf16, WS_H), (const float*)(F.ws + WS_CTL + CTL_SS1)};
        pg8::gemm_phase<pg8::EpiUp, pg8::StaticOrder, true, true>(F.lds, g, S, E);
        for (int pc = blockIdx.x; pc < 8 * (FF / 32); pc += F.G) skinny_piece<1>(F, pc);
        REPSEAM(5, rep);
    }
    SEAM(5);
    if (IN(6)) for (int rep = 0; rep < NREP(6); ++rep) {
        pg8::Gemm g{WSP(bf16, WS_H), WSP(bf16, WS_WDN), MP, DM, FF}; pg8::StaticOrder S; S.init(MP, DM, F.G, (int)blockIdx.x);
        pg8::EpiDown E{WSP(float, WS_X1), F.out};
        pg8::gemm_phase<pg8::EpiDown, pg8::StaticOrder, true, true>(F.lds, g, S, E);
        for (int pc = blockIdx.x; pc < 8 * (DM / 32); pc += F.G) skinny_piece<2>(F, pc);
        REPSEAM(6, rep);
    }
    SEAM(6);
    if (IN(7)) p7_final(F);
#undef IN
#undef SEAM
#undef REPSEAM
#undef NREP
#undef FRESH
}

extern "C" void kernel_launch(void* const* d_in, const int* in_sizes, int n_in, void* d_out, int out_size, void* d_ws, size_t ws_size, hipStream_t stream) {
    static int grid = 0;
    if (grid == 0) {
        if (n_in != 29 || out_size != 44056576 || ws_size < WS_END) { fprintf(stderr, "kernel_launch: unexpected sizes (n_in %d, out %d, ws %zu)\n", n_in, out_size, ws_size); grid = -1; return; }
        int dev = 0, cus = 0, per_cu = 0;
        if (hipGetDevice(&dev) != hipSuccess || hipDeviceGetAttribute(&cus, hipDeviceAttributeMultiprocessorCount, dev) != hipSuccess) { grid = -1; return; }
        if (hipFuncSetAttribute((const void*)nsa_fwd, hipFuncAttributeMaxDynamicSharedMemorySize, LDS_BYTES) != hipSuccess) { fprintf(stderr, "kernel_launch: hipFuncSetAttribute failed\n"); grid = -1; return; }
        if (hipOccupancyMaxActiveBlocksPerMultiprocessor(&per_cu, (const void*)nsa_fwd, NWAVES * 64, LDS_BYTES) != hipSuccess || per_cu < 1) fprintf(stderr, "kernel_launch: occupancy query reports %d\n", per_cu);
        (void)hipGetLastError();
        grid = cus;
    }
    if (grid < 0) return;
    if (hipMemsetAsync((char*)d_ws + WS_CTL, 0, CTL_ZERO_BYTES, stream) != hipSuccess) return;
    Args a{};
    for (int i = 0; i < 29; ++i) a.in[i] = (const float*)d_in[i];
    a.out = (float*)d_out; a.ws = (unsigned char*)d_ws;
#if MK_N_LAUNCHES == 1
    a.ph_lo = 0; a.ph_hi = N_PHASES;
    hipLaunchKernelGGL(nsa_fwd, dim3(grid), dim3(NWAVES * 64), LDS_BYTES, stream, a);
#else
    for (int p = 0; p < N_PHASES; ++p) { a.ph_lo = p; a.ph_hi = p + 1; hipLaunchKernelGGL(nsa_fwd, dim3(grid), dim3(NWAVES * 64), LDS_BYTES, stream, a); }
#endif
}
```

```cpp
#include <hip/hip_runtime.h>
#include <cstdio>
#include <cstdint>

constexpr int DM = 1024, NB = 8, SEQ = 2048, NS = 128, DT = 4;
constexpr int MP = NB * SEQ, MS = NS * DT, MT = MP + MS;
constexpr int NIN = 2560, FF = 4096;
constexpr float EPSN = 1e-6f;
constexpr size_t O_YP = 0, O_KV = 17301504, O_WINP = 25952256, O_WINS = 27000832, O_CONVP = 43778048, O_CONVS = 43790336, O_HP = 43986944, O_HS = 43991040;

namespace pg8 {
#define PG8_LAS __attribute__((address_space(3)))
typedef unsigned short bf16_t;
typedef short bf16x8 __attribute__((ext_vector_type(8)));
typedef float f32x4 __attribute__((ext_vector_type(4)));
typedef unsigned u32x4 __attribute__((ext_vector_type(4)));
constexpr int BM = 256, BK = 64, HALF = 128, HTB = HALF * BK * 2  , STAGE_BYTES = 8 * HTB, NXCD = 8, WGM = 8;

__host__ __device__ __forceinline__ int lds_byte(int r, int c) { const int st = (r >> 4) * 2 + (c >> 5), rr = r & 15, cc = c & 31, ob = rr * 64 + cc * 2; return st * 1024 + (ob ^ (((ob >> 9) & 1) << 5)); }
__host__ __device__ __forceinline__ void stage_rc(int b, int& R, int& C) { const int st = b / 1024, sb = b % 1024, swz = sb ^ (((sb >> 9) & 1) << 5); R = (st >> 1) * 16 + swz / 64; C = (st & 1) * 32 + (swz % 64) / 2; }
__host__ __device__ __forceinline__ int perm32(int rho) { const int n = rho >> 4, i = rho & 15; return 8 * (i >> 2) + 4 * n + (i & 3); }

struct Unit { int pm, pn; };
struct Gemm { const bf16_t* A; const bf16_t* Bt; int M, N, K; };

struct StaticOrder {
    int nM, nN, nwg, G, c;
    __host__ __device__ void init(int M, int N, int G_, int c_) { nM = M / BM; nN = N / BM; nwg = nM * nN; G = G_; c = c_; }
    __host__ __device__ bool next(int i, Unit& u) const {
        const long L = (long)i * G + c; if (L >= nwg) return false;
        int wgid = (int)L; { const int q = nwg / NXCD, r = nwg % NXCD, xcd = wgid % NXCD, off = wgid / NXCD; wgid = (xcd < r ? xcd * (q + 1) : r * (q + 1) + (xcd - r) * q) + off; }
        const int nig = WGM * nN, gid = wgid / nig, fm = gid * WGM, gsz = (nM - fm) < WGM ? (nM - fm) : WGM;
        u.pm = fm + ((wgid % nig) % gsz); u.pn = (wgid % nig) / gsz; return true;
    }
    __device__ __forceinline__ void a_ready(const Unit&) const {}
    __device__ __forceinline__ void done(const Unit&) const {}
};

__device__ __forceinline__ unsigned cvt_pk_bf16(float lo, float hi) { unsigned r; asm volatile("v_cvt_pk_bf16_f32 %0, %1, %2" : "=v"(r) : "v"(lo), "v"(hi)); return r; }
typedef unsigned u32x2 __attribute__((ext_vector_type(2)));
typedef float f32x2 __attribute__((ext_vector_type(2)));
__device__ __forceinline__ float gelu_tanh(float x) {
    const float y = 1.5957691216f * (x + 0.044715f * x * x * x);
    return x / (1.0f + __expf(-y));
}
__device__ __forceinline__ float sigmoidf_(float x) { return 1.0f / (1.0f + __expf(-x)); }
__device__ __forceinline__ u32x2 pack4(f32x4 v) { u32x2 w; w.x = cvt_pk_bf16(v[0], v[1]); w.y = cvt_pk_bf16(v[2], v[3]); return w; }

struct EpiProj {
    static constexpr bool PERM = false, AFTER_DRAIN = false;
    bf16_t *Qn, *Qr, *KS, *VS, *KW, *VW, *GRG; float *GATES, *RX, *out; const float* rot;
    __device__ __forceinline__ f32x4 rotate(f32x4 v, int pos, int fq) const {
        const float* tb = rot + pos * 16 + (fq & 1) * 4;
        const f32x4 cs = *(const f32x4*)tb, sn = *(const f32x4*)(tb + 8);
        f32x4 pr;
#pragma unroll
        for (int e = 0; e < 4; ++e) pr[e] = __shfl_xor(v[e], 32);
        const float sg = fq < 2 ? -1.f : 1.f;
        f32x4 w;
#pragma unroll
        for (int e = 0; e < 4; ++e) w[e] = v[e] * cs[e] + sg * pr[e] * sn[e];
        return w;
    }
    __device__ __forceinline__ void operator()(const f32x4 (&acc)[2][2][4][2], const Unit& u, int wr, int wc, int fr, int fq) const {
        asm volatile("" : "+v"(fr), "+v"(fq));
        const int pn = u.pn;
        const bool rotw = (wc & 1) == 0;
#pragma unroll
        for (int ai = 0; ai < 2; ++ai)
#pragma unroll
            for (int m = 0; m < 4; ++m) {
                const int row = u.pm * BM + ai * HALF + wr * 64 + m * 16 + fr;
                const bool samp = row >= MP;
                int t, pos, sq;
                if (!samp) { t = row & (SEQ - 1); pos = t; sq = row >> 11; } else { t = (row - MP) & 3; pos = SEQ + t; sq = (row - MP) >> 2; }
#pragma unroll
                for (int bj = 0; bj < 2; ++bj)
#pragma unroll
                    for (int n = 0; n < 2; ++n) {
                        const f32x4 v = acc[ai][bj][m][n];
                        const int cc = bj * HALF + wc * 32 + n * 16 + fq * 4;
                        if (pn < 2) {
                            const size_t o = (size_t)row * 512 + pn * 256 + cc;
                            *(u32x2*)(Qn + o) = pack4(v);
                            f32x4 w = v; if (n == 0 && rotw) w = rotate(v, pos, fq);
                            *(u32x2*)(Qr + o) = pack4(w);
                        } else if (pn == 2) {
                            *(f32x4*)(out + O_KV + (size_t)row * 512 + cc) = v;
                        } else if (pn == 3) {
                            f32x4 w = v; if (bj == 0 && n == 0 && rotw) w = rotate(v, pos, fq);
                            *(f32x4*)(out + O_KV + (size_t)row * 512 + 256 + cc) = w;
                            bf16_t* dst = (bj == 0 ? KS : VS) + (size_t)row * 128 + (cc & 127);
                            *(u32x2*)dst = pack4(w);
                        } else if (pn == 4) {
                            f32x4 w = v; if (bj == 0 && n == 0 && rotw) w = rotate(v, pos, fq);
                            bf16_t* dst = (bj == 0 ? KW : VW) + (size_t)row * 128 + (cc & 127);
                            *(u32x2*)dst = pack4(w);
                            if (!samp) { if (t >= SEQ - 512) *(f32x4*)(out + O_WINP + ((size_t)sq * 512 + (t - (SEQ - 512))) * 256 + cc) = w; }
                            else *(f32x4*)(out + O_WINS + ((size_t)sq * 512 + 508 + t) * 256 + cc) = w;
                        } else if (pn < 7) {
                            f32x4 g;
#pragma unroll
                            for (int e = 0; e < 4; ++e) g[e] = gelu_tanh(v[e]);
                            *(u32x2*)(GRG + (size_t)row * 512 + (pn - 5) * 256 + cc) = pack4(g);
                        } else if (pn < 9) {
                            const int c2 = (pn - 7) * 256 + cc;
                            *(f32x4*)(RX + (size_t)row * 512 + c2) = v;
                            if (!samp) { if (t >= SEQ - 3) *(f32x4*)(out + O_CONVP + ((size_t)sq * 3 + (t - (SEQ - 3))) * 512 + c2) = v; }
                            else if (t >= 1) *(f32x4*)(out + O_CONVS + ((size_t)sq * 3 + (t - 1)) * 512 + c2) = v;
                        } else {
                            if (cc < 24) { f32x4 g;
#pragma unroll
                                for (int e = 0; e < 4; ++e) g[e] = sigmoidf_(v[e]);
                                *(f32x4*)(GATES + (size_t)row * 24 + cc) = g; }
                        }
                    }
                asm volatile("" ::: "memory");
            }
    }
};

struct EpiOut {
    static constexpr bool PERM = false, AFTER_DRAIN = false;
    const float *xp, *xs; float* X1; bf16_t* XN; float* SS;
    __device__ __forceinline__ void operator()(const f32x4 (&acc)[2][2][4][2], const Unit& u, int wr, int wc, int fr, int fq) const {
#pragma unroll
        for (int ai = 0; ai < 2; ++ai)
#pragma unroll
            for (int m = 0; m < 4; ++m) {
                const int row = u.pm * BM + ai * HALF + wr * 64 + m * 16 + fr;
                const float* xr = row < MP ? xp + (size_t)row * DM : xs + (size_t)(row - MP) * DM;
                float ss = 0.f;
#pragma unroll
                for (int bj = 0; bj < 2; ++bj)
#pragma unroll
                    for (int n = 0; n < 2; ++n) {
                        const int c = u.pn * BM + bj * HALF + wc * 32 + n * 16 + fq * 4;
                        const f32x4 v = *(const f32x4*)(xr + c) + acc[ai][bj][m][n];
                        *(f32x4*)(X1 + (size_t)row * DM + c) = v;
                        *(u32x2*)(XN + (size_t)row * DM + c) = pack4(v);
                        ss += (v[0] * v[0] + v[1] * v[1]) + (v[2] * v[2] + v[3] * v[3]);
                    }
                ss += __shfl_xor(ss, 16); ss += __shfl_xor(ss, 32);
                if (fq == 0) atomicAdd(SS + row, ss);
            }
    }
};
struct EpiUp {
    static constexpr bool PERM = true, AFTER_DRAIN = false;
    bf16_t* H; const float* SS;
    __device__ __forceinline__ void operator()(const f32x4 (&acc)[2][2][4][2], const Unit& u, int wr, int wc, int fr, int fq) const {
#pragma unroll
        for (int ai = 0; ai < 2; ++ai)
#pragma unroll
            for (int m = 0; m < 4; ++m) {
                const int row = u.pm * BM + ai * HALF + wr * 64 + m * 16 + fr;
                const float rs = rsqrtf(SS[row] * (1.0f / DM) + EPSN);
#pragma unroll
                for (int bj = 0; bj < 2; ++bj) {
                    f32x4 v0 = acc[ai][bj][m][0] * rs, v1 = acc[ai][bj][m][1] * rs;
#pragma unroll
                    for (int e = 0; e < 4; ++e) { const float a = fmaxf(v0[e], 0.f), b = fmaxf(v1[e], 0.f); v0[e] = a * a; v1[e] = b * b; }
                    u32x4 w; w.x = cvt_pk_bf16(v0[0], v0[1]); w.y = cvt_pk_bf16(v0[2], v0[3]); w.z = cvt_pk_bf16(v1[0], v1[1]); w.w = cvt_pk_bf16(v1[2], v1[3]);
                    *(u32x4*)(H + (size_t)row * FF + u.pn * BM + bj * HALF + wc * 32 + 8 * fq) = w;
                }
            }
    }
};
struct EpiDown {
    static constexpr bool PERM = false, AFTER_DRAIN = false;
    const float* X1; float* Y;
    __device__ __forceinline__ void operator()(const f32x4 (&acc)[2][2][4][2], const Unit& u, int wr, int wc, int fr, int fq) const {
#pragma unroll
        for (int ai = 0; ai < 2; ++ai)
#pragma unroll
            for (int m = 0; m < 4; ++m) {
                const int row = u.pm * BM + ai * HALF + wr * 64 + m * 16 + fr;
#pragma unroll
                for (int bj = 0; bj < 2; ++bj)
#pragma unroll
                    for (int n = 0; n < 2; ++n) {
                        const int c = u.pn * BM + bj * HALF + wc * 32 + n * 16 + fq * 4;
                        *(f32x4*)(Y + (size_t)row * DM + c) = *(const f32x4*)(X1 + (size_t)row * DM + c) + acc[ai][bj][m][n];
                    }
            }
    }
};

template <class Epi, class Sched, bool ALIGN_EPI = false, bool SP2 = false>
__device__ __forceinline__ void gemm_phase(PG8_LAS unsigned char* lds, const Gemm g, const Sched& S, const Epi& E) {
    const int tid = threadIdx.x, wid = __builtin_amdgcn_readfirstlane(tid >> 6), lane = tid & 63, wr = wid >> 2, wc = wid & 3, fr = lane & 15, fq = lane >> 4;
    const int K = g.K, nt = K / BK;
    unsigned voffA[2], voffB[2];
#pragma unroll
    for (int i = 0; i < 2; ++i) { int R, C; stage_rc(tid * 16 + i * 8192, R, C); const int Rb = Epi::PERM ? ((R & ~31) + perm32(R & 31)) : R;
        voffA[i] = (unsigned)(R * K + C) * 2u; voffB[i] = (unsigned)(Rb * K + C) * 2u; }
    const size_t kstep = (size_t)(BK * 2);
    const size_t hstep = (size_t)HALF * K * 2;
    const size_t tstep = 2 * hstep;
    const unsigned ldsw = (unsigned)wid * 1024u;
    const int aoff = lds_byte(wr * 64 + fr, fq * 8), boff = lds_byte(wc * 32 + fr, fq * 8);
#define PG8_SA(b, h) (((b) * 2 + (h)) * HTB)
#define PG8_SB(b, h) ((4 + (b) * 2 + (h)) * HTB)
#define PG8_STAGE(bufoff, gbase, voff) do { _Pragma("unroll") for (int _i = 0; _i < 2; ++_i) \
        __builtin_amdgcn_global_load_lds((const unsigned*)((const char*)(gbase) + (voff)[_i]), (PG8_LAS unsigned*)(lds + (bufoff) + ldsw + _i * 8192), 16, 0, 0); } while (0)
#define PG8_LDA(dst, b, h) do { _Pragma("unroll") for (int m = 0; m < 4; ++m) _Pragma("unroll") for (int k = 0; k < 2; ++k) dst[m][k] = *(const PG8_LAS bf16x8*)(lds + PG8_SA(b, h) + aoff + m * 2048 + k * 1024); } while (0)
#define PG8_LDB(dst, b, h) do { _Pragma("unroll") for (int n = 0; n < 2; ++n) _Pragma("unroll") for (int k = 0; k < 2; ++k) dst[n][k] = *(const PG8_LAS bf16x8*)(lds + PG8_SB(b, h) + boff + n * 2048 + k * 1024); } while (0)
#define PG8_MMA(ai, bj, At, Bt) do { __builtin_amdgcn_s_setprio(1); _Pragma("unroll") for (int m = 0; m < 4; ++m) _Pragma("unroll") for (int n = 0; n < 2; ++n) _Pragma("unroll") for (int k = 0; k < 2; ++k) \
        acc[ai][bj][m][n] = __builtin_amdgcn_mfma_f32_16x16x32_bf16(Bt[n][k], At[m][k], acc[ai][bj][m][n], 0, 0, 0); __builtin_amdgcn_s_setprio(0); } while (0)
#define PG8_WAIT_V(n) asm volatile("s_waitcnt vmcnt(" #n ")" ::: "memory")
#define PG8_WAIT_L(n) asm volatile("s_waitcnt lgkmcnt(" #n ")" ::: "memory")
#define PG8_BAR __builtin_amdgcn_s_barrier()
#define PG8_SCHED __builtin_amdgcn_sched_barrier(0)
    Unit cur, nxt; int ui = 0;
    if (!S.next(0, cur)) return;
    f32x4 acc[2][2][4][2];
#pragma unroll
    for (int a = 0; a < 2; ++a)
#pragma unroll
        for (int b = 0; b < 2; ++b)
#pragma unroll
            for (int m = 0; m < 4; ++m)
#pragma unroll
                for (int n = 0; n < 2; ++n) acc[a][b][m][n] = (f32x4){0.f, 0.f, 0.f, 0.f};
    bf16x8 At[4][2], B0[2][2], B1[2][2];
    const char* cA = (const char*)g.A + (size_t)cur.pm * tstep; const char* cB = (const char*)g.Bt + (size_t)cur.pn * tstep;
    S.a_ready(cur);
    if constexpr (SP2) {
        PG8_STAGE(PG8_SB(0, 0), cB, voffB); PG8_STAGE(PG8_SB(0, 1), cB + hstep, voffB); PG8_STAGE(PG8_SA(0, 0), cA, voffA); PG8_STAGE(PG8_SA(0, 1), cA + hstep, voffA);
        if (wr == 1) PG8_BAR;
        PG8_WAIT_V(2); PG8_BAR;
        PG8_STAGE(PG8_SB(1, 0), cB + kstep, voffB); PG8_STAGE(PG8_SA(1, 0), cA + kstep, voffA); PG8_STAGE(PG8_SB(1, 1), cB + hstep + kstep, voffB);
        PG8_WAIT_V(6); PG8_BAR;
    } else {
        PG8_STAGE(PG8_SB(0, 0), cB, voffB); PG8_STAGE(PG8_SA(0, 0), cA, voffA); PG8_STAGE(PG8_SB(0, 1), cB + hstep, voffB); PG8_STAGE(PG8_SA(0, 1), cA + hstep, voffA);
        if (wr == 1) PG8_BAR;
        PG8_WAIT_V(4); PG8_BAR;
        PG8_STAGE(PG8_SB(1, 0), cB + kstep, voffB); PG8_STAGE(PG8_SA(1, 0), cA + kstep, voffA); PG8_STAGE(PG8_SB(1, 1), cB + hstep + kstep, voffB);
        PG8_WAIT_V(6); PG8_BAR;
    }
    for (;;) {
        const bool has_next = S.next(ui + 1, nxt);
        const char* nA = has_next ? (const char*)g.A + (size_t)nxt.pm * tstep : cA; const char* nB = has_next ? (const char*)g.Bt + (size_t)nxt.pn * tstep : cB;
        for (int t = 0; t < nt; t += 2) {
            const bool last = (t == nt - 2);
            const char* a1 = cA + (size_t)(t + 1) * kstep;
            const char* a2 = last ? nA : cA + (size_t)(t + 2) * kstep; const char* b2 = last ? nB : cB + (size_t)(t + 2) * kstep;
            const char* a3 = a2 + kstep; const char* b3 = b2 + kstep;
            if (last && has_next) S.a_ready(nxt);
            if constexpr (SP2) {
            PG8_LDB(B0, 0, 0); PG8_LDB(B1, 0, 1); PG8_SCHED; PG8_LDA(At, 0, 0); PG8_STAGE(PG8_SA(1, 1), a1 + hstep, voffA);
            PG8_WAIT_V(8); PG8_WAIT_L(0); PG8_BAR; PG8_MMA(0, 0, At, B0); PG8_MMA(0, 1, At, B1); PG8_BAR; PG8_SCHED;
            PG8_LDA(At, 0, 1); PG8_STAGE(PG8_SB(0, 0), b2, voffB); PG8_STAGE(PG8_SB(0, 1), b2 + hstep, voffB); PG8_STAGE(PG8_SA(0, 0), a2, voffA);
            PG8_WAIT_V(8); PG8_WAIT_L(0); PG8_BAR; PG8_MMA(1, 0, At, B0); PG8_MMA(1, 1, At, B1); PG8_BAR; PG8_SCHED;
            PG8_LDB(B0, 1, 0); PG8_LDB(B1, 1, 1); PG8_SCHED; PG8_LDA(At, 1, 0); PG8_STAGE(PG8_SA(0, 1), a2 + hstep, voffA);
            PG8_WAIT_V(8); PG8_WAIT_L(0); PG8_BAR; PG8_MMA(0, 0, At, B0); PG8_MMA(0, 1, At, B1); PG8_BAR; PG8_SCHED;
            PG8_LDA(At, 1, 1); PG8_STAGE(PG8_SB(1, 0), b3, voffB); PG8_STAGE(PG8_SB(1, 1), b3 + hstep, voffB); PG8_STAGE(PG8_SA(1, 0), a3, voffA);
            PG8_WAIT_V(8); PG8_WAIT_L(0); PG8_BAR; PG8_MMA(1, 0, At, B0); PG8_MMA(1, 1, At, B1); PG8_BAR; PG8_SCHED;
            } else {
            PG8_LDB(B0, 0, 0); PG8_SCHED; PG8_LDA(At, 0, 0); PG8_STAGE(PG8_SA(1, 1), a1 + hstep, voffA);
            PG8_WAIT_L(8); PG8_BAR; PG8_WAIT_L(0); PG8_MMA(0, 0, At, B0); PG8_BAR; PG8_SCHED;
            PG8_LDB(B1, 0, 1); PG8_STAGE(PG8_SB(0, 0), b2, voffB);
            PG8_BAR; PG8_WAIT_L(0); PG8_MMA(0, 1, At, B1); PG8_BAR;
            PG8_LDA(At, 0, 1); PG8_STAGE(PG8_SA(0, 0), a2, voffA);
            PG8_BAR; PG8_WAIT_L(0); PG8_MMA(1, 0, At, B0); PG8_BAR; PG8_SCHED;
            PG8_STAGE(PG8_SB(0, 1), b2 + hstep, voffB);
            PG8_WAIT_V(6); PG8_BAR; PG8_MMA(1, 1, At, B1); PG8_BAR;
            PG8_LDB(B0, 1, 0); PG8_SCHED; PG8_LDA(At, 1, 0); PG8_STAGE(PG8_SA(0, 1), a2 + hstep, voffA);
            PG8_WAIT_L(8); PG8_BAR; PG8_WAIT_L(0); PG8_MMA(0, 0, At, B0); PG8_BAR; PG8_SCHED;
            PG8_LDB(B1, 1, 1); PG8_STAGE(PG8_SB(1, 0), b3, voffB);
            PG8_BAR; PG8_WAIT_L(0); PG8_MMA(0, 1, At, B1); PG8_BAR;
            PG8_LDA(At, 1, 1); PG8_STAGE(PG8_SA(1, 0), a3, voffA);
            PG8_BAR; PG8_WAIT_L(0); PG8_MMA(1, 0, At, B0); PG8_BAR; PG8_SCHED;
            PG8_STAGE(PG8_SB(1, 1), b3 + hstep, voffB);
            PG8_WAIT_V(6); PG8_BAR; PG8_MMA(1, 1, At, B1); PG8_BAR;
            }
        }
        if constexpr (ALIGN_EPI) { if (wr == 0) PG8_BAR; }
        if constexpr (!Epi::AFTER_DRAIN) { E(acc, cur, wr, wc, fr, fq); S.done(cur); }
        if (!has_next) break;
#pragma unroll
        for (int a = 0; a < 2; ++a)
#pragma unroll
            for (int b = 0; b < 2; ++b)
#pragma unroll
                for (int m = 0; m < 4; ++m)
#pragma unroll
                    for (int n = 0; n < 2; ++n) acc[a][b][m][n] = (f32x4){0.f, 0.f, 0.f, 0.f};
        cur = nxt; cA = nA; cB = nB; ++ui;
        if constexpr (ALIGN_EPI) { if (wr == 1) PG8_BAR; }
    }
    PG8_WAIT_V(0);
    if constexpr (!ALIGN_EPI) { if (wr == 0) PG8_BAR; }
    PG8_BAR;
    if constexpr (Epi::AFTER_DRAIN) { E.fused(acc, cur, wr, wc, fr, fq, lds, wid, lane); S.done(cur); }
#undef PG8_SA
#undef PG8_SB
#undef PG8_STAGE
#undef PG8_LDA
#undef PG8_LDB
#undef PG8_MMA
#undef PG8_WAIT_V
#undef PG8_WAIT_L
#undef PG8_BAR
#undef PG8_SCHED
}
}
constexpr size_t MiB = 1u << 20;
constexpr size_t WS_CTL = 0, CTL_ZERO_BYTES = 1 * MiB;
constexpr int CW_BAR = 4096;
constexpr int CW_RNN = 12288;
constexpr int CW_STAMP = 16384;
constexpr int CW_Q2 = 8192, CW_Q3 = 8192 + 64;
constexpr size_t CTL_SS1 = 256 * 1024, CTL_SS2 = 384 * 1024, CTL_B1 = 640 * 1024, CTL_DUMMY = 768 * 1024;
constexpr size_t WS_ROT = 1 * MiB;
constexpr size_t WS_WC1 = 2 * MiB;
constexpr size_t WS_WC2 = WS_WC1 + 512 * 1024;
constexpr size_t WS_B1 = WS_WC2 + 32 * 1024;
constexpr size_t WS_WR = WS_B1 + 32 * 1024;
constexpr size_t WS_WIN = 4 * MiB, WS_WOUT = 10 * MiB, WS_WUP = 12 * MiB, WS_WDN = 20 * MiB;
constexpr size_t WS_XN = 32 * MiB;
constexpr size_t WS_QN = 66 * MiB, WS_QR = 83 * MiB;
constexpr size_t WS_KS = 100 * MiB, WS_VS = 105 * MiB, WS_KW = 110 * MiB, WS_VW = 115 * MiB;
constexpr size_t WS_GATES = 120 * MiB;
constexpr size_t WS_GRG = 122 * MiB;
constexpr size_t WS_RX = 139 * MiB;
constexpr size_t WS_HL = 172 * MiB, WS_AC = 205 * MiB;
constexpr size_t WS_CARRY = 239 * MiB;
constexpr size_t WS_SSA = 239 * MiB + 512 * 1024;
constexpr size_t WS_SUMM = 238 * MiB;
constexpr size_t WS_KCC = 240 * MiB, WS_VCC = 245 * MiB;
constexpr size_t WS_MIXED = 250 * MiB;
constexpr size_t WS_X1 = 284 * MiB;
constexpr size_t WS_H = 352 * MiB;
constexpr size_t WS_END = 486 * MiB;

constexpr int NWAVES = 8;
constexpr int RING_BYTES = 131072, LDS_BYTES = 147456, MISC_OFF = LDS_BYTES - 64;

#define GAS __attribute__((address_space(1)))
#define LAS __attribute__((address_space(3)))
typedef unsigned short bf16;
typedef unsigned v4u __attribute__((ext_vector_type(4)));
typedef unsigned v2u __attribute__((ext_vector_type(2)));
typedef float f32x4 __attribute__((ext_vector_type(4)));
typedef float f32x16 __attribute__((ext_vector_type(16)));
typedef short bf16x8 __attribute__((ext_vector_type(8)));
typedef short s16x4 __attribute__((ext_vector_type(4)));
typedef GAS unsigned gu32;
#define RLX_AGENT __ATOMIC_RELAXED, __HIP_MEMORY_SCOPE_AGENT
#define LDS_WAIT() asm volatile("s_waitcnt lgkmcnt(0)" ::: "memory")
typedef float f32x2_t __attribute__((ext_vector_type(2))); typedef __bf16 bf16x2_t __attribute__((ext_vector_type(2)));
__device__ __forceinline__ unsigned pk2(float lo, float hi) { f32x2_t v = {lo, hi}; bf16x2_t b = __builtin_convertvector(v, bf16x2_t); return __builtin_bit_cast(unsigned, b); }
__device__ __forceinline__ float bf2f(unsigned short h) { return __builtin_bit_cast(float, (unsigned)h << 16); }
__device__ __forceinline__ float bflo(unsigned w) { return __builtin_bit_cast(float, w << 16); }
__device__ __forceinline__ float bfhi(unsigned w) { return __builtin_bit_cast(float, w & 0xffff0000u); }
__device__ __forceinline__ float wave_sum(float v) {
#pragma unroll
    for (int o = 1; o < 64; o <<= 1) v += __shfl_xor(v, o);
    return v;
}

#define XB_TMO      128
#define XB_XCNT(j)  (256  + 64 * (j))
#define XB_XSUB(j)  (1280 + 64 * (j))
#define XB_XGEN(j)  (2304 + 64 * (j))
#define XB_TOP      3328
#define XB_TOPGEN   3392
#define XCD_BAR_WORDS 3456
#define XB_SPIN_CAP (1u << 18)

__device__ __forceinline__ unsigned xb_ld(unsigned* p)              { return __hip_atomic_load(p, __ATOMIC_RELAXED, __HIP_MEMORY_SCOPE_AGENT); }
__device__ __forceinline__ unsigned xb_add(unsigned* p, unsigned v) { return __hip_atomic_fetch_add(p, v, __ATOMIC_RELAXED, __HIP_MEMORY_SCOPE_AGENT); }
__device__ __forceinline__ unsigned xb_xcc_id() { return (unsigned)__builtin_amdgcn_s_getreg((3 << 11) | 20) & 0xFu; }
#define XB_SPIN(cond, bar) do { unsigned _sp = 0; while (cond) { __builtin_amdgcn_s_sleep(1); \
    if ((++_sp & 255u) == 0u) { if (xb_ld(&(bar)[XB_TMO])) break; if (_sp > XB_SPIN_CAP) { atomicAdd(&(bar)[XB_TMO], 1u); break; } } } } while (0)

struct XcdBarrier {
    unsigned* bar; unsigned x;
    volatile LAS unsigned* st;
};

__device__ __forceinline__ XcdBarrier xcd_barrier_post(unsigned* bar, volatile LAS unsigned* st) {
    XcdBarrier b; b.bar = bar; b.x = xb_xcc_id(); b.st = st;
    if (threadIdx.x == 0) (void)xb_add(&bar[XB_XCNT(b.x)], 1u);
    return b;
}
__device__ __forceinline__ void xcd_barrier_complete(unsigned* bar, unsigned x, unsigned& nloc, unsigned& nx) {
    const unsigned G = gridDim.x * gridDim.y * gridDim.z;
    unsigned sum, cnt, mine, sp = 0u;
    for (;;) {
        sum = 0u; cnt = 0u; mine = 0u;
#pragma unroll
        for (unsigned j = 0; j < 16; ++j) { const unsigned c = xb_ld(&bar[XB_XCNT(j)]); sum += c; cnt += (c > 0u) ? 1u : 0u; mine = (j == x) ? c : mine; }
        if (sum == G) break;
        __builtin_amdgcn_s_sleep(1);
        if ((++sp & 255u) == 0u) { if (xb_ld(&bar[XB_TMO])) break; if (sp > XB_SPIN_CAP) { atomicAdd(&bar[XB_TMO], 1u); break; } }
    }
    nloc = mine > 0u ? mine : 1u; nx = cnt > 0u ? cnt : 1u;
}

__device__ __forceinline__ void xcd_barrier(const XcdBarrier& b) {
    asm volatile("s_waitcnt vmcnt(0)" ::: "memory");
    __syncthreads();
    if (threadIdx.x == 0) {
        unsigned* bar = b.bar;
        __builtin_amdgcn_s_waitcnt(0);
        unsigned nloc = b.st[0], nx = b.st[1];
        if (nloc == 0u) { xcd_barrier_complete(bar, b.x, nloc, nx); b.st[0] = nloc; b.st[1] = nx; }
        const unsigned old = xb_add(&bar[XB_XSUB(b.x)], 1u);
        const unsigned gen = old / nloc;
        if (old + 1u == (gen + 1u) * nloc) {
            __builtin_amdgcn_fence(__ATOMIC_RELEASE, "agent");
            asm volatile("s_waitcnt vmcnt(0)" ::: "memory");
            const unsigned og = xb_add(&bar[XB_TOP], 1u);
            const unsigned tg = og / nx;
            if (og + 1u == (tg + 1u) * nx) xb_add(&bar[XB_TOPGEN], 1u);
            else XB_SPIN(xb_ld(&bar[XB_TOPGEN]) == tg, bar);
            __builtin_amdgcn_fence(__ATOMIC_ACQUIRE, "agent");
            xb_add(&bar[XB_XGEN(b.x)], 1u);
            asm volatile("s_waitcnt vmcnt(0)" ::: "memory");
        } else {
            XB_SPIN(xb_ld(&bar[XB_XGEN(b.x)]) == gen, bar);
            __builtin_amdgcn_fence(__ATOMIC_ACQUIRE, "agent");
            asm volatile("s_waitcnt vmcnt(0)" ::: "memory");
        }
    }
    __syncthreads();
}

struct Frame {
    LAS unsigned char* lds;
    int tid, lane, wave, G, vcu;
    const float* const* in; const int* page_table;
    float* out; unsigned char* ws; gu32* ctl;
};
#define WSP(T, off) ((T*)(F.ws + (off)))

template <int MAP>
__device__ __forceinline__ void p0_transpose_item(const float* W, int ldw, int K, int Nphys, bf16* WT, int row_off, LAS float* scr, int item, int lane, const float* kscale) {
    const int nblk = Nphys / 32, kb = item / nblk, nb = item % nblk, k0 = 64 * kb, n0 = 32 * nb;
    const int np = n0 + (lane & 31);
    int ln = np;
    if (MAP == 1) ln = np < 1280 ? np : (np < 2304 ? np + 24 : (np < 2328 ? np - 1024 : -1));
    float tv[32];
#pragma unroll
    for (int i = 0; i < 32; ++i) { const int kk = 2 * i + (lane >> 5); tv[i] = ln >= 0 ? W[(size_t)(k0 + kk) * ldw + ln] : 0.f; }
#pragma unroll
    for (int i = 0; i < 32; ++i) { const int kk = 2 * i + (lane >> 5); float v = tv[i];
        if (kscale) v *= kscale[k0 + kk];
        scr[kk * 33 + (lane & 31)] = v; }
    LDS_WAIT(); asm volatile("" ::: "memory");
    const int c = lane & 7;
#pragma unroll
    for (int j = 0; j < 4; ++j) { const int n = (lane >> 3) + 8 * j; const LAS float* s = scr + (8 * c) * 33 + n;
        v4u o; o.x = pk2(s[0 * 33], s[1 * 33]); o.y = pk2(s[2 * 33], s[3 * 33]); o.z = pk2(s[4 * 33], s[5 * 33]); o.w = pk2(s[6 * 33], s[7 * 33]);
        *(GAS v4u*)(WT + (size_t)(row_off + n0 + n) * K + k0 + 8 * c) = o; }
    LDS_WAIT(); asm volatile("" ::: "memory");
}
__device__ __forceinline__ void rms_row_to_bf16(const float* xrow, const float* g, bf16* orow, int lane) {
    const GAS f32x4* xr = (const GAS f32x4*)xrow + lane; const GAS f32x4* gr = (const GAS f32x4*)g + lane;
    f32x4 v[4]; float s = 0.f;
#pragma unroll
    for (int j = 0; j < 4; ++j) { v[j] = xr[64 * j]; s += (v[j].x * v[j].x + v[j].y * v[j].y) + (v[j].z * v[j].z + v[j].w * v[j].w); }
    const float rs = rsqrtf(wave_sum(s) * (1.f / DM) + EPSN);
    GAS unsigned long long* o8 = (GAS unsigned long long*)orow + lane;
#pragma unroll
    for (int j = 0; j < 4; ++j) { const f32x4 gg = gr[64 * j];
        o8[64 * j] = (unsigned long long)pk2(v[j].x * rs * gg.x, v[j].y * rs * gg.y) | ((unsigned long long)pk2(v[j].z * rs * gg.z, v[j].w * rs * gg.w) << 32); }
}
__device__ __forceinline__ void p0_prologue(Frame& F) {
    LAS float* scr = (LAS float*)(F.lds + F.wave * 16384);
    const int gw = F.vcu * NWAVES + F.wave, NGW = F.G * NWAVES;
    constexpr int I_IN = 16 * (NIN / 32), I_OUT = 16 * 32, I_UP = 16 * (FF / 32), I_DN = 64 * 32, I_C1 = 4 * 32, I_C2 = 2 * 2, I_R = 16 * 2;
    constexpr int NITEMS = I_IN + I_OUT + I_UP + I_DN + I_C1 + I_C2 + I_R;
    for (int it = gw; it < NITEMS; it += NGW) {
        int r = it;
        if (r < I_IN) { p0_transpose_item<1>(F.in[7], 2328, DM, NIN, WSP(bf16, WS_WIN), 0, scr, r, F.lane, nullptr); continue; } r -= I_IN;
        if (r < I_OUT) { p0_transpose_item<0>(F.in[23], DM, DM, DM, WSP(bf16, WS_WOUT), 0, scr, r, F.lane, nullptr); continue; } r -= I_OUT;
        if (r < I_UP) { p0_transpose_item<0>(F.in[26], FF, DM, FF, WSP(bf16, WS_WUP), 0, scr, r, F.lane, F.in[25]); continue; } r -= I_UP;
        if (r < I_DN) { p0_transpose_item<0>(F.in[27], DM, FF, DM, WSP(bf16, WS_WDN), 0, scr, r, F.lane, nullptr); continue; } r -= I_DN;
        if (r < I_C1) { const int q = r / 32, slot = q >> 1, half = q & 1;
            p0_transpose_item<0>(F.in[slot ? 12 : 9] + (size_t)half * 1024 * 64, 64, 1024, 64, WSP(bf16, WS_WC1) + (size_t)slot * 128 * 1024, half * 64, scr, r % 32, F.lane, nullptr); continue; } r -= I_C1;
        if (r < I_C2) { const int slot = r >> 1;
            p0_transpose_item<0>(F.in[slot ? 13 : 10], 64, 64, 64, WSP(bf16, WS_WC2) + (size_t)slot * 4096, 0, scr, r & 1, F.lane, nullptr); continue; } r -= I_C2;
        { const int q = r >> 1, blk = q >> 1, which = q & 1;
            p0_transpose_item<0>(F.in[which ? 20 : 18] + (size_t)blk * 4096, 64, 64, 64, WSP(bf16, WS_WR) + (size_t)blk * 8192, which * 64, scr, r & 1, F.lane, nullptr); }
    }
    { const int gt = gw * 64 + F.lane;
      if (gt < 2052 * 8) { const int pos = gt >> 3, i = gt & 7;
          const double inv = pow(500000.0, -(double)i / 8.0), ang = (double)pos * inv;
          float* rt = WSP(float, WS_ROT) + pos * 16; rt[i] = (float)cos(ang); rt[8 + i] = (float)sin(ang); } }
    if (gw >= NGW - 64) { const int idx = gw - (NGW - 64), slot = idx >> 5, kp = idx & 31; const float* pe = F.in[slot ? 11 : 8] + kp * 64; const float* w1 = F.in[slot ? 12 : 9] + (size_t)kp * 64 * 64;
        float a = 0.f;
#pragma unroll 16
        for (int k = 0; k < 64; ++k) a += pe[k] * w1[(size_t)k * 64 + F.lane];
        atomicAdd((float*)(F.ws + WS_CTL + CTL_B1) + slot * 64 + F.lane, a); }
    {   const GAS f32x4* gr = (const GAS f32x4*)F.in[24] + F.lane;
        f32x4 gg[4];
#pragma unroll
        for (int j = 0; j < 4; ++j) gg[j] = gr[64 * j];
        for (int m0 = gw; m0 < MT; m0 += 4 * NGW) {
            f32x4 v[4][4]; float s[4];
#pragma unroll
            for (int q = 0; q < 4; ++q) { const int m = m0 + q * NGW; s[q] = 0.f;
                if (m < MT) { const float* xr = m < MP ? F.in[0] + (size_t)m * DM : F.in[1] + (size_t)(m - MP) * DM; const GAS f32x4* xp = (const GAS f32x4*)xr + F.lane;
#pragma unroll
                    for (int j = 0; j < 4; ++j) v[q][j] = xp[64 * j]; } }
#pragma unroll
            for (int q = 0; q < 4; ++q) { const int m = m0 + q * NGW;
                if (m < MT) {
#pragma unroll
                    for (int j = 0; j < 4; ++j) s[q] += (v[q][j].x * v[q][j].x + v[q][j].y * v[q][j].y) + (v[q][j].z * v[q][j].z + v[q][j].w * v[q][j].w);
                    const float rs = rsqrtf(wave_sum(s[q]) * (1.f / DM) + EPSN);
                    GAS unsigned long long* o8 = (GAS unsigned long long*)(WSP(bf16, WS_XN) + (size_t)m * DM) + F.lane;
#pragma unroll
                    for (int j = 0; j < 4; ++j) o8[64 * j] = (unsigned long long)pk2(v[q][j].x * rs * gg[j].x, v[q][j].y * rs * gg[j].y) | ((unsigned long long)pk2(v[q][j].z * rs * gg[j].z, v[q][j].w * rs * gg[j].w) << 32); } }
        }
    }
}
__device__ __forceinline__ void p7_final(Frame& F) {
    const int gw = F.vcu * NWAVES + F.wave, NGW = F.G * NWAVES;
    const GAS f32x4* gr = (const GAS f32x4*)F.in[28] + F.lane;
    f32x4 gg[4];
#pragma unroll
    for (int j = 0; j < 4; ++j) gg[j] = gr[64 * j];
    for (int m0 = gw; m0 < MT; m0 += 4 * NGW) {
        f32x4 v[4][4];
#pragma unroll
        for (int q = 0; q < 4; ++q) { const int m = m0 + q * NGW;
            if (m < MT) { const GAS f32x4* yr = (const GAS f32x4*)(F.out + (size_t)m * DM) + F.lane;
#pragma unroll
                for (int j = 0; j < 4; ++j) v[q][j] = yr[64 * j]; } }
#pragma unroll
        for (int q = 0; q < 4; ++q) { const int m = m0 + q * NGW;
            if (m < MT) { float s = 0.f;
#pragma unroll
                for (int j = 0; j < 4; ++j) s += (v[q][j].x * v[q][j].x + v[q][j].y * v[q][j].y) + (v[q][j].z * v[q][j].z + v[q][j].w * v[q][j].w);
                const float rs = rsqrtf(wave_sum(s) * (1.f / DM) + EPSN);
                GAS f32x4* yr = (GAS f32x4*)(F.out + (size_t)m * DM) + F.lane;
#pragma unroll
                for (int j = 0; j < 4; ++j) yr[64 * j] = v[q][j] * rs * gg[j]; } }
    }
}

__device__ __forceinline__ void rnn_unit(Frame& F, int u_, int probe_u = -1) {
    const int u = probe_u >= 0 ? probe_u : u_;
    const int b = F.wave, lane = F.lane, fr = lane & 15, fq = lane >> 4;
    const bool samp = u >= 256;
    const int rowbase = samp ? MP + 64 * (u - 256) : (u >> 5) * SEQ + (u & 31) * 64;
    const int t0 = samp ? 0 : (u & 31) * 64;
    const float* RX = WSP(float, WS_RX); float* HL = WSP(float, WS_HL); float* AC = WSP(float, WS_AC);
    const float* convw = F.in[16]; const float* convb = F.in[17]; const float* stc = F.in[4]; const float* sth = F.in[5];
    LAS float* xcs = (LAS float*)(F.lds + b * 8704);
    const bf16* wrp = WSP(bf16, WS_WR) + (size_t)b * 8192 + fr * 64 + 8 * fq;
    float hc[4], Ac[4], braA[4], briA[4], spA[4];
#pragma unroll
    for (int nn = 0; nn < 4; ++nn) { const int ch = 64 * b + 16 * nn + fr; hc[nn] = 0.f; Ac[nn] = 1.f; braA[nn] = F.in[19][ch]; briA[nn] = F.in[21][ch]; spA[nn] = log1pf(__expf(-F.in[22][ch])); }
    bf16x8 wq[2][2];
#pragma unroll
    for (int g = 0; g < 2; ++g)
#pragma unroll
        for (int ks = 0; ks < 2; ++ks) wq[g][ks] = *(const bf16x8*)(wrp + (size_t)(64 * g) * 64 + 32 * ks);
#ifndef RNN_PASSES
#define RNN_PASSES 1
#endif
    for (int rpass = 0; rpass < RNN_PASSES; ++rpass) {
    if (rpass > 0) {
#pragma unroll
        for (int nn = 0; nn < 4; ++nn) { hc[nn] = 0.f; Ac[nn] = 1.f; } }
    for (int sub = 0; sub < 2; ++sub) {
        bf16x8 af[2][2];
#pragma unroll
        for (int m = 0; m < 2; ++m) {
            const int tau = 32 * sub + 16 * m + fr;
#pragma unroll
            for (int ks = 0; ks < 2; ++ks) {
                const int cbase = 64 * b + 32 * ks + 8 * fq;
                f32x4 xa = *(const f32x4*)(convb + cbase), xb = *(const f32x4*)(convb + cbase + 4);
#pragma unroll
                for (int k = 0; k < 4; ++k) {
                    const float* src; bool ok = true;
                    if (!samp) { const int rr = tau - 3 + k; ok = (t0 + rr) >= 0; src = RX + (size_t)(rowbase + rr) * 512 + cbase; }
                    else { const int r2 = (tau & 3) - 3 + k;
                        if (r2 >= 0) src = RX + (size_t)(rowbase + (tau & ~3) + r2) * 512 + cbase;
                        else src = stc + ((size_t)((u - 256) * 16 + (tau >> 2)) * 3 + (3 + r2)) * 512 + cbase; }
                    f32x4 v0 = (f32x4){0.f, 0.f, 0.f, 0.f}, v1 = v0;
                    if (ok) { v0 = *(const f32x4*)src; v1 = *(const f32x4*)(src + 4); }
                    const f32x4 w0 = *(const f32x4*)(convw + k * 512 + cbase), w1 = *(const f32x4*)(convw + k * 512 + cbase + 4);
                    xa += w0 * v0; xb += w1 * v1;
                }
                v4u pk; pk.x = pk2(xa[0], xa[1]); pk.y = pk2(xa[2], xa[3]); pk.z = pk2(xb[0], xb[1]); pk.w = pk2(xb[2], xb[3]);
                af[m][ks] = __builtin_bit_cast(bf16x8, pk);
                LAS float* xd = xcs + (16 * m + fr) * 68 + 32 * ks + 8 * fq;
                *(LAS f32x4*)xd = xa; *(LAS f32x4*)(xd + 4) = xb;
            }
        }
        LDS_WAIT();
#pragma unroll 1
        for (int nn = 0; nn < 4; ++nn) {
            const int ch = 64 * b + 16 * nn + fr;
            f32x4 acc[2][2];
#pragma unroll
            for (int m = 0; m < 2; ++m) { acc[m][0] = (f32x4){0.f, 0.f, 0.f, 0.f}; acc[m][1] = acc[m][0]; }
            bf16x8 wc_[2][2];
#pragma unroll
            for (int g = 0; g < 2; ++g)
#pragma unroll
                for (int ks = 0; ks < 2; ++ks) wc_[g][ks] = wq[g][ks];
            { const int nx = (nn + 1) & 3;
#pragma unroll
              for (int g = 0; g < 2; ++g)
#pragma unroll
                  for (int ks = 0; ks < 2; ++ks) wq[g][ks] = *(const bf16x8*)(wrp + (size_t)(64 * g + 16 * nx) * 64 + 32 * ks); }
#pragma unroll
            for (int g = 0; g < 2; ++g)
#pragma unroll
                for (int ks = 0; ks < 2; ++ks)
#pragma unroll
                    for (int m = 0; m < 2; ++m) acc[m][g] = __builtin_amdgcn_mfma_f32_16x16x32_bf16(af[m][ks], wc_[g][ks], acc[m][g], 0, 0, 0);
            float hcn = 0.f, acn = 1.f, bra = 0.f, bri = 0.f, sp = 0.f;
#pragma unroll
            for (int q = 0; q < 4; ++q) if (q == nn) { hcn = hc[q]; acn = Ac[q]; bra = braA[q]; bri = briA[q]; sp = spA[q]; }
#pragma unroll
            for (int m = 0; m < 2; ++m) {
                float a[4], bb[4];
#pragma unroll
                for (int e = 0; e < 4; ++e) {
                    const float r = 1.f / (1.f + __expf(-(acc[m][0][e] + bra)));
                    const float ig = 1.f / (1.f + __expf(-(acc[m][1][e] + bri)));
                    const float la = -8.0f * r * sp;
                    a[e] = __expf(la);
                    const float xcv = xcs[(16 * m + 4 * fq + e) * 68 + 16 * nn + fr];
                    bb[e] = sqrtf(fmaxf(1.f - a[e] * a[e], 0.f)) * (ig * xcv);
                }
                const int trow = rowbase + 32 * sub + 16 * m + 4 * fq;
                if (!samp) {
                    const float Pl = (a[0] * a[1]) * (a[2] * a[3]);
                    float Hl = bb[0]; Hl = a[1] * Hl + bb[1]; Hl = a[2] * Hl + bb[2]; Hl = a[3] * Hl + bb[3];
                    float cin = hcn, ain = acn;
#pragma unroll
                    for (int k = 0; k < 4; ++k) {
                        const float hend = Pl * cin + Hl, aend = ain * Pl;
                        const float nh = __shfl(hend, fr + 16 * k), na = __shfl(aend, fr + 16 * k);
                        if (k < 3) { if (fq == k + 1) { cin = nh; ain = na; } } else { hcn = nh; acn = na; }
                    }
                    float hv = cin, av = ain;
#pragma unroll
                    for (int e = 0; e < 4; ++e) { hv = a[e] * hv + bb[e]; av *= a[e]; HL[(size_t)(trow + e) * 512 + ch] = hv; AC[(size_t)(trow + e) * 512 + ch] = av; }
                } else {
                    const int s = (u - 256) * 16 + 8 * sub + 4 * m + fq;
                    float hv = sth[(size_t)s * 512 + ch];
#pragma unroll
                    for (int e = 0; e < 4; ++e) { hv = a[e] * hv + bb[e]; HL[(size_t)(trow + e) * 512 + ch] = hv; AC[(size_t)(trow + e) * 512 + ch] = 0.f; }
                    F.out[O_HS + (size_t)s * 512 + ch] = hv;
                }
            }
#pragma unroll
            for (int q = 0; q < 4; ++q) if (q == nn) { hc[q] = hcn; Ac[q] = acn; }
        }
        LDS_WAIT();
    }
    }
    if (!samp && fq == 0) { float* sm = WSP(float, WS_SUMM) + (size_t)u * 1024;
#pragma unroll
        for (int nn = 0; nn < 4; ++nn) { const int ch = 64 * b + 16 * nn + fr; sm[ch] = hc[nn]; sm[512 + ch] = Ac[nn]; } }
    if (!samp && probe_u < 0) {
        asm volatile("s_waitcnt vmcnt(0)" ::: "memory");
        __syncthreads();
        volatile LAS unsigned* MISC = (volatile LAS unsigned*)(F.lds + MISC_OFF);
        const int n = u >> 5;
        if (F.tid == 0) {
            __builtin_amdgcn_fence(__ATOMIC_RELEASE, "agent");
            asm volatile("s_waitcnt vmcnt(0)" ::: "memory");
            const unsigned old = __hip_atomic_fetch_add((unsigned*)(F.ctl + CW_RNN + 64 * n), 1u, RLX_AGENT);
            if (old == 31u) { __builtin_amdgcn_fence(__ATOMIC_ACQUIRE, "agent"); asm volatile("s_waitcnt vmcnt(0)" ::: "memory"); }
            MISC[1] = old;
        }
        __syncthreads();
        const bool last = MISC[1] == 31u;
        if (last) {
            const float* sm = WSP(float, WS_SUMM) + (size_t)n * 32 * 1024 + F.tid; float* cr = WSP(float, WS_CARRY) + (size_t)n * 32 * 512 + F.tid;
            float hv[32], av[32];
#pragma unroll
            for (int c = 0; c < 32; ++c) { hv[c] = __builtin_nontemporal_load(sm + c * 1024); av[c] = __builtin_nontemporal_load(sm + c * 1024 + 512); }
            float carry = 0.f;
#pragma unroll
            for (int c = 0; c < 32; ++c) { cr[c * 512] = carry; carry = av[c] * carry + hv[c]; }
        }
    }
}

__device__ __forceinline__ void compress_unit(Frame& F, int cu) {
    const int tid = F.tid, lane = F.lane, w = F.wave, wr = w >> 2, wc = w & 3, fr = lane & 15, fq = lane >> 4;
    const bool samp = cu < 512;
    const int q = samp ? cu : cu - 512, sq = q >> 2, h = (q >> 1) & 1, slot = q & 1;
    const int seqi = samp ? 8 + sq : sq;
    const int li = tid >> 2, qd = tid & 3;
    const float* abase;
    if (samp) { const int page = F.page_table[sq * 16 + (li >> 3)]; abase = F.in[2] + ((size_t)page * 128 + (size_t)((16 * li) & 127)) * 512 + slot * 128 + h * 64 + 16 * qd; }
    else abase = F.out + O_KV + ((size_t)sq * SEQ + 16 * li) * 512 + slot * 128 + h * 64 + 16 * qd;
    const bf16* bbase = WSP(bf16, WS_WC1) + (size_t)slot * 128 * 1024 + (size_t)li * 1024 + 16 * qd;
    LAS unsigned char* lds = F.lds;
    const int wo0 = li * 128 + (((2 * qd) ^ (li & 7)) << 4), wo1 = li * 128 + (((2 * qd + 1) ^ (li & 7)) << 4);
    f32x4 ar[4][4]; v4u br[4][2];
    f32x4 acc[4][2];
#pragma unroll
    for (int m = 0; m < 4; ++m)
#pragma unroll
        for (int n = 0; n < 2; ++n) acc[m][n] = (f32x4){0.f, 0.f, 0.f, 0.f};
#define CMP_LOAD(s_, j) do { _Pragma("unroll") for (int i_ = 0; i_ < 4; ++i_) ar[s_][i_] = *(const f32x4*)(abase + (size_t)(j) * 512 + 4 * i_); \
        br[s_][0] = *(const v4u*)(bbase + (j) * 64); br[s_][1] = *(const v4u*)(bbase + (j) * 64 + 8); } while (0)
#define CMP_WRITE(s_, st) do { LAS unsigned char* A_ = lds + (st) * 32768; LAS unsigned char* B_ = A_ + 16384; \
        v4u p0_, p1_; p0_.x = pk2(ar[s_][0][0], ar[s_][0][1]); p0_.y = pk2(ar[s_][0][2], ar[s_][0][3]); p0_.z = pk2(ar[s_][1][0], ar[s_][1][1]); p0_.w = pk2(ar[s_][1][2], ar[s_][1][3]); \
        p1_.x = pk2(ar[s_][2][0], ar[s_][2][1]); p1_.y = pk2(ar[s_][2][2], ar[s_][2][3]); p1_.z = pk2(ar[s_][3][0], ar[s_][3][1]); p1_.w = pk2(ar[s_][3][2], ar[s_][3][3]); \
        *(LAS v4u*)(A_ + wo0) = p0_; *(LAS v4u*)(A_ + wo1) = p1_; *(LAS v4u*)(B_ + wo0) = br[s_][0]; *(LAS v4u*)(B_ + wo1) = br[s_][1]; } while (0)
#define CMP_COMPUTE(st) do { const LAS unsigned char* A_ = lds + (st) * 32768; const LAS unsigned char* B_ = A_ + 16384; \
        bf16x8 af[4][2], bf[2][2]; \
        _Pragma("unroll") for (int m = 0; m < 4; ++m) _Pragma("unroll") for (int k = 0; k < 2; ++k) { const int row = 64 * wr + 16 * m + fr; af[m][k] = *(const LAS bf16x8*)(A_ + row * 128 + (((4 * k + fq) ^ (row & 7)) << 4)); } \
        _Pragma("unroll") for (int n = 0; n < 2; ++n) _Pragma("unroll") for (int k = 0; k < 2; ++k) { const int row = 32 * wc + 16 * n + fr; bf[n][k] = *(const LAS bf16x8*)(B_ + row * 128 + (((4 * k + fq) ^ (row & 7)) << 4)); } \
        _Pragma("unroll") for (int m = 0; m < 4; ++m) _Pragma("unroll") for (int n = 0; n < 2; ++n) _Pragma("unroll") for (int k = 0; k < 2; ++k) \
            acc[m][n] = __builtin_amdgcn_mfma_f32_16x16x32_bf16(bf[n][k], af[m][k], acc[m][n], 0, 0, 0); } while (0)
    CMP_LOAD(0, 0); CMP_LOAD(1, 1); CMP_LOAD(2, 2); CMP_WRITE(0, 0);
    __syncthreads();
#pragma unroll
    for (int j = 0; j < 16; ++j) {
        if (j + 3 < 16) CMP_LOAD((j + 3) & 3, j + 3);
        CMP_COMPUTE(j & 1);
        if (j + 1 < 16) CMP_WRITE((j + 1) & 3, (j + 1) & 1);
        __syncthreads();
    }
#undef CMP_COMPUTE
#undef CMP_LOAD
#undef CMP_WRITE
    LAS float* Ys = (LAS float*)lds;
#pragma unroll
    for (int m = 0; m < 4; ++m)
#pragma unroll
        for (int n = 0; n < 2; ++n) *(LAS f32x4*)(Ys + (64 * wr + 16 * m + fr) * 132 + 32 * wc + 16 * n + 4 * fq) = acc[m][n];
    __syncthreads();
    LAS unsigned char* Hs = lds + 73728;
    { const int c = tid >> 2, e0 = (tid & 3) * 16; const float* b1 = (const float*)(F.ws + WS_CTL + CTL_B1) + slot * 64;
      float hv[16];
#pragma unroll
      for (int i = 0; i < 16; ++i) { float v = 0.f; if (c < 127) v = pg8::gelu_tanh(Ys[c * 132 + e0 + i] + Ys[(c + 1) * 132 + 64 + e0 + i] + b1[e0 + i]); hv[i] = v; }
      v4u p0, p1; p0.x = pk2(hv[0], hv[1]); p0.y = pk2(hv[2], hv[3]); p0.z = pk2(hv[4], hv[5]); p0.w = pk2(hv[6], hv[7]);
      p1.x = pk2(hv[8], hv[9]); p1.y = pk2(hv[10], hv[11]); p1.z = pk2(hv[12], hv[13]); p1.w = pk2(hv[14], hv[15]);
      const int c8 = (tid & 3) * 2;
      *(LAS v4u*)(Hs + c * 128 + ((c8 ^ (c & 7)) << 4)) = p0; *(LAS v4u*)(Hs + c * 128 + (((c8 + 1) ^ (c & 7)) << 4)) = p1; }
    __syncthreads();
    { const bf16* w2 = WSP(bf16, WS_WC2) + (size_t)slot * 4096;
      f32x4 a2[4];
#pragma unroll
      for (int n = 0; n < 4; ++n) a2[n] = (f32x4){0.f, 0.f, 0.f, 0.f};
      const int row = 16 * w + fr;
#pragma unroll
      for (int k = 0; k < 2; ++k) { const bf16x8 hf = *(const LAS bf16x8*)(Hs + row * 128 + (((4 * k + fq) ^ (row & 7)) << 4));
#pragma unroll
          for (int n = 0; n < 4; ++n) { const bf16x8 wv = *(const bf16x8*)(w2 + (16 * n + fr) * 64 + 32 * k + 8 * fq); a2[n] = __builtin_amdgcn_mfma_f32_16x16x32_bf16(wv, hf, a2[n], 0, 0, 0); } }
      bf16* dst = WSP(bf16, slot ? WS_VCC : WS_KCC) + ((size_t)seqi * 128 + row) * 128 + h * 64;
#pragma unroll
      for (int n = 0; n < 4; ++n) { v2u o; o.x = pk2(a2[n][0], a2[n][1]); o.y = pk2(a2[n][2], a2[n][3]); *(v2u*)(dst + 16 * n + 4 * fq) = o; } }
    __syncthreads();
}

constexpr float C2S = 0.125f * 1.4426950408889634f;
constexpr float NEGB = -1e30f;
constexpr int A_OA = 65536, A_IMP = 98304, A_SEL = 107520, A_GT = 108032, A_WSF = 111104;
__device__ __forceinline__ int crow(int r, int hi) { return (r & 3) + 8 * (r >> 2) + 4 * hi; }
__device__ __forceinline__ float ex2(float x) { return __builtin_amdgcn_exp2f(x); }

__device__ __forceinline__ void qk_tile(f32x16& p0, f32x16& p1, const LAS unsigned char* Kt, const bf16x8 (&qf)[4], int r32, int hi) {
#pragma unroll
    for (int r = 0; r < 16; ++r) { p0[r] = 0.f; p1[r] = 0.f; }
#pragma unroll
    for (int d0 = 0; d0 < 4; ++d0) {
        const int off = r32 * 128 + (((2 * d0 + hi) ^ (r32 & 7)) << 4);
        const bf16x8 ka = *(const LAS bf16x8*)(Kt + off), kb = *(const LAS bf16x8*)(Kt + off + 4096);
        p0 = __builtin_amdgcn_mfma_f32_32x32x16_bf16(ka, qf[d0], p0, 0, 0, 0);
        p1 = __builtin_amdgcn_mfma_f32_32x32x16_bf16(kb, qf[d0], p1, 0, 0, 0);
    }
}
__device__ __forceinline__ void pv_tile(f32x16 (&o)[2], const LAS unsigned char* Vt, const bf16x8 (&pa)[4], int lane) {
    const int g = lane >> 4, i = lane & 15, q = i >> 2, p = i & 3, hg = g >> 1;
#pragma unroll
    for (int d0 = 0; d0 < 2; ++d0)
#pragma unroll
        for (int ks = 0; ks < 4; ++ks) {
            const int row0 = 16 * ks + 4 * hg + q, chunk = 4 * d0 + 2 * (g & 1) + (p >> 1);
            const LAS unsigned char* a0 = Vt + row0 * 128 + ((chunk ^ (row0 & 7)) << 4) + 8 * (p & 1);
            const s16x4 lo = __builtin_bit_cast(s16x4, __builtin_amdgcn_ds_read_tr16_b64_v4i16((LAS s16x4*)a0));
            const s16x4 hi4 = __builtin_bit_cast(s16x4, __builtin_amdgcn_ds_read_tr16_b64_v4i16((LAS s16x4*)(a0 + 1024)));
            const bf16x8 bv = (bf16x8){lo[0], lo[1], lo[2], lo[3], hi4[0], hi4[1], hi4[2], hi4[3]};
            o[d0] = __builtin_amdgcn_mfma_f32_32x32x16_bf16(pa[ks], bv, o[d0], 0, 0, 0);
        }
}
__device__ __forceinline__ void pack_p(bf16x8 (&pa)[4], const f32x16& p0, const f32x16& p1) {
#pragma unroll
    for (int ks = 0; ks < 2; ++ks) {
        v4u a, b;
        a.x = pk2(p0[8 * ks + 0], p0[8 * ks + 1]); a.y = pk2(p0[8 * ks + 2], p0[8 * ks + 3]); a.z = pk2(p0[8 * ks + 4], p0[8 * ks + 5]); a.w = pk2(p0[8 * ks + 6], p0[8 * ks + 7]);
        b.x = pk2(p1[8 * ks + 0], p1[8 * ks + 1]); b.y = pk2(p1[8 * ks + 2], p1[8 * ks + 3]); b.z = pk2(p1[8 * ks + 4], p1[8 * ks + 5]); b.w = pk2(p1[8 * ks + 6], p1[8 * ks + 7]);
        pa[ks] = __builtin_bit_cast(bf16x8, a); pa[2 + ks] = __builtin_bit_cast(bf16x8, b);
    }
}
__device__ __forceinline__ float mask_scale(f32x16& p0, f32x16& p1, int kbase, int klo, int khi, bool rflag, int hi) {
    float mx = NEGB;
#pragma unroll
    for (int r = 0; r < 16; ++r) { const int kv = kbase + crow(r, hi);
        const bool v0 = rflag && kv >= klo && kv <= khi, v1 = rflag && (kv + 32) >= klo && (kv + 32) <= khi;
        p0[r] = v0 ? p0[r] * C2S : NEGB; p1[r] = v1 ? p1[r] * C2S : NEGB;
        mx = fmaxf(mx, fmaxf(p0[r], p1[r])); }
    return fmaxf(mx, __shfl_xor(mx, 32));
}

template <bool SAMP>
__device__ __forceinline__ void attn_unit(Frame& F, int sq, int qb) {
    int tid = F.tid; asm volatile("" : "+v"(tid));
    const int lane = tid & 63, w = F.wave, r32 = lane & 31, hi = lane >> 5, h = w >> 2, wg = w & 3;
    const int q0 = SAMP ? 0 : qb * 32;
    const int rowbase = SAMP ? MP + 4 * sq : sq * SEQ + q0;
    const int tok = SAMP ? (r32 & 3) : r32;
    const int myhead = h * 4 + (SAMP ? ((r32 >> 2) & 3) : wg);
    const int qpos = SAMP ? SEQ + tok : q0 + r32;
    const int cur = SAMP ? 32 : (q0 >> 6);
    const int seqc = SAMP ? 8 + sq : sq;
    constexpr int NT = SAMP ? 4 : 32;
    LAS unsigned char* lds = F.lds;
    LAS float* IMP = (LAS float*)(lds + A_IMP);
    LAS unsigned long long* SEL = (LAS unsigned long long*)(lds + A_SEL);
    LAS float* GT = (LAS float*)(lds + A_GT);
    LAS float* wsf = (LAS float*)(lds + A_WSF) + w * 64;
    LAS unsigned short* OA = (LAS unsigned short*)(lds + A_OA);
    const bf16 *KS = WSP(bf16, WS_KS), *VS = WSP(bf16, WS_VS), *KW = WSP(bf16, WS_KW), *VW = WSP(bf16, WS_VW), *KCC = WSP(bf16, WS_KCC), *VCC = WSP(bf16, WS_VCC);
    const int lrow = tid >> 3, lch = tid & 7;
    const int lwo = lrow * 128 + ((lch ^ (lrow & 7)) << 4);
    v4u rb[4]; f32x4 rf[8]; bool isf32 = false; unsigned ldmask = 0xF;
#define LD_ISSUE(kind, j, hmask) do { isf32 = false; ldmask = 0; \
        _Pragma("unroll") for (int mi = 0; mi < 4; ++mi) { const int hm_ = mi >> 1, isV_ = mi & 1; \
            if (!(((hmask) >> hm_) & 1)) continue; ldmask |= 1u << mi; \
            if ((kind) == 0) { rb[mi] = *(const v4u*)((isV_ ? VCC : KCC) + ((size_t)(seqc * 128 + 64 * (j) + lrow)) * 128 + hm_ * 64 + lch * 8); } \
            else if (!SAMP) { rb[mi] = *(const v4u*)(((kind) == 1 ? (isV_ ? VS : KS) : (isV_ ? VW : KW)) + ((size_t)(sq * SEQ + 64 * (j) + lrow)) * 128 + hm_ * 64 + lch * 8); } \
            else if ((kind) == 1) { \
                if ((j) < 32) { isf32 = true; const float* s_ = F.in[2] + ((size_t)F.page_table[sq * 16 + ((j) >> 1)] * 128 + ((j) & 1) * 64 + lrow) * 512 + (2 + isV_) * 128 + hm_ * 64 + lch * 8; \
                    rf[2 * mi] = *(const f32x4*)s_; rf[2 * mi + 1] = *(const f32x4*)(s_ + 4); } \
                else { rb[mi] = (v4u){0u, 0u, 0u, 0u}; if (lrow < 4) rb[mi] = *(const v4u*)((isV_ ? VS : KS) + ((size_t)(MP + 4 * sq + lrow)) * 128 + hm_ * 64 + lch * 8); } } \
            else { \
                if ((j) < 8) { isf32 = true; const float* s_ = F.in[3] + ((size_t)(sq * 512 + 64 * (j) + lrow)) * 256 + isV_ * 128 + hm_ * 64 + lch * 8; \
                    rf[2 * mi] = *(const f32x4*)s_; rf[2 * mi + 1] = *(const f32x4*)(s_ + 4); } \
                else { rb[mi] = (v4u){0u, 0u, 0u, 0u}; if (lrow < 4) rb[mi] = *(const v4u*)((isV_ ? VW : KW) + ((size_t)(MP + 4 * sq + lrow)) * 128 + hm_ * 64 + lch * 8); } } \
        } } while (0)
#define LD_WRITE(st) do { _Pragma("unroll") for (int mi = 0; mi < 4; ++mi) { if (!((ldmask >> mi) & 1)) continue; v4u v_ = rb[mi]; \
            if (SAMP && isf32) { v_.x = pk2(rf[2 * mi][0], rf[2 * mi][1]); v_.y = pk2(rf[2 * mi][2], rf[2 * mi][3]); v_.z = pk2(rf[2 * mi + 1][0], rf[2 * mi + 1][1]); v_.w = pk2(rf[2 * mi + 1][2], rf[2 * mi + 1][3]); } \
            *(LAS v4u*)(lds + (st) * 32768 + mi * 8192 + lwo) = v_; } } while (0)

    if (SAMP) { const f32x4* src = (const f32x4*)(F.in[3] + ((size_t)sq * 512 + 4) * 256); f32x4* dst = (f32x4*)(F.out + O_WINS + (size_t)sq * 512 * 256);
        for (int i = tid; i < 508 * 64; i += 512) dst[i] = src[i]; }
    for (int i = tid; i < 2 * 32 * 36; i += 512) IMP[i] = 0.f;
    for (int i = tid; i < NT * 24; i += 512) GT[i] = WSP(float, WS_GATES)[(size_t)rowbase * 24 + i];
    LD_ISSUE(0, 0, 3); LD_WRITE(0);
    LD_ISSUE(0, 1, 3); LD_WRITE(1);
    __syncthreads();
    bf16x8 qf[4];
    f32x16 o[2]; float m_run = NEGB, l_run = 0.f;
#pragma unroll
    for (int r = 0; r < 16; ++r) { o[0][r] = 0.f; o[1][r] = 0.f; }
    const size_t qoff = (size_t)(rowbase + tok) * 512 + myhead * 64 + 8 * hi;
#define ATT_TILE(Kt_, Vt_, kbase_, klo_, khi_, rflag_, fast_) do { \
        f32x16 p0, p1; \
        qk_tile(p0, p1, (Kt_), qf, r32, hi); \
        float mx_; \
        if (fast_) {     \
            float mr_ = fmaxf(p0[0], p1[0]); \
            _Pragma("unroll") for (int r = 1; r < 16; ++r) mr_ = fmaxf(mr_, fmaxf(p0[r], p1[r])); \
            mr_ = fmaxf(mr_, __shfl_xor(mr_, 32)); \
            mx_ = (rflag_) ? mr_ * C2S : NEGB; \
        } else mx_ = mask_scale(p0, p1, (kbase_), (klo_), (khi_), (rflag_), hi); \
        const float mnew_ = fmaxf(m_run, mx_); \
        const float alpha_ = ex2(m_run - mnew_); \
        const float msub_ = fmaxf(mnew_, -1e20f); \
        float ls_ = 0.f; \
        if (fast_) { const float nb_ = (rflag_) ? -msub_ : -1e30f; \
            _Pragma("unroll") for (int r = 0; r < 16; ++r) { p0[r] = ex2(fmaf(p0[r], C2S, nb_)); p1[r] = ex2(fmaf(p1[r], C2S, nb_)); ls_ += p0[r] + p1[r]; } } \
        else { _Pragma("unroll") for (int r = 0; r < 16; ++r) { p0[r] = ex2(p0[r] - msub_); p1[r] = ex2(p1[r] - msub_); ls_ += p0[r] + p1[r]; } } \
        l_run = l_run * alpha_ + ls_; m_run = mnew_; \
        if (!__all(alpha_ == 1.0f)) { \
            if (hi == 0) wsf[r32] = alpha_; \
            LDS_WAIT(); \
            _Pragma("unroll") for (int r = 0; r < 16; ++r) { const float a_ = wsf[crow(r, hi)]; o[0][r] *= a_; o[1][r] *= a_; } \
            LDS_WAIT(); \
        } \
        bf16x8 pa_[4]; \
        pack_p(pa_, p0, p1); \
        pv_tile(o, (Vt_), pa_, lane); } while (0)
#define FINALIZE(br) do { const float l_ = l_run + __shfl_xor(l_run, 32); const float inv_ = l_ > 0.f ? 1.f / l_ : 0.f; \
        if (hi == 0) wsf[r32] = inv_; LDS_WAIT(); \
        if (!SAMP || wg == 0) { \
        _Pragma("unroll") for (int r = 0; r < 16; ++r) { const int q = crow(r, hi); \
            if (!SAMP || q < 16) { const int tk = SAMP ? (q & 3) : q, hd = h * 4 + (SAMP ? (q >> 2) : wg); \
            const float f = wsf[q] * GT[tk * 24 + (br) * 8 + hd]; \
            _Pragma("unroll") for (int d0 = 0; d0 < 2; ++d0) { LAS unsigned short* p_ = OA + tk * 512 + hd * 64 + 32 * d0 + r32; \
                float v_ = o[d0][r] * f; if ((br) != 0) v_ += bf2f(*p_); *p_ = (unsigned short)(pk2(v_, 0.f) & 0xffffu); } } } } \
        LDS_WAIT(); } while (0)
    {
        const bf16* Qn = WSP(bf16, WS_QN);
#pragma unroll
        for (int d0 = 0; d0 < 4; ++d0) qf[d0] = *(const bf16x8*)(Qn + qoff + 16 * d0);
        const LAS unsigned char* K0 = lds + (2 * h) * 8192; const LAS unsigned char* V0 = K0 + 8192;
        const int khi = SAMP ? 126 : (qpos >= 31 ? ((qpos - 31) >> 4) : -1);
        ATT_TILE(K0, V0, 0, 0, khi, true, false);
        ATT_TILE(K0 + 32768, V0 + 32768, 64, 0, khi, true, false);
        const float l = l_run + __shfl_xor(l_run, 32);
        const float inv = l > 0.f ? 1.f / l : 0.f;
        const float msub = fmaxf(m_run, -1e20f);
#pragma unroll
        for (int tl = 0; tl < 2; ++tl) {
            f32x16 p0, p1;
            qk_tile(p0, p1, K0 + tl * 32768, qf, r32, hi);
            (void)mask_scale(p0, p1, 64 * tl, 0, khi, true, hi);
            if (!SAMP || (wg == 0 && r32 < 16)) {
                LAS float* ip = IMP + (h * 32 + tok) * 36;
#pragma unroll
                for (int half = 0; half < 2; ++half) {
#pragma unroll
                    for (int rq = 0; rq < 4; ++rq) {
                        const f32x16& X = half == 0 ? p0 : p1;
                        const float e0 = ex2(X[4 * rq] - msub), e1 = ex2(X[4 * rq + 1] - msub), e2 = ex2(X[4 * rq + 2] - msub), e3 = ex2(X[4 * rq + 3] - msub);
                        const float last = e3 * inv;
                        const float G = ((e0 + e1) + (e2 + e3)) * inv;
                        const int jj = 8 * (2 * tl + half) + 2 * rq + hi;
                        [[clang::atomic(ignore_denormal_mode)]] { (void)__hip_atomic_fetch_add(ip + jj, G, __ATOMIC_RELAXED, __HIP_MEMORY_SCOPE_WORKGROUP); (void)__hip_atomic_fetch_add(ip + jj + 1, last, __ATOMIC_RELAXED, __HIP_MEMORY_SCOPE_WORKGROUP); }
                    }
                }
            }
        }
        FINALIZE(0);
    }
    __syncthreads();
    {
        const bf16* Qr = WSP(bf16, WS_QR);
#pragma unroll
        for (int d0 = 0; d0 < 4; ++d0) qf[d0] = *(const bf16x8*)(Qr + qoff + 16 * d0);
        LD_ISSUE(1, 0, 3);
    }
    {
        const int nit = SAMP ? 1 : 4;
        for (int it = 0; it < nit; ++it) {
            const int tk = SAMP ? (hi + 2 * (w & 1)) : (wg * 8 + 2 * it + hi);
            const bool act = SAMP ? (wg < 2) : true;
            const int j = r32;
            const LAS float* ip = IMP + (h * 32 + tk) * 36;
            const float my = ip[j];
            const bool valid = j <= cur, forced = (j == 0) || (j == cur) || (j == cur - 1);
            const int nforced = cur == 0 ? 1 : (cur == 1 ? 2 : 3);
            const int quota = 16 - nforced;
            int cnt = 0;
            for (int i = 0; i < 32; ++i) { const float v = ip[i];
                const bool cand = (i <= cur) && !((i == 0) || (i == cur) || (i == cur - 1));
                cnt += (cand && (v > my || (v == my && i < j))) ? 1 : 0; }
            const bool selb = valid && (forced || cnt < quota);
            const unsigned long long bal = __ballot(selb);
            unsigned long long msk = hi ? (bal >> 32) : (bal & 0xffffffffull);
            if (SAMP) msk |= 1ull << 32;
            if (act && r32 == 0) SEL[h * 32 + tk] = msk;
        }
    }
    __syncthreads();
    const unsigned long long mysel = SEL[h * 32 + tok];
    unsigned long long U0 = 0ull, U1 = 0ull;
    if (SAMP) { for (int i = 0; i < NT; ++i) { U0 |= SEL[i]; U1 |= SEL[32 + i]; } }
    const unsigned long long Uall = SAMP ? (U0 | U1) : ((2ull << cur) - 1ull), Uh = SAMP ? (h ? U1 : U0) : ~0ull;
    const int wlo = SAMP ? 0 : ((q0 - 511) > 0 ? ((q0 - 511) >> 6) : 0), whi = SAMP ? 8 : ((q0 + 31) >> 6);
    int skind = 1; m_run = NEGB; l_run = 0.f;
#pragma unroll
    for (int r = 0; r < 16; ++r) { o[0][r] = 0.f; o[1][r] = 0.f; }
#define HM_OF(code) ((code) < 64 ? (SAMP ? (unsigned)(((U0 >> (code)) & 1ull) | (((U1 >> (code)) & 1ull) << 1)) : 3u) : 3u)
    int code = 0, st = 0;
    LD_WRITE(0);
    __syncthreads();
    for (;;) {
        int nxt;
        if (code < 64) { const unsigned long long mm = (code >= 63) ? 0ull : (Uall >> (code + 1)); nxt = mm ? code + 1 + __builtin_ctzll(mm) : 64 + wlo; if (nxt < 64 && nxt > cur) nxt = 64 + wlo; }
        else nxt = (code + 1 - 64 <= whi) ? code + 1 : -1;
        if (nxt >= 0) { const unsigned hm = HM_OF(nxt); if (nxt < 64) { LD_ISSUE(1, nxt, hm); } else { LD_ISSUE(2, nxt - 64, hm); } }
        {
            const int kind = code < 64 ? 1 : 2, j = code < 64 ? code : code - 64;
            if (kind != skind) { FINALIZE(1); m_run = NEGB; l_run = 0.f;
#pragma unroll
                for (int r = 0; r < 16; ++r) { o[0][r] = 0.f; o[1][r] = 0.f; }
                skind = kind; }
            const bool need = kind == 2 || ((Uh >> j) & 1ull);
            if (need) {
                const LAS unsigned char* Kt = lds + st * 32768 + (2 * h) * 8192; const LAS unsigned char* Vt = Kt + 8192;
                int kbase, klo, khi; bool rflag;
                if (kind == 1) { kbase = (SAMP && j == 32) ? SEQ : 64 * j; klo = -(1 << 30); khi = qpos; rflag = (mysel >> j) & 1ull; }
                else { kbase = SAMP ? (j < 8 ? 1536 + 64 * j : SEQ) : 64 * j; klo = qpos - 511; khi = qpos; rflag = true; }
                bool fast;
                if (kind == 1) fast = j < cur;
                else fast = SAMP ? (j >= 1 && j < 8) : (kbase >= q0 + 31 - 511 && kbase + 63 <= q0);
                ATT_TILE(Kt, Vt, kbase, klo, khi, rflag, fast);
            }
        }
        if (nxt >= 0) LD_WRITE(st ^ 1);
        __syncthreads();
        if (nxt < 0) break;
        code = nxt; st ^= 1;
    }
    FINALIZE(2);
#undef HM_OF
#undef FINALIZE
#undef ATT_TILE
#undef LD_ISSUE
#undef LD_WRITE
    __syncthreads();
    {
        bf16* MIX = WSP(bf16, WS_MIXED);
        const int ntk = SAMP ? (w < 4 ? 1 : 0) : 4;
        const f32x4 ga0 = *(const f32x4*)(F.in[14] + lane * 8), ga1 = *(const f32x4*)(F.in[14] + lane * 8 + 4);
        const f32x4 gr0 = *(const f32x4*)(F.in[15] + lane * 8), gr1 = *(const f32x4*)(F.in[15] + lane * 8 + 4);
        f32x4 c0 = (f32x4){0.f, 0.f, 0.f, 0.f}, c1 = c0;
        if (!SAMP) { const int cch = q0 >> 6; const float* sm = WSP(float, WS_SUMM) + (size_t)sq * 32 * 1024 + lane * 8;
#pragma unroll 4
            for (int cc = 0; cc < cch; ++cc) { const f32x4 h0 = *(const f32x4*)(sm + cc * 1024), h1 = *(const f32x4*)(sm + cc * 1024 + 4), a0 = *(const f32x4*)(sm + cc * 1024 + 512), a1 = *(const f32x4*)(sm + cc * 1024 + 516);
                c0 = a0 * c0 + h0; c1 = a1 * c1 + h1; } }
#pragma unroll
        for (int it = 0; it < (SAMP ? 1 : 4); ++it) { if (it >= ntk) break;
            const int tk = SAMP ? w : 4 * w + it; const size_t row = (size_t)rowbase + tk;
            { const v4u pk = *(const LAS v4u*)(lds + A_OA + tk * 1024 + lane * 16);
              float v[8] = {bflo(pk.x), bfhi(pk.x), bflo(pk.y), bfhi(pk.y), bflo(pk.z), bfhi(pk.z), bflo(pk.w), bfhi(pk.w)};
              float ss = 0.f;
#pragma unroll
              for (int i = 0; i < 8; ++i) ss += v[i] * v[i];
              const float rs = rsqrtf(wave_sum(ss) * (1.f / 512.f) + EPSN);
              v4u o; o.x = pk2(v[0] * rs * ga0[0], v[1] * rs * ga0[1]); o.y = pk2(v[2] * rs * ga0[2], v[3] * rs * ga0[3]); o.z = pk2(v[4] * rs * ga1[0], v[5] * rs * ga1[1]); o.w = pk2(v[6] * rs * ga1[2], v[7] * rs * ga1[3]);
              *(v4u*)(MIX + row * 1024 + lane * 8) = o; }
            { const float* hl = WSP(float, WS_HL) + row * 512 + lane * 8; const float* ac = WSP(float, WS_AC) + row * 512 + lane * 8;
              const f32x4 h0 = *(const f32x4*)hl + *(const f32x4*)ac * c0, h1 = *(const f32x4*)(hl + 4) + *(const f32x4*)(ac + 4) * c1;
              if (!SAMP && q0 + tk == SEQ - 1) { float* hp = F.out + O_HP + (size_t)sq * 512 + lane * 8; *(f32x4*)hp = h0; *(f32x4*)(hp + 4) = h1; }
              const v4u pk = *(const v4u*)(WSP(bf16, WS_GRG) + row * 512 + lane * 8);
              float v[8] = {bflo(pk.x) * h0[0], bfhi(pk.x) * h0[1], bflo(pk.y) * h0[2], bfhi(pk.y) * h0[3], bflo(pk.z) * h1[0], bfhi(pk.z) * h1[1], bflo(pk.w) * h1[2], bfhi(pk.w) * h1[3]};
              float ss = 0.f;
#pragma unroll
              for (int i = 0; i < 8; ++i) ss += v[i] * v[i];
              const float rs = rsqrtf(wave_sum(ss) * (1.f / 512.f) + EPSN);
              v4u o; o.x = pk2(v[0] * rs * gr0[0], v[1] * rs * gr0[1]); o.y = pk2(v[2] * rs * gr0[2], v[3] * rs * gr0[3]); o.z = pk2(v[4] * rs * gr1[0], v[5] * rs * gr1[1]); o.w = pk2(v[6] * rs * gr1[2], v[7] * rs * gr1[3]);
              *(v4u*)(MIX + row * 1024 + 512 + lane * 8) = o; }
        }
    }
    __syncthreads();
}

constexpr int P_OA = 98304, P_IMP = 131072, P_SEL = 140288, P_GT = 140800, P_WSF = 143872;
__device__ __forceinline__ void attn_unit_p(Frame& F, int sq, int qb) {
    int tid = F.tid; asm volatile("" : "+v"(tid));
    const int lane = tid & 63, w = F.wave, r32 = lane & 31, hi = lane >> 5, h = w >> 2, wg = w & 3;
    const int q0 = qb * 32, rowbase = sq * SEQ + q0, qpos = q0 + r32, cur = q0 >> 6;
    LAS unsigned char* lds = F.lds;
    LAS float* IMP = (LAS float*)(lds + P_IMP);
    LAS unsigned long long* SEL = (LAS unsigned long long*)(lds + P_SEL);
    LAS float* GT = (LAS float*)(lds + P_GT);
    LAS float* wsf = (LAS float*)(lds + P_WSF) + w * 64;
    LAS unsigned short* OA = (LAS unsigned short*)(lds + P_OA);
    const int drow = 8 * w + (lane >> 3);
    const int dsrc = drow * 128 + (((lane & 7) ^ (lane >> 3)) << 3);
    const bf16* kcc = WSP(bf16, WS_KCC) + (size_t)sq * 128 * 128 + dsrc; const bf16* vcc = WSP(bf16, WS_VCC) + (size_t)sq * 128 * 128 + dsrc;
    const bf16* ksb = WSP(bf16, WS_KS) + (size_t)sq * SEQ * 128 + dsrc; const bf16* vsb = WSP(bf16, WS_VS) + (size_t)sq * SEQ * 128 + dsrc;
    const bf16* kwb = WSP(bf16, WS_KW) + (size_t)sq * SEQ * 128 + dsrc; const bf16* vwb = WSP(bf16, WS_VW) + (size_t)sq * SEQ * 128 + dsrc;
#define DMA_TILE(kp_, vp_, j_, st_) do { const bf16* k_ = (kp_) + (size_t)(j_) * 8192; const bf16* v_ = (vp_) + (size_t)(j_) * 8192; LAS unsigned char* d_ = lds + (st_) * 32768 + w * 1024; \
        __builtin_amdgcn_global_load_lds((const unsigned*)k_, (LAS unsigned*)d_, 16, 0, 0); \
        __builtin_amdgcn_global_load_lds((const unsigned*)v_, (LAS unsigned*)(d_ + 8192), 16, 0, 0); \
        __builtin_amdgcn_global_load_lds((const unsigned*)(k_ + 64), (LAS unsigned*)(d_ + 16384), 16, 0, 0); \
        __builtin_amdgcn_global_load_lds((const unsigned*)(v_ + 64), (LAS unsigned*)(d_ + 24576), 16, 0, 0); } while (0)
#define DMA_CODE(code_, st_) do { if ((code_) < 64) DMA_TILE(ksb, vsb, (code_), (st_)); else DMA_TILE(kwb, vwb, (code_) - 64, (st_)); } while (0)
#define WAITV(n) asm volatile("s_waitcnt vmcnt(" #n ")" ::: "memory")
#define RAWBAR() do { asm volatile("s_waitcnt lgkmcnt(0)" ::: "memory"); __builtin_amdgcn_s_barrier(); asm volatile("" ::: "memory"); } while (0)
    for (int i = tid; i < 2 * 32 * 36; i += 512) IMP[i] = 0.f;
    for (int i = tid; i < 32 * 24; i += 512) GT[i] = WSP(float, WS_GATES)[(size_t)rowbase * 24 + i];
    DMA_TILE(kcc, vcc, 0, 0); DMA_TILE(kcc, vcc, 1, 1);
    bf16x8 qf[4];
    const size_t qoff = (size_t)(rowbase + r32) * 512 + (h * 4 + wg) * 64 + 8 * hi;
    { const bf16* Qn = WSP(bf16, WS_QN);
#pragma unroll
      for (int d0 = 0; d0 < 4; ++d0) qf[d0] = *(const bf16x8*)(Qn + qoff + 16 * d0); }
    WAITV(0); RAWBAR();
    f32x16 o[2]; float m_run = NEGB, l_run = 0.f;
#pragma unroll
    for (int r = 0; r < 16; ++r) { o[0][r] = 0.f; o[1][r] = 0.f; }
#define ATT_TILE(Kt_, Vt_, kbase_, klo_, khi_, rflag_, fast_) do { \
        f32x16 p0, p1; \
        qk_tile(p0, p1, (Kt_), qf, r32, hi); \
        float mx_; \
        if (fast_) { \
            float mr_ = fmaxf(p0[0], p1[0]); \
            _Pragma("unroll") for (int r = 1; r < 16; ++r) mr_ = fmaxf(mr_, fmaxf(p0[r], p1[r])); \
            mr_ = fmaxf(mr_, __shfl_xor(mr_, 32)); \
            mx_ = (rflag_) ? mr_ * C2S : NEGB; \
        } else mx_ = mask_scale(p0, p1, (kbase_), (klo_), (khi_), (rflag_), hi); \
        const float mnew_ = fmaxf(m_run, mx_); \
        const float alpha_ = ex2(m_run - mnew_); \
        const float msub_ = fmaxf(mnew_, -1e20f); \
        float ls_ = 0.f; \
        if (fast_) { const float nb_ = (rflag_) ? -msub_ : -1e30f; \
            _Pragma("unroll") for (int r = 0; r < 16; ++r) { p0[r] = ex2(fmaf(p0[r], C2S, nb_)); p1[r] = ex2(fmaf(p1[r], C2S, nb_)); ls_ += p0[r] + p1[r]; } } \
        else { _Pragma("unroll") for (int r = 0; r < 16; ++r) { p0[r] = ex2(p0[r] - msub_); p1[r] = ex2(p1[r] - msub_); ls_ += p0[r] + p1[r]; } } \
        l_run = l_run * alpha_ + ls_; m_run = mnew_; \
        if (!__all(alpha_ == 1.0f)) { \
            if (hi == 0) wsf[r32] = alpha_; \
            LDS_WAIT(); \
            _Pragma("unroll") for (int r = 0; r < 16; ++r) { const float a_ = wsf[crow(r, hi)]; o[0][r] *= a_; o[1][r] *= a_; } \
            LDS_WAIT(); \
        } \
        bf16x8 pa_[4]; \
        pack_p(pa_, p0, p1); \
        pv_tile(o, (Vt_), pa_, lane); } while (0)
#define FINALIZE(br) do { const float l_ = l_run + __shfl_xor(l_run, 32); const float inv_ = l_ > 0.f ? 1.f / l_ : 0.f; \
        if (hi == 0) wsf[r32] = inv_; LDS_WAIT(); \
        _Pragma("unroll") for (int r = 0; r < 16; ++r) { const int q = crow(r, hi); const int hd = h * 4 + wg; \
            const float f = wsf[q] * GT[q * 24 + (br) * 8 + hd]; \
            _Pragma("unroll") for (int d0 = 0; d0 < 2; ++d0) { LAS unsigned short* p_ = OA + q * 512 + hd * 64 + 32 * d0 + r32; \
                float v_ = o[d0][r] * f; if ((br) != 0) v_ += bf2f(*p_); *p_ = (unsigned short)(pk2(v_, 0.f) & 0xffffu); } } \
        LDS_WAIT(); } while (0)
#ifndef CMP_PASSES
#define CMP_PASSES 1
#endif
    for (int cpass = 0; cpass < CMP_PASSES; ++cpass) { m_run = NEGB; l_run = 0.f;
#pragma unroll
    for (int r = 0; r < 16; ++r) { o[0][r] = 0.f; o[1][r] = 0.f; }
    {
        const LAS unsigned char* K0 = lds + (2 * h) * 8192; const LAS unsigned char* V0 = K0 + 8192;
        const int khi = qpos >= 31 ? ((qpos - 31) >> 4) : -1;
        ATT_TILE(K0, V0, 0, 0, khi, true, false);
        ATT_TILE(K0 + 32768, V0 + 32768, 64, 0, khi, true, false);
        const float l = l_run + __shfl_xor(l_run, 32);
        const float inv = l > 0.f ? 1.f / l : 0.f;
        const float msub = fmaxf(m_run, -1e20f);
        float Gv[16], Lv[16];
#pragma unroll
        for (int tl = 0; tl < 2; ++tl) {
            f32x16 p0, p1;
            qk_tile(p0, p1, K0 + tl * 32768, qf, r32, hi);
            (void)mask_scale(p0, p1, 64 * tl, 0, khi, true, hi);
#pragma unroll
            for (int half = 0; half < 2; ++half) {
#pragma unroll
                for (int rq = 0; rq < 4; ++rq) {
                    const f32x16& X = half == 0 ? p0 : p1;
                    const float e0 = ex2(X[4 * rq] - msub), e1 = ex2(X[4 * rq + 1] - msub), e2 = ex2(X[4 * rq + 2] - msub), e3 = ex2(X[4 * rq + 3] - msub);
                    Lv[4 * (2 * tl + half) + rq] = e3 * inv;
                    Gv[4 * (2 * tl + half) + rq] = ((e0 + e1) + (e2 + e3)) * inv;
                }
            }
        }
        {
            LAS float* R = (LAS float*)(lds + 65536) + (h * 4 + wg) * 1024 + r32;
            float prev = 0.f;
#pragma unroll
            for (int jl = 0; jl < 16; ++jl) {
                const float pl = __shfl_xor(Lv[jl], 32);
                const float add = hi ? pl : prev;
                R[(2 * jl + hi) * 32] = Gv[jl] + add;
                prev = pl;
            }
        }
        FINALIZE(0);
    }
    }
    RAWBAR();
    const int wlo = (q0 - 511) > 0 ? ((q0 - 511) >> 6) : 0, whi = (q0 + 31) >> 6;
#define NEXT_CODE(c_) ((c_) < 0 ? -1 : ((c_) < 64 ? ((c_) < cur ? (c_) + 1 : 64 + wlo) : ((c_) - 64 < whi ? (c_) + 1 : -1)))
    int code = 0, n1 = NEXT_CODE(0), n2;
    DMA_CODE(0, 0);
    DMA_CODE(n1, 1);
    {   const bf16* Qr = WSP(bf16, WS_QR);
#pragma unroll
        for (int d0 = 0; d0 < 4; ++d0) qf[d0] = *(const bf16x8*)(Qr + qoff + 16 * d0); }
    {   const int tk = tid & 31, jg = (tid >> 5) & 7, hh = tid >> 8;
        const LAS float* R = (const LAS float*)(lds + 65536) + hh * 4096 + tk;
#pragma unroll
        for (int k = 0; k < 4; ++k) { const int j = 4 * jg + k;
            IMP[(hh * 32 + tk) * 36 + j] = (R[j * 32] + R[1024 + j * 32]) + (R[2048 + j * 32] + R[3072 + j * 32]); } }
    RAWBAR();
    for (int it = 0; it < 4; ++it) {
        const int tk = wg * 8 + 2 * it + hi, j = r32;
        const LAS float* ip = IMP + (h * 32 + tk) * 36;
        const float my = ip[j];
        const bool valid = j <= cur, forced = (j == 0) || (j == cur) || (j == cur - 1);
        const int quota = 16 - (cur == 0 ? 1 : (cur == 1 ? 2 : 3));
        int cnt = 0;
        for (int i = 0; i < 32; ++i) { const float v = ip[i];
            const bool cand = (i <= cur) && !((i == 0) || (i == cur) || (i == cur - 1));
            cnt += (cand && (v > my || (v == my && i < j))) ? 1 : 0; }
        const bool selb = valid && (forced || cnt < quota);
        const unsigned long long bal = __ballot(selb);
        if (r32 == 0) SEL[h * 32 + tk] = hi ? (bal >> 32) : (bal & 0xffffffffull);
    }
    WAITV(4); RAWBAR();
    const unsigned mysel = (unsigned)SEL[h * 32 + r32];
#ifndef LOOP_PASSES
#define LOOP_PASSES 1
#endif
    for (int pass = 0; pass < LOOP_PASSES; ++pass) {
    if (pass > 0) { code = 0; n1 = NEXT_CODE(0); DMA_CODE(0, 0); DMA_CODE(n1, 1); WAITV(4); RAWBAR(); }
    int skind = 1, st = 0; m_run = NEGB; l_run = 0.f;
#pragma unroll
    for (int r = 0; r < 16; ++r) { o[0][r] = 0.f; o[1][r] = 0.f; }
    for (;;) {
        n2 = NEXT_CODE(n1);
        const int st2 = st >= 1 ? st - 1 : 2;
        if (n2 >= 0) DMA_CODE(n2, st2);
        {
            const int kind = code < 64 ? 1 : 2, j = code < 64 ? code : code - 64;
            if (kind != skind) { if (pass == LOOP_PASSES - 1) FINALIZE(1); m_run = NEGB; l_run = 0.f;
#pragma unroll
                for (int r = 0; r < 16; ++r) { o[0][r] = 0.f; o[1][r] = 0.f; }
                skind = kind; }
            const LAS unsigned char* Kt = lds + st * 32768 + (2 * h) * 8192; const LAS unsigned char* Vt = Kt + 8192;
            const int kbase = 64 * j, khi = qpos;
            int klo; bool rflag, fast;
            if (kind == 1) { klo = -(1 << 30); rflag = (mysel >> j) & 1u; fast = j < cur; }
            else { klo = qpos - 511; rflag = true; fast = (kbase >= q0 + 31 - 511 && kbase + 63 <= q0); }
            ATT_TILE(Kt, Vt, kbase, klo, khi, rflag, fast);
        }
        if (n1 < 0) break;
        if (n2 >= 0) WAITV(4); else WAITV(0);
        RAWBAR();
        code = n1; n1 = n2; st = st == 2 ? 0 : st + 1;
    }
    if (pass == LOOP_PASSES - 1) FINALIZE(2);
    RAWBAR();
    }
#undef NEXT_CODE
#undef FINALIZE
#undef ATT_TILE
#undef DMA_CODE
#undef DMA_TILE
    RAWBAR();
#ifndef NORM_PASSES
#define NORM_PASSES 1
#endif
    for (int npass = 0; npass < NORM_PASSES; ++npass) {
        bf16* MIX = WSP(bf16, WS_MIXED);
        const f32x4 ga0 = *(const f32x4*)(F.in[14] + lane * 8), ga1 = *(const f32x4*)(F.in[14] + lane * 8 + 4);
        const f32x4 gr0 = *(const f32x4*)(F.in[15] + lane * 8), gr1 = *(const f32x4*)(F.in[15] + lane * 8 + 4);
        f32x4 c0 = (f32x4){0.f, 0.f, 0.f, 0.f}, c1 = c0;
        { const float* cr = WSP(float, WS_CARRY) + ((size_t)sq * 32 + cur) * 512 + lane * 8; c0 = *(const f32x4*)cr; c1 = *(const f32x4*)(cr + 4); }
#pragma unroll
        for (int it = 0; it < 4; ++it) {
            const int tk = 4 * w + it; const size_t row = (size_t)rowbase + tk;
            { const v4u pk = *(const LAS v4u*)(lds + P_OA + tk * 1024 + lane * 16);
              float v[8] = {bflo(pk.x), bfhi(pk.x), bflo(pk.y), bfhi(pk.y), bflo(pk.z), bfhi(pk.z), bflo(pk.w), bfhi(pk.w)};
              float ss = 0.f;
#pragma unroll
              for (int i = 0; i < 8; ++i) ss += v[i] * v[i];
              const float rs = rsqrtf(wave_sum(ss) * (1.f / 512.f) + EPSN);
              v4u ov; ov.x = pk2(v[0] * rs * ga0[0], v[1] * rs * ga0[1]); ov.y = pk2(v[2] * rs * ga0[2], v[3] * rs * ga0[3]); ov.z = pk2(v[4] * rs * ga1[0], v[5] * rs * ga1[1]); ov.w = pk2(v[6] * rs * ga1[2], v[7] * rs * ga1[3]);
              *(v4u*)(MIX + row * 1024 + lane * 8) = ov; }
            { const float* hl = WSP(float, WS_HL) + row * 512 + lane * 8; const float* ac = WSP(float, WS_AC) + row * 512 + lane * 8;
              const f32x4 h0 = *(const f32x4*)hl + *(const f32x4*)ac * c0, h1 = *(const f32x4*)(hl + 4) + *(const f32x4*)(ac + 4) * c1;
              if (q0 + tk == SEQ - 1) { float* hp = F.out + O_HP + (size_t)sq * 512 + lane * 8; *(f32x4*)hp = h0; *(f32x4*)(hp + 4) = h1; }
              const v4u pk = *(const v4u*)(WSP(bf16, WS_GRG) + row * 512 + lane * 8);
              float v[8] = {bflo(pk.x) * h0[0], bfhi(pk.x) * h0[1], bflo(pk.y) * h0[2], bfhi(pk.y) * h0[3], bflo(pk.z) * h1[0], bfhi(pk.z) * h1[1], bflo(pk.w) * h1[2], bfhi(pk.w) * h1[3]};
              float ss = 0.f;
#pragma unroll
              for (int i = 0; i < 8; ++i) ss += v[i] * v[i];
              const float rs = rsqrtf(wave_sum(ss) * (1.f / 512.f) + EPSN);
              v4u ov; ov.x = pk2(v[0] * rs * gr0[0], v[1] * rs * gr0[1]); ov.y = pk2(v[2] * rs * gr0[2], v[3] * rs * gr0[3]); ov.z = pk2(v[4] * rs * gr1[0], v[5] * rs * gr1[1]); ov.w = pk2(v[6] * rs * gr1[2], v[7] * rs * gr1[3]);
              *(v4u*)(MIX + row * 1024 + 512 + lane * 8) = ov; }
        }
    }
    WAITV(0); RAWBAR();
#undef WAITV
#undef RAWBAR
}

constexpr int S_PART = 65536, S_IMPG = 117760, S_IMPL = 118912, S_SEL = 120064, S_GT = 120128, S_WSF = 120512, S_OA = 122560;
__device__ __forceinline__ void attn_unit_s(Frame& F, int s) {
    int tid = F.tid; asm volatile("" : "+v"(tid));
    const int lane = tid & 63, w = F.wave, r32 = lane & 31, hi = lane >> 5, h = w & 1;
    const bool cw = w < 2, ldr = w >= 4;
    const int tok = r32 & 3, g = (r32 >> 2) & 3, qpos = SEQ + tok;
    LAS unsigned char* lds = F.lds;
    LAS float* IMPG = (LAS float*)(lds + S_IMPG) + h * 144; LAS float* IMPL = (LAS float*)(lds + S_IMPL) + h * 144;
    LAS unsigned long long* SEL = (LAS unsigned long long*)(lds + S_SEL);
    LAS float* GT = (LAS float*)(lds + S_GT);
    LAS float* wsf = (LAS float*)(lds + S_WSF) + w * 64;
    LAS float* OA = (LAS float*)(lds + S_OA);
    const int lt = tid & 255, lrow = lt >> 2, lq = lt & 3;
    const int lwo0 = lrow * 128 + (((2 * lq) ^ (lrow & 7)) << 4), lwo1 = lrow * 128 + (((2 * lq + 1) ^ (lrow & 7)) << 4);
    const float* cache = F.in[2]; const float* cwin = F.in[3]; const int* pt = F.page_table + s * 16;
    f32x4 rs[3][4][4];
    unsigned fm[3]; int cpw[3];
#define S_ISSUE(k_, code_) do { if (ldr) { const int c_ = (code_); fm[k_] = (c_ < 32 || (c_ >= 64 && c_ < 72)) ? 1u : 0u; cpw[k_] = (c_ >= 64 && c_ < 72) ? c_ - 64 : -1; \
        _Pragma("unroll") for (int mi = 0; mi < 4; ++mi) { const int isV_ = mi & 1, colo_ = (mi >> 1) * 64 + 16 * lq; \
            if (c_ >= 100) { const v4u* s_ = (const v4u*)((isV_ ? WSP(bf16, WS_VCC) : WSP(bf16, WS_KCC)) + ((size_t)((8 + s) * 128 + 64 * (c_ - 100) + lrow)) * 128 + colo_); \
                rs[k_][mi][0] = __builtin_bit_cast(f32x4, s_[0]); rs[k_][mi][1] = __builtin_bit_cast(f32x4, s_[1]); } \
            else if (c_ < 32) { const f32x4* s_ = (const f32x4*)(cache + ((size_t)pt[c_ >> 1] * 128 + (c_ & 1) * 64 + lrow) * 512 + (2 + isV_) * 128 + colo_); \
                rs[k_][mi][0] = s_[0]; rs[k_][mi][1] = s_[1]; rs[k_][mi][2] = s_[2]; rs[k_][mi][3] = s_[3]; } \
            else if (c_ == 32) { rs[k_][mi][0] = (f32x4){0.f, 0.f, 0.f, 0.f}; rs[k_][mi][1] = rs[k_][mi][0]; \
                if (lrow < 4) { const v4u* s_ = (const v4u*)((isV_ ? WSP(bf16, WS_VS) : WSP(bf16, WS_KS)) + ((size_t)(MP + 4 * s + lrow)) * 128 + colo_); rs[k_][mi][0] = __builtin_bit_cast(f32x4, s_[0]); rs[k_][mi][1] = __builtin_bit_cast(f32x4, s_[1]); } } \
            else if (c_ < 72) { const f32x4* s_ = (const f32x4*)(cwin + ((size_t)(s * 512 + 64 * (c_ - 64) + lrow)) * 256 + isV_ * 128 + colo_); \
                rs[k_][mi][0] = s_[0]; rs[k_][mi][1] = s_[1]; rs[k_][mi][2] = s_[2]; rs[k_][mi][3] = s_[3]; } \
            else { rs[k_][mi][0] = (f32x4){0.f, 0.f, 0.f, 0.f}; rs[k_][mi][1] = rs[k_][mi][0]; \
                if (lrow < 4) { const v4u* s_ = (const v4u*)((isV_ ? WSP(bf16, WS_VW) : WSP(bf16, WS_KW)) + ((size_t)(MP + 4 * s + lrow)) * 128 + colo_); rs[k_][mi][0] = __builtin_bit_cast(f32x4, s_[0]); rs[k_][mi][1] = __builtin_bit_cast(f32x4, s_[1]); } } \
        } } } while (0)
#define S_WRITE(k_, st_) do { if (ldr) { _Pragma("unroll") for (int mi = 0; mi < 4; ++mi) { \
            v4u v0_ = __builtin_bit_cast(v4u, rs[k_][mi][0]), v1_ = __builtin_bit_cast(v4u, rs[k_][mi][1]); \
            if (fm[k_]) { \
                v0_.x = pk2(rs[k_][mi][0][0], rs[k_][mi][0][1]); v0_.y = pk2(rs[k_][mi][0][2], rs[k_][mi][0][3]); v0_.z = pk2(rs[k_][mi][1][0], rs[k_][mi][1][1]); v0_.w = pk2(rs[k_][mi][1][2], rs[k_][mi][1][3]); \
                v1_.x = pk2(rs[k_][mi][2][0], rs[k_][mi][2][1]); v1_.y = pk2(rs[k_][mi][2][2], rs[k_][mi][2][3]); v1_.z = pk2(rs[k_][mi][3][0], rs[k_][mi][3][1]); v1_.w = pk2(rs[k_][mi][3][2], rs[k_][mi][3][3]); \
                if (cpw[k_] >= 0) { const int jr_ = 64 * cpw[k_] + lrow; if (jr_ >= 4) { f32x4* d_ = (f32x4*)(F.out + O_WINS + ((size_t)(s * 512 + jr_ - 4)) * 256 + (mi & 1) * 128 + (mi >> 1) * 64 + 16 * lq); \
                    d_[0] = rs[k_][mi][0]; d_[1] = rs[k_][mi][1]; d_[2] = rs[k_][mi][2]; d_[3] = rs[k_][mi][3]; } } } \
            *(LAS v4u*)(lds + (st_) * 32768 + mi * 8192 + lwo0) = v0_; *(LAS v4u*)(lds + (st_) * 32768 + mi * 8192 + lwo1) = v1_; } } } while (0)
    if (tid < 96) GT[tid] = WSP(float, WS_GATES)[(size_t)(MP + 4 * s) * 24 + tid];
    if (tid < 288) { ((LAS float*)(lds + S_IMPG))[tid] = 0.f; ((LAS float*)(lds + S_IMPL))[tid] = 0.f; }
    S_ISSUE(0, 100); S_ISSUE(1, 101); S_WRITE(0, 0); S_WRITE(1, 1);
    bf16x8 qf[4];
    const size_t qoff = (size_t)(MP + 4 * s + tok) * 512 + (h * 4 + g) * 64 + 8 * hi;
    { const bf16* Qn = WSP(bf16, WS_QN);
#pragma unroll
      for (int d0 = 0; d0 < 4; ++d0) qf[d0] = *(const bf16x8*)(Qn + qoff + 16 * d0); }
    __syncthreads();
    f32x16 o[2]; float m_run = NEGB, l_run = 0.f;
#pragma unroll
    for (int r = 0; r < 16; ++r) { o[0][r] = 0.f; o[1][r] = 0.f; }
#define ATT_TILE(Kt_, Vt_, kbase_, klo_, khi_, rflag_, fast_) do { \
        f32x16 p0, p1; \
        qk_tile(p0, p1, (Kt_), qf, r32, hi); \
        float mx_; \
        if (fast_) { \
            float mr_ = fmaxf(p0[0], p1[0]); \
            _Pragma("unroll") for (int r = 1; r < 16; ++r) mr_ = fmaxf(mr_, fmaxf(p0[r], p1[r])); \
            mr_ = fmaxf(mr_, __shfl_xor(mr_, 32)); \
            mx_ = (rflag_) ? mr_ * C2S : NEGB; \
        } else mx_ = mask_scale(p0, p1, (kbase_), (klo_), (khi_), (rflag_), hi); \
        const float mnew_ = fmaxf(m_run, mx_); \
        const float alpha_ = ex2(m_run - mnew_); \
        const float msub_ = fmaxf(mnew_, -1e20f); \
        float ls_ = 0.f; \
        if (fast_) { const float nb_ = (rflag_) ? -msub_ : -1e30f; \
            _Pragma("unroll") for (int r = 0; r < 16; ++r) { p0[r] = ex2(fmaf(p0[r], C2S, nb_)); p1[r] = ex2(fmaf(p1[r], C2S, nb_)); ls_ += p0[r] + p1[r]; } } \
        else { _Pragma("unroll") for (int r = 0; r < 16; ++r) { p0[r] = ex2(p0[r] - msub_); p1[r] = ex2(p1[r] - msub_); ls_ += p0[r] + p1[r]; } } \
        l_run = l_run * alpha_ + ls_; m_run = mnew_; \
        if (!__all(alpha_ == 1.0f)) { \
            if (hi == 0) wsf[r32] = alpha_; \
            LDS_WAIT(); \
            _Pragma("unroll") for (int r = 0; r < 16; ++r) { const float a_ = wsf[crow(r, hi)]; o[0][r] *= a_; o[1][r] *= a_; } \
            LDS_WAIT(); \
        } \
        bf16x8 pa_[4]; \
        pack_p(pa_, p0, p1); \
        pv_tile(o, (Vt_), pa_, lane); } while (0)
#define FINALIZE(br) do { if (cw) { const float l_ = l_run + __shfl_xor(l_run, 32); const float inv_ = l_ > 0.f ? 1.f / l_ : 0.f; \
        if (hi == 0) wsf[r32] = inv_; LDS_WAIT(); \
        _Pragma("unroll") for (int r = 0; r < 16; ++r) { const int q = crow(r, hi); \
            if (q < 16) { const float f = wsf[q] * GT[(q & 3) * 24 + (br) * 8 + h * 4 + (q >> 2)]; \
            _Pragma("unroll") for (int d0 = 0; d0 < 2; ++d0) { LAS float* p_ = OA + h * 1024 + (q & 3) * 256 + (q >> 2) * 64 + 32 * d0 + r32; \
                float v_ = o[d0][r] * f; if ((br) != 0) v_ += *p_; *p_ = v_; } } } \
        LDS_WAIT(); } } while (0)
    if (cw) {
        const LAS unsigned char* K0 = lds + (2 * h) * 8192; const LAS unsigned char* V0 = K0 + 8192;
        ATT_TILE(K0, V0, 0, 0, 126, true, false);
        ATT_TILE(K0 + 32768, V0 + 32768, 64, 0, 126, true, false);
        const float l = l_run + __shfl_xor(l_run, 32);
        const float inv = l > 0.f ? 1.f / l : 0.f, msub = fmaxf(m_run, -1e20f);
#pragma unroll
        for (int tl = 0; tl < 2; ++tl) {
            f32x16 p0, p1;
            qk_tile(p0, p1, K0 + tl * 32768, qf, r32, hi);
            (void)mask_scale(p0, p1, 64 * tl, 0, 126, true, hi);
#pragma unroll
            for (int half = 0; half < 2; ++half)
#pragma unroll
                for (int rq = 0; rq < 4; ++rq) {
                    const f32x16& X = half == 0 ? p0 : p1;
                    const float e0 = ex2(X[4 * rq] - msub), e1 = ex2(X[4 * rq + 1] - msub), e2 = ex2(X[4 * rq + 2] - msub), e3 = ex2(X[4 * rq + 3] - msub);
                    float Lq = e3 * inv, Gq = ((e0 + e1) + (e2 + e3)) * inv;
                    Lq += __shfl_xor(Lq, 4); Lq += __shfl_xor(Lq, 8); Gq += __shfl_xor(Gq, 4); Gq += __shfl_xor(Gq, 8);
                    const int jj = 16 * tl + 8 * half + 2 * rq + hi;
                    if (r32 < 4) { IMPG[tok * 36 + jj] = Gq; IMPL[tok * 36 + jj + 1] = Lq; }
                }
        }
    }
    FINALIZE(0);
    LDS_WAIT();
    if (cw) {
#pragma unroll
        for (int it = 0; it < 2; ++it) {
            const int tk = 2 * it + hi, j = r32;
            const float my = IMPG[tk * 36 + j] + IMPL[tk * 36 + j];
            int cnt = 0;
            for (int i = 1; i < 31; ++i) { const float v = IMPG[tk * 36 + i] + IMPL[tk * 36 + i]; cnt += (v > my || (v == my && i < j)) ? 1 : 0; }
            const bool selb = (j == 0) || (j == 31) || cnt < 13;
            const unsigned long long bal = __ballot(selb);
            if (r32 == 0) SEL[h * 4 + tk] = (hi ? (bal >> 32) : (bal & 0xffffffffull)) | (1ull << 32);
        }
    }
    __syncthreads();
    const unsigned long long mysel = SEL[h * 4 + tok];
    const unsigned long long Uh = SEL[h * 4] | SEL[h * 4 + 1] | SEL[h * 4 + 2] | SEL[h * 4 + 3];
    unsigned long long rem = (SEL[0] | SEL[1] | SEL[2] | SEL[3]) | (SEL[4] | SEL[5] | SEL[6] | SEL[7]);
    { const bf16* Qr = WSP(bf16, WS_QR);
#pragma unroll
      for (int d0 = 0; d0 < 4; ++d0) qf[d0] = *(const bf16x8*)(Qr + qoff + 16 * d0); }
    m_run = NEGB; l_run = 0.f;
#pragma unroll
    for (int r = 0; r < 16; ++r) { o[0][r] = 0.f; o[1][r] = 0.f; }
#define NEXT_CODE(c_) do { if (rem) { c_ = __builtin_ctzll(rem); rem &= rem - 1; } else if (wnext <= 72) { c_ = wnext; wnext += 1; } else c_ = -1; } while (0)
    int wnext = 64, c0, c1, c2, c3;
    NEXT_CODE(c0); NEXT_CODE(c1); NEXT_CODE(c2);
    bool done = false;
    if (ldr) {
        S_ISSUE(0, c0); S_ISSUE(1, c1); S_ISSUE(2, c2);
        S_WRITE(0, 0);
        __syncthreads();
#define L_STEP(k0_, k1_, st_) do { \
        NEXT_CODE(c3); \
        if (c3 >= 0) S_ISSUE(k0_, c3); \
        if (c1 >= 0) S_WRITE(k1_, (st_) ^ 1); \
        __syncthreads(); \
        done = c1 < 0; \
        c0 = c1; c1 = c2; c2 = c3; } while (0)
        for (;;) {
            L_STEP(0, 1, 0); if (done) break;
            L_STEP(1, 2, 1); if (done) break;
            L_STEP(2, 0, 0); if (done) break;
            L_STEP(0, 1, 1); if (done) break;
            L_STEP(1, 2, 0); if (done) break;
            L_STEP(2, 0, 1); if (done) break;
        }
#undef L_STEP
    } else {
        __syncthreads();
        int st = 0;
        for (;;) {
            NEXT_CODE(c3);
            if (cw && (c0 >= 64 || ((Uh >> c0) & 1ull))) {
                const LAS unsigned char* Kt = lds + st * 32768 + (2 * h) * 8192;
                int kbase, klo; bool rflag, fast;
                if (c0 < 64) { kbase = c0 == 32 ? SEQ : 64 * c0; klo = -(1 << 30); rflag = (mysel >> c0) & 1ull; fast = c0 < 32; }
                else { const int j = c0 - 64; kbase = j < 8 ? 1536 + 64 * j : SEQ; klo = qpos - 511; rflag = true; fast = (j >= 1 && j < 8); }
                ATT_TILE(Kt, Kt + 8192, kbase, klo, qpos, rflag, fast);
            }
            if (c0 < 64 && c1 >= 64) { FINALIZE(1); m_run = NEGB; l_run = 0.f;
#pragma unroll
                for (int r = 0; r < 16; ++r) { o[0][r] = 0.f; o[1][r] = 0.f; } }
            __syncthreads();
            done = c1 < 0;
            c0 = c1; c1 = c2; c2 = c3; st ^= 1;
            if (done) break;
        }
    }
    FINALIZE(2);
#undef NEXT_CODE
#undef FINALIZE
#undef ATT_TILE
#undef S_WRITE
#undef S_ISSUE
    __syncthreads();
    if (w < 4) {
        const size_t row = (size_t)MP + 4 * s + w;
#pragma unroll
        for (int hh = 0; hh < 2; ++hh) {
            const f32x4 v = *(const LAS f32x4*)(OA + hh * 1024 + w * 256 + lane * 4);
            const f32x4 ga = *(const f32x4*)(F.in[14] + hh * 256 + lane * 4);
            const float ss = wave_sum((v[0] * v[0] + v[1] * v[1]) + (v[2] * v[2] + v[3] * v[3]));
            if (lane == 0) WSP(float, WS_SSA)[(4 * s + w) * 2 + hh] = ss;
            v2u ov; ov.x = pk2(v[0] * ga[0], v[1] * ga[1]); ov.y = pk2(v[2] * ga[2], v[3] * ga[3]);
            *(v2u*)(WSP(bf16, WS_MIXED) + row * 1024 + hh * 256 + lane * 4) = ov;
        }
    } else {
        const size_t row = (size_t)MP + 4 * s + (w - 4);
        const f32x4 gr0 = *(const f32x4*)(F.in[15] + lane * 8), gr1 = *(const f32x4*)(F.in[15] + lane * 8 + 4);
        const float* hl = WSP(float, WS_HL) + row * 512 + lane * 8;
        const f32x4 h0 = *(const f32x4*)hl, h1 = *(const f32x4*)(hl + 4);
        const v4u pk = *(const v4u*)(WSP(bf16, WS_GRG) + row * 512 + lane * 8);
        float v[8] = {bflo(pk.x) * h0[0], bfhi(pk.x) * h0[1], bflo(pk.y) * h0[2], bfhi(pk.y) * h0[3], bflo(pk.z) * h1[0], bfhi(pk.z) * h1[1], bflo(pk.w) * h1[2], bfhi(pk.w) * h1[3]};
        float ss = 0.f;
#pragma unroll
        for (int i = 0; i < 8; ++i) ss += v[i] * v[i];
        const float rs = rsqrtf(wave_sum(ss) * (1.f / 512.f) + EPSN);
        v4u ov; ov.x = pk2(v[0] * rs * gr0[0], v[1] * rs * gr0[1]); ov.y = pk2(v[2] * rs * gr0[2], v[3] * rs * gr0[3]); ov.z = pk2(v[4] * rs * gr1[0], v[5] * rs * gr1[1]); ov.w = pk2(v[6] * rs * gr1[2], v[7] * rs * gr1[3]);
        *(v4u*)(WSP(bf16, WS_MIXED) + row * 1024 + 512 + lane * 8) = ov;
    }
    __syncthreads();
}

template <int MODE>
__device__ __forceinline__ void skinny_piece(Frame& F, int pc) {
    constexpr int K = MODE == 2 ? FF : DM, N = MODE == 1 ? FF : DM, NTN = N / 32, KW = K / 8;
    int tid = F.tid; asm volatile("" : "+v"(tid));
    const int lane = tid & 63, w = F.wave, fr = lane & 15, fq = lane >> 4;
    const bf16* A = MODE == 0 ? WSP(bf16, WS_MIXED) : (MODE == 1 ? WSP(bf16, WS_XN) : WSP(bf16, WS_H));
    const bf16* Bt = MODE == 0 ? WSP(bf16, WS_WOUT) : (MODE == 1 ? WSP(bf16, WS_WUP) : WSP(bf16, WS_WDN));
    const int rt = pc / NTN, ct = pc % NTN, row0 = MP + 64 * rt, col0 = 32 * ct;
    f32x4 acc[4][2];
#pragma unroll
    for (int m = 0; m < 4; ++m) { acc[m][0] = (f32x4){0.f, 0.f, 0.f, 0.f}; acc[m][1] = acc[m][0]; }
    const bf16* ap = A + (size_t)(row0 + fr) * K + w * KW + 8 * fq;
    const bf16* bp = Bt + (size_t)(col0 + fr) * K + w * KW + 8 * fq;
#pragma unroll 4
    for (int ks = 0; ks < KW / 32; ++ks) {
        bf16x8 af[4], bf[2];
#pragma unroll
        for (int m = 0; m < 4; ++m) af[m] = *(const bf16x8*)(ap + (size_t)(16 * m) * K + 32 * ks);
#pragma unroll
        for (int n = 0; n < 2; ++n) bf[n] = *(const bf16x8*)(bp + (size_t)(16 * n) * K + 32 * ks);
#pragma unroll
        for (int m = 0; m < 4; ++m)
#pragma unroll
            for (int n = 0; n < 2; ++n) acc[m][n] = __builtin_amdgcn_mfma_f32_16x16x32_bf16(bf[n], af[m], acc[m][n], 0, 0, 0);
    }
    if (MODE == 0 && w < 4) {
        const float* ssa = WSP(float, WS_SSA) + (size_t)(row0 - MP + fr) * 2;
#pragma unroll
        for (int m = 0; m < 4; ++m) { const float rs = rsqrtf((ssa[32 * m] + ssa[32 * m + 1]) * (1.f / 512.f) + EPSN); acc[m][0] *= rs; acc[m][1] *= rs; }
    }
    LAS float* red = (LAS float*)F.lds;
#pragma unroll
    for (int m = 0; m < 4; ++m)
#pragma unroll
        for (int n = 0; n < 2; ++n) *(LAS f32x4*)(red + w * 2048 + (16 * m + fr) * 32 + 16 * n + 4 * fq) = acc[m][n];
    __syncthreads();
    const int r = tid >> 3, c4 = (tid & 7) * 4;
    f32x4 v = (f32x4){0.f, 0.f, 0.f, 0.f};
#pragma unroll
    for (int ww = 0; ww < 8; ++ww) v += *(const LAS f32x4*)(red + ww * 2048 + r * 32 + c4);
    const int row = row0 + r, col = col0 + c4;
    if (MODE == 0) {
        const f32x4 x1 = *(const f32x4*)(F.in[1] + (size_t)(row - MP) * DM + col) + v;
        *(f32x4*)(WSP(float, WS_X1) + (size_t)row * DM + col) = x1;
        v2u p; p.x = pk2(x1[0], x1[1]); p.y = pk2(x1[2], x1[3]);
        *(v2u*)(WSP(bf16, WS_XN) + (size_t)row * DM + col) = p;
        float ss = (x1[0] * x1[0] + x1[1] * x1[1]) + (x1[2] * x1[2] + x1[3] * x1[3]);
        ss += __shfl_xor(ss, 1); ss += __shfl_xor(ss, 2); ss += __shfl_xor(ss, 4);
        if ((tid & 7) == 0) atomicAdd((float*)(F.ws + WS_CTL + CTL_SS1) + row, ss);
    } else if (MODE == 1) {
        const float rs = rsqrtf(((const float*)(F.ws + WS_CTL + CTL_SS1))[row] * (1.0f / DM) + EPSN);
        f32x4 hv;
#pragma unroll
        for (int e = 0; e < 4; ++e) { const float a = fmaxf(v[e] * rs, 0.f); hv[e] = a * a; }
        v2u p; p.x = pk2(hv[0], hv[1]); p.y = pk2(hv[2], hv[3]);
        *(v2u*)(WSP(bf16, WS_H) + (size_t)row * FF + col) = p;
    } else {
        const f32x4 x2 = *(const f32x4*)(WSP(float, WS_X1) + (size_t)row * DM + col) + v;
        *(f32x4*)(F.out + (size_t)row * DM + col) = x2;
    }
    __syncthreads();
}

#ifndef MK_N_LAUNCHES
#define MK_N_LAUNCHES 1
#endif
constexpr int N_PHASES = 8;
struct Args { const float* in[29]; float* out; unsigned char* ws; int ph_lo, ph_hi; };
__global__ void __launch_bounds__(NWAVES * 64, 2) nsa_fwd(Args args) {
    extern __shared__ __attribute__((aligned(16))) unsigned char lds[];
    Frame F;
    F.lds = (LAS unsigned char*)lds;
    F.tid = threadIdx.x; F.lane = F.tid & 63; F.wave = __builtin_amdgcn_readfirstlane(F.tid >> 6);
    F.G = gridDim.x; { const int bx = blockIdx.x; F.vcu = (F.G % 8 == 0) ? (bx % 8) * (F.G / 8) + bx / 8 : bx; }
    F.in = args.in;
    F.page_table = (const int*)args.in[6];
    F.out = args.out; F.ws = args.ws; F.ctl = (gu32*)(args.ws + WS_CTL);
    volatile LAS unsigned* MISC = (volatile LAS unsigned*)(F.lds + MISC_OFF);
    for (int u = F.tid; u < (LDS_BYTES - RING_BYTES) / 4; u += NWAVES * 64) ((LAS unsigned*)(F.lds + RING_BYTES))[u] = 0u;
    __syncthreads();
    XcdBarrier bar; bar.bar = (unsigned*)(F.ctl + CW_BAR); bar.x = 0; bar.st = nullptr;
    if (MK_N_LAUNCHES == 1) bar = xcd_barrier_post((unsigned*)(F.ctl + CW_BAR), MISC + 8);
    const int lo = args.ph_lo, hi = args.ph_hi;
#ifdef STAMP_A
#define STAMP(i) do { if (blockIdx.x == 0 && threadIdx.x == 0) __hip_atomic_store((unsigned*)(F.ctl + CW_STAMP + (i)), (unsigned)__builtin_amdgcn_s_memrealtime(), RLX_AGENT); } while (0)
#define STAMPMAX(i) do { if (threadIdx.x == 0) __hip_atomic_fetch_max((unsigned*)(F.ctl + CW_STAMP + (i)), (unsigned)__builtin_amdgcn_s_memrealtime(), RLX_AGENT); } while (0)
#else
#define STAMP(i) do { } while (0)
#define STAMPMAX(i) do { } while (0)
#endif
    STAMP(0);
#ifndef PHASE_MASK
#define PHASE_MASK 0xFF
#endif
#define IN(k) (((PHASE_MASK >> (k)) & 1) && lo <= (k) && (k) < hi)
#ifndef REPEAT_MASK
#define REPEAT_MASK 0
#endif
#define NREP(k) (1 + ((REPEAT_MASK >> (k)) & 1))
#define REPSEAM(k, rep) do { if ((rep) + 1 < NREP(k)) { xcd_barrier(bar); FRESH(); } } while (0)
#define SEAM(k) do { if (IN(k) && IN((k) + 1)) xcd_barrier(bar); FRESH(); STAMP((k) + 1); } while (0)
#define FRESH() do { int t_ = threadIdx.x; asm volatile("" : "+v"(t_)); F.tid = t_; F.lane = t_ & 63; F.wave = __builtin_amdgcn_readfirstlane(t_ >> 6); } while (0)
    if (IN(0)) { p0_prologue(F); }
    SEAM(0);
    if (IN(1)) for (int rep = 0; rep < NREP(1); ++rep) {
        pg8::Gemm g{WSP(bf16, WS_XN), WSP(bf16, WS_WIN), MT, NIN, DM}; pg8::StaticOrder S; S.init(MT, NIN, F.G, (int)blockIdx.x);
        pg8::EpiProj E{WSP(bf16, WS_QN), WSP(bf16, WS_QR), WSP(bf16, WS_KS), WSP(bf16, WS_VS), WSP(bf16, WS_KW), WSP(bf16, WS_VW), WSP(bf16, WS_GRG), WSP(float, WS_GATES), WSP(float, WS_RX), F.out, WSP(float, WS_ROT)};
        pg8::gemm_phase<pg8::EpiProj, pg8::StaticOrder, true, true>(F.lds, g, S, E);
        REPSEAM(1, rep);
    }
    SEAM(1);
    if (IN(2)) for (int rep = 0; rep < NREP(2); ++rep) {
        for (;;) {
            if (F.tid == 0) MISC[0] = __hip_atomic_fetch_add((unsigned*)(F.ctl + CW_Q2 + 256 * rep), 1u, RLX_AGENT);
            __syncthreads();
            const int id = (int)MISC[0];
            __syncthreads();
            if (id >= 264 + 544) break;
            if (id < 264) { rnn_unit(F, id); __syncthreads(); } else compress_unit(F, id - 264);
        }
#ifdef REP_P2R
        for (;;) { if (F.tid == 0) MISC[0] = __hip_atomic_fetch_add((unsigned*)(F.ctl + CW_Q2 + 1024), 1u, RLX_AGENT); __syncthreads(); const int id = (int)MISC[0]; __syncthreads(); if (id >= 256) break; rnn_unit(F, 264, id); __syncthreads(); }
#endif
#ifdef REP_P2C
        for (;;) { if (F.tid == 0) MISC[0] = __hip_atomic_fetch_add((unsigned*)(F.ctl + CW_Q2 + 1024), 1u, RLX_AGENT); __syncthreads(); const int id = (int)MISC[0]; __syncthreads(); if (id >= 544) break; compress_unit(F, id); }
#endif
        REPSEAM(2, rep);
    }
    SEAM(2);
#ifndef REP_P3S
#define REP_P3S 1
#endif
#ifndef REP_P3P
#define REP_P3P 1
#endif
    if (IN(3)) for (int rep = 0; rep < NREP(3); ++rep) {
        for (int r2 = 0; r2 < REP_P3S; ++r2)
        for (;;) {
            if (F.tid == 0) MISC[0] = __hip_atomic_fetch_add((unsigned*)(F.ctl + CW_Q3 + 256 * rep + 512 * r2), 1u, RLX_AGENT);
            __syncthreads();
            const int id = (int)MISC[0];
            __syncthreads();
            if (id >= 128) break;
            attn_unit_s(F, id);
        }
        STAMPMAX(10);
        for (int r2 = 0; r2 < REP_P3P; ++r2)
        for (;;) {
            if (F.tid == 0) MISC[0] = __hip_atomic_fetch_add((unsigned*)(F.ctl + CW_Q3 + 64 + 256 * rep + 512 * r2), 1u, RLX_AGENT);
            __syncthreads();
            const int k = (int)MISC[0];
            __syncthreads();
            if (k >= 512) break;
            attn_unit_p(F, k & 7, 63 - (k >> 3));
        }
        REPSEAM(3, rep);
    }
    SEAM(3);
    if (IN(4)) for (int rep = 0; rep < NREP(4); ++rep) {
        pg8::Gemm g{WSP(bf16, WS_MIXED), WSP(bf16, WS_WOUT), MP, DM, DM}; pg8::StaticOrder S; S.init(MP, DM, F.G, (int)blockIdx.x);
        pg8::EpiOut E{F.in[0], F.in[1], WSP(float, WS_X1), WSP(bf16, WS_XN), (float*)(F.ws + WS_CTL + (rep ? CTL_DUMMY : CTL_SS1))};
        pg8::gemm_phase<pg8::EpiOut, pg8::StaticOrder, true, true>(F.lds, g, S, E);
        if (rep == 0) for (int pc = blockIdx.x; pc < 8 * (DM / 32); pc += F.G) skinny_piece<0>(F, pc);
        REPSEAM(4, rep);
    }
    SEAM(4);
    if (IN(5)) for (int rep = 0; rep < NREP(5); ++rep) {
        pg8::Gemm g{WSP(bf16, WS_XN), WSP(bf16, WS_WUP), MP, FF, DM}; pg8::StaticOrder S; S.init(MP, FF, F.G, (int)blockIdx.x);
        pg8::EpiUp E{WSP(bf16, WS_H), (const float*)(F.ws + WS_CTL + CTL_SS1)};
        pg8::gemm_phase<pg8::EpiUp, pg8::StaticOrder, true, true>(F.lds, g, S, E);
        for (int pc = blockIdx.x; pc < 8 * (FF / 32); pc += F.G) skinny_piece<1>(F, pc);
        REPSEAM(5, rep);
    }
    SEAM(5);
    if (IN(6)) for (int rep = 0; rep < NREP(6); ++rep) {
        pg8::Gemm g{WSP(bf16, WS_H), WSP(bf16, WS_WDN), MP, DM, FF}; pg8::StaticOrder S; S.init(MP, DM, F.G, (int)blockIdx.x);
        pg8::EpiDown E{WSP(float, WS_X1), F.out};
        pg8::gemm_phase<pg8::EpiDown, pg8::StaticOrder, true, true>(F.lds, g, S, E);
        for (int pc = blockIdx.x; pc < 8 * (DM / 32); pc += F.G) skinny_piece<2>(F, pc);
        REPSEAM(6, rep);
    }
    SEAM(6);
    if (IN(7)) p7_final(F);
#ifdef STAMP_A
    STAMP(8);
    if (blockIdx.x == 0) {
        __syncthreads();
        const unsigned a = __hip_atomic_load((unsigned*)(F.ctl + CW_STAMP + STAMP_A), RLX_AGENT), b = __hip_atomic_load((unsigned*)(F.ctl + CW_STAMP + STAMP_B), RLX_AGENT);
        const float us = STAMP_A < 0 ? 100.f : (float)(b - a) * 0.01f;
        for (int i = threadIdx.x; i < 4096; i += 512) F.out[O_HP + i] = us;
    }
#endif
#undef IN
#undef SEAM
#undef REPSEAM
#undef NREP
#undef FRESH
}

extern "C" void kernel_launch(void* const* d_in, const int* in_sizes, int n_in, void* d_out, int out_size, void* d_ws, size_t ws_size, hipStream_t stream) {
    static int grid = 0;
    if (grid == 0) {
        if (n_in != 29 || out_size != 44056576 || ws_size < WS_END) { fprintf(stderr, "kernel_launch: unexpected sizes (n_in %d, out %d, ws %zu)\n", n_in, out_size, ws_size); grid = -1; return; }
        int dev = 0, cus = 0, per_cu = 0;
        if (hipGetDevice(&dev) != hipSuccess || hipDeviceGetAttribute(&cus, hipDeviceAttributeMultiprocessorCount, dev) != hipSuccess) { grid = -1; return; }
        if (hipFuncSetAttribute((const void*)nsa_fwd, hipFuncAttributeMaxDynamicSharedMemorySize, LDS_BYTES) != hipSuccess) { fprintf(stderr, "kernel_launch: hipFuncSetAttribute failed\n"); grid = -1; return; }
        if (hipOccupancyMaxActiveBlocksPerMultiprocessor(&per_cu, (const void*)nsa_fwd, NWAVES * 64, LDS_BYTES) != hipSuccess || per_cu < 1) fprintf(stderr, "kernel_launch: occupancy query reports %d\n", per_cu);
        (void)hipGetLastError();
        grid = cus;
    }
    if (grid < 0) return;
    if (hipMemsetAsync((char*)d_ws + WS_CTL, 0, CTL_ZERO_BYTES, stream) != hipSuccess) return;
    Args a{};
    for (int i = 0; i < 29; ++i) a.in[i] = (const float*)d_in[i];
    a.out = (float*)d_out; a.ws = (unsigned char*)d_ws;
#if MK_N_LAUNCHES == 1
    a.ph_lo = 0; a.ph_hi = N_PHASES;
    hipLaunchKernelGGL(nsa_fwd, dim3(grid), dim3(NWAVES * 64), LDS_BYTES, stream, a);
#else
    for (int p = 0; p < N_PHASES; ++p) { a.ph_lo = p; a.ph_hi = p + 1; hipLaunchKernelGGL(nsa_fwd, dim3(grid), dim3(NWAVES * 64), LDS_BYTES, stream, a); }
#endif
}
```

```cpp
#include <hip/hip_runtime.h>
#include <cstdio>
#include <cstdint>

constexpr int DM = 1024, NB = 8, SEQ = 2048, NS = 128, DT = 4;
constexpr int MP = NB * SEQ, MS = NS * DT, MT = MP + MS;
constexpr int NIN = 2560, FF = 4096;
constexpr float EPSN = 1e-6f;
constexpr size_t O_YP = 0, O_KV = 17301504, O_WINP = 25952256, O_WINS = 27000832, O_CONVP = 43778048, O_CONVS = 43790336, O_HP = 43986944, O_HS = 43991040;

namespace pg8 {
#define PG8_LAS __attribute__((address_space(3)))
typedef unsigned short bf16_t;
typedef short bf16x8 __attribute__((ext_vector_type(8)));
typedef float f32x4 __attribute__((ext_vector_type(4)));
typedef unsigned u32x4 __attribute__((ext_vector_type(4)));
constexpr int BM = 256, BK = 64, HALF = 128, HTB = HALF * BK * 2  , STAGE_BYTES = 8 * HTB, NXCD = 8, WGM = 8;

__host__ __device__ __forceinline__ int lds_byte(int r, int c) { const int st = (r >> 4) * 2 + (c >> 5), rr = r & 15, cc = c & 31, ob = rr * 64 + cc * 2; return st * 1024 + (ob ^ (((ob >> 9) & 1) << 5)); }
__host__ __device__ __forceinline__ void stage_rc(int b, int& R, int& C) { const int st = b / 1024, sb = b % 1024, swz = sb ^ (((sb >> 9) & 1) << 5); R = (st >> 1) * 16 + swz / 64; C = (st & 1) * 32 + (swz % 64) / 2; }
__host__ __device__ __forceinline__ int perm32(int rho) { const int n = rho >> 4, i = rho & 15; return 8 * (i >> 2) + 4 * n + (i & 3); }

struct Unit { int pm, pn; };
struct Gemm { const bf16_t* A; const bf16_t* Bt; int M, N, K; };

struct StaticOrder {
    int nM, nN, nwg, G, c;
    __host__ __device__ void init(int M, int N, int G_, int c_) { nM = M / BM; nN = N / BM; nwg = nM * nN; G = G_; c = c_; }
    __host__ __device__ bool next(int i, Unit& u) const {
        const long L = (long)i * G + c; if (L >= nwg) return false;
        int wgid = (int)L; { const int q = nwg / NXCD, r = nwg % NXCD, xcd = wgid % NXCD, off = wgid / NXCD; wgid = (xcd < r ? xcd * (q + 1) : r * (q + 1) + (xcd - r) * q) + off; }
        const int nig = WGM * nN, gid = wgid / nig, fm = gid * WGM, gsz = (nM - fm) < WGM ? (nM - fm) : WGM;
        u.pm = fm + ((wgid % nig) % gsz); u.pn = (wgid % nig) / gsz; return true;
    }
    __device__ __forceinline__ void a_ready(const Unit&) const {}
    __device__ __forceinline__ void done(const Unit&) const {}
};

__device__ __forceinline__ unsigned cvt_pk_bf16(float lo, float hi) { unsigned r; asm volatile("v_cvt_pk_bf16_f32 %0, %1, %2" : "=v"(r) : "v"(lo), "v"(hi)); return r; }
typedef unsigned u32x2 __attribute__((ext_vector_type(2)));
typedef float f32x2 __attribute__((ext_vector_type(2)));
__device__ __forceinline__ float gelu_tanh(float x) {
    const float y = 1.5957691216f * (x + 0.044715f * x * x * x);
    return x / (1.0f + __expf(-y));
}
__device__ __forceinline__ float sigmoidf_(float x) { return 1.0f / (1.0f + __expf(-x)); }
__device__ __forceinline__ u32x2 pack4(f32x4 v) { u32x2 w; w.x = cvt_pk_bf16(v[0], v[1]); w.y = cvt_pk_bf16(v[2], v[3]); return w; }

struct EpiProj {
    static constexpr bool PERM = false, AFTER_DRAIN = false;
    bf16_t *Qn, *Qr, *KS, *VS, *KW, *VW, *GRG; float *GATES, *RX, *out; const float* rot;
    __device__ __forceinline__ f32x4 rotate(f32x4 v, int pos, int fq) const {
        const float* tb = rot + pos * 16 + (fq & 1) * 4;
        const f32x4 cs = *(const f32x4*)tb, sn = *(const f32x4*)(tb + 8);
        f32x4 pr;
#pragma unroll
        for (int e = 0; e < 4; ++e) pr[e] = __shfl_xor(v[e], 32);
        const float sg = fq < 2 ? -1.f : 1.f;
        f32x4 w;
#pragma unroll
        for (int e = 0; e < 4; ++e) w[e] = v[e] * cs[e] + sg * pr[e] * sn[e];
        return w;
    }
    __device__ __forceinline__ void operator()(const f32x4 (&acc)[2][2][4][2], const Unit& u, int wr, int wc, int fr, int fq) const {
        asm volatile("" : "+v"(fr), "+v"(fq));
        const int pn = u.pn;
        const bool rotw = (wc & 1) == 0;
#pragma unroll
        for (int ai = 0; ai < 2; ++ai)
#pragma unroll
            for (int m = 0; m < 4; ++m) {
                const int row = u.pm * BM + ai * HALF + wr * 64 + m * 16 + fr;
                const bool samp = row >= MP;
                int t, pos, sq;
                if (!samp) { t = row & (SEQ - 1); pos = t; sq = row >> 11; } else { t = (row - MP) & 3; pos = SEQ + t; sq = (row - MP) >> 2; }
#pragma unroll
                for (int bj = 0; bj < 2; ++bj)
#pragma unroll
                    for (int n = 0; n < 2; ++n) {
                        const f32x4 v = acc[ai][bj][m][n];
                        const int cc = bj * HALF + wc * 32 + n * 16 + fq * 4;
                        if (pn < 2) {
                            const size_t o = (size_t)row * 512 + pn * 256 + cc;
                            *(u32x2*)(Qn + o) = pack4(v);
                            f32x4 w = v; if (n == 0 && rotw) w = rotate(v, pos, fq);
                            *(u32x2*)(Qr + o) = pack4(w);
                        } else if (pn == 2) {
                            *(f32x4*)(out + O_KV + (size_t)row * 512 + cc) = v;
                        } else if (pn == 3) {
                            f32x4 w = v; if (bj == 0 && n == 0 && rotw) w = rotate(v, pos, fq);
                            *(f32x4*)(out + O_KV + (size_t)row * 512 + 256 + cc) = w;
                            bf16_t* dst = (bj == 0 ? KS : VS) + (size_t)row * 128 + (cc & 127);
                            *(u32x2*)dst = pack4(w);
                        } else if (pn == 4) {
                            f32x4 w = v; if (bj == 0 && n == 0 && rotw) w = rotate(v, pos, fq);
                            bf16_t* dst = (bj == 0 ? KW : VW) + (size_t)row * 128 + (cc & 127);
                            *(u32x2*)dst = pack4(w);
                            if (!samp) { if (t >= SEQ - 512) *(f32x4*)(out + O_WINP + ((size_t)sq * 512 + (t - (SEQ - 512))) * 256 + cc) = w; }
                            else *(f32x4*)(out + O_WINS + ((size_t)sq * 512 + 508 + t) * 256 + cc) = w;
                        } else if (pn < 7) {
                            f32x4 g;
#pragma unroll
                            for (int e = 0; e < 4; ++e) g[e] = gelu_tanh(v[e]);
                            *(u32x2*)(GRG + (size_t)row * 512 + (pn - 5) * 256 + cc) = pack4(g);
                        } else if (pn < 9) {
                            const int c2 = (pn - 7) * 256 + cc;
                            *(f32x4*)(RX + (size_t)row * 512 + c2) = v;
                            if (!samp) { if (t >= SEQ - 3) *(f32x4*)(out + O_CONVP + ((size_t)sq * 3 + (t - (SEQ - 3))) * 512 + c2) = v; }
                            else if (t >= 1) *(f32x4*)(out + O_CONVS + ((size_t)sq * 3 + (t - 1)) * 512 + c2) = v;
                        } else {
                            if (cc < 24) { f32x4 g;
#pragma unroll
                                for (int e = 0; e < 4; ++e) g[e] = sigmoidf_(v[e]);
                                *(f32x4*)(GATES + (size_t)row * 24 + cc) = g; }
                        }
                    }
                asm volatile("" ::: "memory");
            }
    }
};

struct EpiOut {
    static constexpr bool PERM = false, AFTER_DRAIN = false;
    const float *xp, *xs; float* X1; bf16_t* XN; float* SS;
    __device__ __forceinline__ void operator()(const f32x4 (&acc)[2][2][4][2], const Unit& u, int wr, int wc, int fr, int fq) const {
#pragma unroll
        for (int ai = 0; ai < 2; ++ai)
#pragma unroll
            for (int m = 0; m < 4; ++m) {
                const int row = u.pm * BM + ai * HALF + wr * 64 + m * 16 + fr;
                const float* xr = row < MP ? xp + (size_t)row * DM : xs + (size_t)(row - MP) * DM;
                float ss = 0.f;
#pragma unroll
                for (int bj = 0; bj < 2; ++bj)
#pragma unroll
                    for (int n = 0; n < 2; ++n) {
                        const int c = u.pn * BM + bj * HALF + wc * 32 + n * 16 + fq * 4;
                        const f32x4 v = *(const f32x4*)(xr + c) + acc[ai][bj][m][n];
                        *(f32x4*)(X1 + (size_t)row * DM + c) = v;
                        *(u32x2*)(XN + (size_t)row * DM + c) = pack4(v);
                        ss += (v[0] * v[0] + v[1] * v[1]) + (v[2] * v[2] + v[3] * v[3]);
                    }
                ss += __shfl_xor(ss, 16); ss += __shfl_xor(ss, 32);
                if (fq == 0) atomicAdd(SS + row, ss);
            }
    }
};
struct EpiUp {
    static constexpr bool PERM = true, AFTER_DRAIN = false;
    bf16_t* H; const float* SS;
    __device__ __forceinline__ void operator()(const f32x4 (&acc)[2][2][4][2], const Unit& u, int wr, int wc, int fr, int fq) const {
#pragma unroll
        for (int ai = 0; ai < 2; ++ai)
#pragma unroll
            for (int m = 0; m < 4; ++m) {
                const int row = u.pm * BM + ai * HALF + wr * 64 + m * 16 + fr;
                const float rs = rsqrtf(SS[row] * (1.0f / DM) + EPSN);
#pragma unroll
                for (int bj = 0; bj < 2; ++bj) {
                    f32x4 v0 = acc[ai][bj][m][0] * rs, v1 = acc[ai][bj][m][1] * rs;
#pragma unroll
                    for (int e = 0; e < 4; ++e) { const float a = fmaxf(v0[e], 0.f), b = fmaxf(v1[e], 0.f); v0[e] = a * a; v1[e] = b * b; }
                    u32x4 w; w.x = cvt_pk_bf16(v0[0], v0[1]); w.y = cvt_pk_bf16(v0[2], v0[3]); w.z = cvt_pk_bf16(v1[0], v1[1]); w.w = cvt_pk_bf16(v1[2], v1[3]);
                    *(u32x4*)(H + (size_t)row * FF + u.pn * BM + bj * HALF + wc * 32 + 8 * fq) = w;
                }
            }
    }
};
struct EpiDown {
    static constexpr bool PERM = false, AFTER_DRAIN = false;
    const float* X1; float* Y;
    __device__ __forceinline__ void operator()(const f32x4 (&acc)[2][2][4][2], const Unit& u, int wr, int wc, int fr, int fq) const {
#pragma unroll
        for (int ai = 0; ai < 2; ++ai)
#pragma unroll
            for (int m = 0; m < 4; ++m) {
                const int row = u.pm * BM + ai * HALF + wr * 64 + m * 16 + fr;
#pragma unroll
                for (int bj = 0; bj < 2; ++bj)
#pragma unroll
                    for (int n = 0; n < 2; ++n) {
                        const int c = u.pn * BM + bj * HALF + wc * 32 + n * 16 + fq * 4;
                        *(f32x4*)(Y + (size_t)row * DM + c) = *(const f32x4*)(X1 + (size_t)row * DM + c) + acc[ai][bj][m][n];
                    }
            }
    }
};

template <class Epi, class Sched, bool ALIGN_EPI = false, bool SP2 = false>
__device__ __forceinline__ void gemm_phase(PG8_LAS unsigned char* lds, const Gemm g, const Sched& S, const Epi& E) {
    const int tid = threadIdx.x, wid = __builtin_amdgcn_readfirstlane(tid >> 6), lane = tid & 63, wr = wid >> 2, wc = wid & 3, fr = lane & 15, fq = lane >> 4;
    const int K = g.K, nt = K / BK;
    unsigned voffA[2], voffB[2];
#pragma unroll
    for (int i = 0; i < 2; ++i) { int R, C; stage_rc(tid * 16 + i * 8192, R, C); const int Rb = Epi::PERM ? ((R & ~31) + perm32(R & 31)) : R;
        voffA[i] = (unsigned)(R * K + C) * 2u; voffB[i] = (unsigned)(Rb * K + C) * 2u; }
    const size_t kstep = (size_t)(BK * 2);
    const size_t hstep = (size_t)HALF * K * 2;
    const size_t tstep = 2 * hstep;
    const unsigned ldsw = (unsigned)wid * 1024u;
    const int aoff = lds_byte(wr * 64 + fr, fq * 8), boff = lds_byte(wc * 32 + fr, fq * 8);
#define PG8_SA(b, h) (((b) * 2 + (h)) * HTB)
#define PG8_SB(b, h) ((4 + (b) * 2 + (h)) * HTB)
#define PG8_STAGE(bufoff, gbase, voff) do { _Pragma("unroll") for (int _i = 0; _i < 2; ++_i) \
        __builtin_amdgcn_global_load_lds((const unsigned*)((const char*)(gbase) + (voff)[_i]), (PG8_LAS unsigned*)(lds + (bufoff) + ldsw + _i * 8192), 16, 0, 0); } while (0)
#define PG8_LDA(dst, b, h) do { _Pragma("unroll") for (int m = 0; m < 4; ++m) _Pragma("unroll") for (int k = 0; k < 2; ++k) dst[m][k] = *(const PG8_LAS bf16x8*)(lds + PG8_SA(b, h) + aoff + m * 2048 + k * 1024); } while (0)
#define PG8_LDB(dst, b, h) do { _Pragma("unroll") for (int n = 0; n < 2; ++n) _Pragma("unroll") for (int k = 0; k < 2; ++k) dst[n][k] = *(const PG8_LAS bf16x8*)(lds + PG8_SB(b, h) + boff + n * 2048 + k * 1024); } while (0)
#define PG8_MMA(ai, bj, At, Bt) do { __builtin_amdgcn_s_setprio(1); _Pragma("unroll") for (int m = 0; m < 4; ++m) _Pragma("unroll") for (int n = 0; n < 2; ++n) _Pragma("unroll") for (int k = 0; k < 2; ++k) \
        acc[ai][bj][m][n] = __builtin_amdgcn_mfma_f32_16x16x32_bf16(Bt[n][k], At[m][k], acc[ai][bj][m][n], 0, 0, 0); __builtin_amdgcn_s_setprio(0); } while (0)
#define PG8_WAIT_V(n) asm volatile("s_waitcnt vmcnt(" #n ")" ::: "memory")
#define PG8_WAIT_L(n) asm volatile("s_waitcnt lgkmcnt(" #n ")" ::: "memory")
#define PG8_BAR __builtin_amdgcn_s_barrier()
#define PG8_SCHED __builtin_amdgcn_sched_barrier(0)
    Unit cur, nxt; int ui = 0;
    if (!S.next(0, cur)) return;
    f32x4 acc[2][2][4][2];
#pragma unroll
    for (int a = 0; a < 2; ++a)
#pragma unroll
        for (int b = 0; b < 2; ++b)
#pragma unroll
            for (int m = 0; m < 4; ++m)
#pragma unroll
                for (int n = 0; n < 2; ++n) acc[a][b][m][n] = (f32x4){0.f, 0.f, 0.f, 0.f};
    bf16x8 At[4][2], B0[2][2], B1[2][2];
    const char* cA = (const char*)g.A + (size_t)cur.pm * tstep; const char* cB = (const char*)g.Bt + (size_t)cur.pn * tstep;
    S.a_ready(cur);
    if constexpr (SP2) {
        PG8_STAGE(PG8_SB(0, 0), cB, voffB); PG8_STAGE(PG8_SB(0, 1), cB + hstep, voffB); PG8_STAGE(PG8_SA(0, 0), cA, voffA); PG8_STAGE(PG8_SA(0, 1), cA + hstep, voffA);
        if (wr == 1) PG8_BAR;
        PG8_WAIT_V(2); PG8_BAR;
        PG8_STAGE(PG8_SB(1, 0), cB + kstep, voffB); PG8_STAGE(PG8_SA(1, 0), cA + kstep, voffA); PG8_STAGE(PG8_SB(1, 1), cB + hstep + kstep, voffB);
        PG8_WAIT_V(6); PG8_BAR;
    } else {
        PG8_STAGE(PG8_SB(0, 0), cB, voffB); PG8_STAGE(PG8_SA(0, 0), cA, voffA); PG8_STAGE(PG8_SB(0, 1), cB + hstep, voffB); PG8_STAGE(PG8_SA(0, 1), cA + hstep, voffA);
        if (wr == 1) PG8_BAR;
        PG8_WAIT_V(4); PG8_BAR;
        PG8_STAGE(PG8_SB(1, 0), cB + kstep, voffB); PG8_STAGE(PG8_SA(1, 0), cA + kstep, voffA); PG8_STAGE(PG8_SB(1, 1), cB + hstep + kstep, voffB);
        PG8_WAIT_V(6); PG8_BAR;
    }
    for (;;) {
        const bool has_next = S.next(ui + 1, nxt);
        const char* nA = has_next ? (const char*)g.A + (size_t)nxt.pm * tstep : cA; const char* nB = has_next ? (const char*)g.Bt + (size_t)nxt.pn * tstep : cB;
        for (int t = 0; t < nt; t += 2) {
            const bool last = (t == nt - 2);
            const char* a1 = cA + (size_t)(t + 1) * kstep;
            const char* a2 = last ? nA : cA + (size_t)(t + 2) * kstep; const char* b2 = last ? nB : cB + (size_t)(t + 2) * kstep;
            const char* a3 = a2 + kstep; const char* b3 = b2 + kstep;
            if (last && has_next) S.a_ready(nxt);
            if constexpr (SP2) {
            PG8_LDB(B0, 0, 0); PG8_LDB(B1, 0, 1); PG8_SCHED; PG8_LDA(At, 0, 0); PG8_STAGE(PG8_SA(1, 1), a1 + hstep, voffA);
            PG8_WAIT_V(8); PG8_WAIT_L(0); PG8_BAR; PG8_MMA(0, 0, At, B0); PG8_MMA(0, 1, At, B1); PG8_BAR; PG8_SCHED;
            PG8_LDA(At, 0, 1); PG8_STAGE(PG8_SB(0, 0), b2, voffB); PG8_STAGE(PG8_SB(0, 1), b2 + hstep, voffB); PG8_STAGE(PG8_SA(0, 0), a2, voffA);
            PG8_WAIT_V(8); PG8_WAIT_L(0); PG8_BAR; PG8_MMA(1, 0, At, B0); PG8_MMA(1, 1, At, B1); PG8_BAR; PG8_SCHED;
            PG8_LDB(B0, 1, 0); PG8_LDB(B1, 1, 1); PG8_SCHED; PG8_LDA(At, 1, 0); PG8_STAGE(PG8_SA(0, 1), a2 + hstep, voffA);
            PG8_WAIT_V(8); PG8_WAIT_L(0); PG8_BAR; PG8_MMA(0, 0, At, B0); PG8_MMA(0, 1, At, B1); PG8_BAR; PG8_SCHED;
            PG8_LDA(At, 1, 1); PG8_STAGE(PG8_SB(1, 0), b3, voffB); PG8_STAGE(PG8_SB(1, 1), b3 + hstep, voffB); PG8_STAGE(PG8_SA(1, 0), a3, voffA);
            PG8_WAIT_V(8); PG8_WAIT_L(0); PG8_BAR; PG8_MMA(1, 0, At, B0); PG8_MMA(1, 1, At, B1); PG8_BAR; PG8_SCHED;
            } else {
            PG8_LDB(B0, 0, 0); PG8_SCHED; PG8_LDA(At, 0, 0); PG8_STAGE(PG8_SA(1, 1), a1 + hstep, voffA);
            PG8_WAIT_L(8); PG8_BAR; PG8_WAIT_L(0); PG8_MMA(0, 0, At, B0); PG8_BAR; PG8_SCHED;
            PG8_LDB(B1, 0, 1); PG8_STAGE(PG8_SB(0, 0), b2, voffB);
            PG8_BAR; PG8_WAIT_L(0); PG8_MMA(0, 1, At, B1); PG8_BAR;
            PG8_LDA(At, 0, 1); PG8_STAGE(PG8_SA(0, 0), a2, voffA);
            PG8_BAR; PG8_WAIT_L(0); PG8_MMA(1, 0, At, B0); PG8_BAR; PG8_SCHED;
            PG8_STAGE(PG8_SB(0, 1), b2 + hstep, voffB);
            PG8_WAIT_V(6); PG8_BAR; PG8_MMA(1, 1, At, B1); PG8_BAR;
            PG8_LDB(B0, 1, 0); PG8_SCHED; PG8_LDA(At, 1, 0); PG8_STAGE(PG8_SA(0, 1), a2 + hstep, voffA);
            PG8_WAIT_L(8); PG8_BAR; PG8_WAIT_L(0); PG8_MMA(0, 0, At, B0); PG8_BAR; PG8_SCHED;
            PG8_LDB(B1, 1, 1); PG8_STAGE(PG8_SB(1, 0), b3, voffB);
            PG8_BAR; PG8_WAIT_L(0); PG8_MMA(0, 1, At, B1); PG8_BAR;
            PG8_LDA(At, 1, 1); PG8_STAGE(PG8_SA(1, 0), a3, voffA);
            PG8_BAR; PG8_WAIT_L(0); PG8_MMA(1, 0, At, B0); PG8_BAR; PG8_SCHED;
            PG8_STAGE(PG8_SB(1, 1), b3 + hstep, voffB);
            PG8_WAIT_V(6); PG8_BAR; PG8_MMA(1, 1, At, B1); PG8_BAR;
            }
        }
        if constexpr (ALIGN_EPI) { if (wr == 0) PG8_BAR; }
        if constexpr (!Epi::AFTER_DRAIN) { E(acc, cur, wr, wc, fr, fq); S.done(cur); }
        if (!has_next) break;
#pragma unroll
        for (int a = 0; a < 2; ++a)
#pragma unroll
            for (int b = 0; b < 2; ++b)
#pragma unroll
                for (int m = 0; m < 4; ++m)
#pragma unroll
                    for (int n = 0; n < 2; ++n) acc[a][b][m][n] = (f32x4){0.f, 0.f, 0.f, 0.f};
        cur = nxt; cA = nA; cB = nB; ++ui;
        if constexpr (ALIGN_EPI) { if (wr == 1) PG8_BAR; }
    }
    PG8_WAIT_V(0);
    if constexpr (!ALIGN_EPI) { if (wr == 0) PG8_BAR; }
    PG8_BAR;
    if constexpr (Epi::AFTER_DRAIN) { E.fused(acc, cur, wr, wc, fr, fq, lds, wid, lane); S.done(cur); }
#undef PG8_SA
#undef PG8_SB
#undef PG8_STAGE
#undef PG8_LDA
#undef PG8_LDB
#undef PG8_MMA
#undef PG8_WAIT_V
#undef PG8_WAIT_L
#undef PG8_BAR
#undef PG8_SCHED
}
}
constexpr size_t MiB = 1u << 20;
constexpr size_t WS_CTL = 0, CTL_ZERO_BYTES = 1 * MiB;
constexpr int CW_BAR = 4096;
constexpr int CW_RNN = 12288;
constexpr int CW_STAMP = 16384;
constexpr int CW_Q2 = 8192, CW_Q3 = 8192 + 64;
constexpr size_t CTL_SS1 = 256 * 1024, CTL_SS2 = 384 * 1024, CTL_B1 = 640 * 1024, CTL_DUMMY = 768 * 1024;
constexpr size_t WS_ROT = 1 * MiB;
constexpr size_t WS_WC1 = 2 * MiB;
constexpr size_t WS_WC2 = WS_WC1 + 512 * 1024;
constexpr size_t WS_B1 = WS_WC2 + 32 * 1024;
constexpr size_t WS_WR = WS_B1 + 32 * 1024;
constexpr size_t WS_WIN = 4 * MiB, WS_WOUT = 10 * MiB, WS_WUP = 12 * MiB, WS_WDN = 20 * MiB;
constexpr size_t WS_XN = 32 * MiB;
constexpr size_t WS_QN = 66 * MiB, WS_QR = 83 * MiB;
constexpr size_t WS_KS = 100 * MiB, WS_VS = 105 * MiB, WS_KW = 110 * MiB, WS_VW = 115 * MiB;
constexpr size_t WS_GATES = 120 * MiB;
constexpr size_t WS_GRG = 122 * MiB;
constexpr size_t WS_RX = 139 * MiB;
constexpr size_t WS_HL = 172 * MiB, WS_AC = 205 * MiB;
constexpr size_t WS_CARRY = 239 * MiB;
constexpr size_t WS_SSA = 239 * MiB + 512 * 1024;
constexpr size_t WS_SUMM = 238 * MiB;
constexpr size_t WS_KCC = 240 * MiB, WS_VCC = 245 * MiB;
constexpr size_t WS_MIXED = 250 * MiB;
constexpr size_t WS_X1 = 284 * MiB;
constexpr size_t WS_H = 352 * MiB;
constexpr size_t WS_END = 486 * MiB;

constexpr int NWAVES = 8;
constexpr int RING_BYTES = 131072, LDS_BYTES = 147456, MISC_OFF = LDS_BYTES - 64;

#define GAS __attribute__((address_space(1)))
#define LAS __attribute__((address_space(3)))
typedef unsigned short bf16;
typedef unsigned v4u __attribute__((ext_vector_type(4)));
typedef unsigned v2u __attribute__((ext_vector_type(2)));
typedef float f32x4 __attribute__((ext_vector_type(4)));
typedef float f32x16 __attribute__((ext_vector_type(16)));
typedef short bf16x8 __attribute__((ext_vector_type(8)));
typedef short s16x4 __attribute__((ext_vector_type(4)));
typedef GAS unsigned gu32;
#define RLX_AGENT __ATOMIC_RELAXED, __HIP_MEMORY_SCOPE_AGENT
#define LDS_WAIT() asm volatile("s_waitcnt lgkmcnt(0)" ::: "memory")
typedef float f32x2_t __attribute__((ext_vector_type(2))); typedef __bf16 bf16x2_t __attribute__((ext_vector_type(2)));
__device__ __forceinline__ unsigned pk2(float lo, float hi) { f32x2_t v = {lo, hi}; bf16x2_t b = __builtin_convertvector(v, bf16x2_t); return __builtin_bit_cast(unsigned, b); }
__device__ __forceinline__ float bf2f(unsigned short h) { return __builtin_bit_cast(float, (unsigned)h << 16); }
__device__ __forceinline__ float bflo(unsigned w) { return __builtin_bit_cast(float, w << 16); }
__device__ __forceinline__ float bfhi(unsigned w) { return __builtin_bit_cast(float, w & 0xffff0000u); }
__device__ __forceinline__ float wave_sum(float v) {
#pragma unroll
    for (int o = 1; o < 64; o <<= 1) v += __shfl_xor(v, o);
    return v;
}

#define XB_TMO      128
#define XB_XCNT(j)  (256  + 64 * (j))
#define XB_XSUB(j)  (1280 + 64 * (j))
#define XB_XGEN(j)  (2304 + 64 * (j))
#define XB_TOP      3328
#define XB_TOPGEN   3392
#define XCD_BAR_WORDS 3456
#define XB_SPIN_CAP (1u << 18)

__device__ __forceinline__ unsigned xb_ld(unsigned* p)              { return __hip_atomic_load(p, __ATOMIC_RELAXED, __HIP_MEMORY_SCOPE_AGENT); }
__device__ __forceinline__ unsigned xb_add(unsigned* p, unsigned v) { return __hip_atomic_fetch_add(p, v, __ATOMIC_RELAXED, __HIP_MEMORY_SCOPE_AGENT); }
__device__ __forceinline__ unsigned xb_xcc_id() { return (unsigned)__builtin_amdgcn_s_getreg((3 << 11) | 20) & 0xFu; }
#define XB_SPIN(cond, bar) do { unsigned _sp = 0; while (cond) { __builtin_amdgcn_s_sleep(1); \
    if ((++_sp & 255u) == 0u) { if (xb_ld(&(bar)[XB_TMO])) break; if (_sp > XB_SPIN_CAP) { atomicAdd(&(bar)[XB_TMO], 1u); break; } } } } while (0)

struct XcdBarrier {
    unsigned* bar; unsigned x;
    volatile LAS unsigned* st;
};

__device__ __forceinline__ XcdBarrier xcd_barrier_post(unsigned* bar, volatile LAS unsigned* st) {
    XcdBarrier b; b.bar = bar; b.x = xb_xcc_id(); b.st = st;
    if (threadIdx.x == 0) (void)xb_add(&bar[XB_XCNT(b.x)], 1u);
    return b;
}
__device__ __forceinline__ void xcd_barrier_complete(unsigned* bar, unsigned x, unsigned& nloc, unsigned& nx) {
    const unsigned G = gridDim.x * gridDim.y * gridDim.z;
    unsigned sum, cnt, mine, sp = 0u;
    for (;;) {
        sum = 0u; cnt = 0u; mine = 0u;
#pragma unroll
        for (unsigned j = 0; j < 16; ++j) { const unsigned c = xb_ld(&bar[XB_XCNT(j)]); sum += c; cnt += (c > 0u) ? 1u : 0u; mine = (j == x) ? c : mine; }
        if (sum == G) break;
        __builtin_amdgcn_s_sleep(1);
        if ((++sp & 255u) == 0u) { if (xb_ld(&bar[XB_TMO])) break; if (sp > XB_SPIN_CAP) { atomicAdd(&bar[XB_TMO], 1u); break; } }
    }
    nloc = mine > 0u ? mine : 1u; nx = cnt > 0u ? cnt : 1u;
}

__device__ __forceinline__ void xcd_barrier(const XcdBarrier& b) {
    asm volatile("s_waitcnt vmcnt(0)" ::: "memory");
    __syncthreads();
    if (threadIdx.x == 0) {
        unsigned* bar = b.bar;
        __builtin_amdgcn_s_waitcnt(0);
        unsigned nloc = b.st[0], nx = b.st[1];
        if (nloc == 0u) { xcd_barrier_complete(bar, b.x, nloc, nx); b.st[0] = nloc; b.st[1] = nx; }
        const unsigned old = xb_add(&bar[XB_XSUB(b.x)], 1u);
        const unsigned gen = old / nloc;
        if (old + 1u == (gen + 1u) * nloc) {
            __builtin_amdgcn_fence(__ATOMIC_RELEASE, "agent");
            asm volatile("s_waitcnt vmcnt(0)" ::: "memory");
            const unsigned og = xb_add(&bar[XB_TOP], 1u);
            const unsigned tg = og / nx;
            if (og + 1u == (tg + 1u) * nx) xb_add(&bar[XB_TOPGEN], 1u);
            else XB_SPIN(xb_ld(&bar[XB_TOPGEN]) == tg, bar);
            __builtin_amdgcn_fence(__ATOMIC_ACQUIRE, "agent");
            xb_add(&bar[XB_XGEN(b.x)], 1u);
            asm volatile("s_waitcnt vmcnt(0)" ::: "memory");
        } else {
            XB_SPIN(xb_ld(&bar[XB_XGEN(b.x)]) == gen, bar);
            __builtin_amdgcn_fence(__ATOMIC_ACQUIRE, "agent");
            asm volatile("s_waitcnt vmcnt(0)" ::: "memory");
        }
    }
    __syncthreads();
}

struct Frame {
    LAS unsigned char* lds;
    int tid, lane, wave, G, vcu;
    const float* const* in; const int* page_table;
    float* out; unsigned char* ws; gu32* ctl;
};
#define WSP(T, off) ((T*)(F.ws + (off)))

template <int MAP>
__device__ __forceinline__ void p0_transpose_item(const float* W, int ldw, int K, int Nphys, bf16* WT, int row_off, LAS float* scr, int item, int lane, const float* kscale) {
    const int nblk = Nphys / 32, kb = item / nblk, nb = item % nblk, k0 = 64 * kb, n0 = 32 * nb;
    const int np = n0 + (lane & 31);
    int ln = np;
    if (MAP == 1) ln = np < 1280 ? np : (np < 2304 ? np + 24 : (np < 2328 ? np - 1024 : -1));
    float tv[32];
#pragma unroll
    for (int i = 0; i < 32; ++i) { const int kk = 2 * i + (lane >> 5); tv[i] = ln >= 0 ? W[(size_t)(k0 + kk) * ldw + ln] : 0.f; }
#pragma unroll
    for (int i = 0; i < 32; ++i) { const int kk = 2 * i + (lane >> 5); float v = tv[i];
        if (kscale) v *= kscale[k0 + kk];
        scr[kk * 33 + (lane & 31)] = v; }
    LDS_WAIT(); asm volatile("" ::: "memory");
    const int c = lane & 7;
#pragma unroll
    for (int j = 0; j < 4; ++j) { const int n = (lane >> 3) + 8 * j; const LAS float* s = scr + (8 * c) * 33 + n;
        v4u o; o.x = pk2(s[0 * 33], s[1 * 33]); o.y = pk2(s[2 * 33], s[3 * 33]); o.z = pk2(s[4 * 33], s[5 * 33]); o.w = pk2(s[6 * 33], s[7 * 33]);
        *(GAS v4u*)(WT + (size_t)(row_off + n0 + n) * K + k0 + 8 * c) = o; }
    LDS_WAIT(); asm volatile("" ::: "memory");
}
__device__ __forceinline__ void rms_row_to_bf16(const float* xrow, const float* g, bf16* orow, int lane) {
    const GAS f32x4* xr = (const GAS f32x4*)xrow + lane; const GAS f32x4* gr = (const GAS f32x4*)g + lane;
    f32x4 v[4]; float s = 0.f;
#pragma unroll
    for (int j = 0; j < 4; ++j) { v[j] = xr[64 * j]; s += (v[j].x * v[j].x + v[j].y * v[j].y) + (v[j].z * v[j].z + v[j].w * v[j].w); }
    const float rs = rsqrtf(wave_sum(s) * (1.f / DM) + EPSN);
    GAS unsigned long long* o8 = (GAS unsigned long long*)orow + lane;
#pragma unroll
    for (int j = 0; j < 4; ++j) { const f32x4 gg = gr[64 * j];
        o8[64 * j] = (unsigned long long)pk2(v[j].x * rs * gg.x, v[j].y * rs * gg.y) | ((unsigned long long)pk2(v[j].z * rs * gg.z, v[j].w * rs * gg.w) << 32); }
}
__device__ __forceinline__ void p0_prologue(Frame& F) {
    LAS float* scr = (LAS float*)(F.lds + F.wave * 16384);
    const int gw = F.vcu * NWAVES + F.wave, NGW = F.G * NWAVES;
    constexpr int I_IN = 16 * (NIN / 32), I_OUT = 16 * 32, I_UP = 16 * (FF / 32), I_DN = 64 * 32, I_C1 = 4 * 32, I_C2 = 2 * 2, I_R = 16 * 2;
    constexpr int NITEMS = I_IN + I_OUT + I_UP + I_DN + I_C1 + I_C2 + I_R;
    for (int it = gw; it < NITEMS; it += NGW) {
        int r = it;
        if (r < I_IN) { p0_transpose_item<1>(F.in[7], 2328, DM, NIN, WSP(bf16, WS_WIN), 0, scr, r, F.lane, nullptr); continue; } r -= I_IN;
        if (r < I_OUT) { p0_transpose_item<0>(F.in[23], DM, DM, DM, WSP(bf16, WS_WOUT), 0, scr, r, F.lane, nullptr); continue; } r -= I_OUT;
        if (r < I_UP) { p0_transpose_item<0>(F.in[26], FF, DM, FF, WSP(bf16, WS_WUP), 0, scr, r, F.lane, F.in[25]); continue; } r -= I_UP;
        if (r < I_DN) { p0_transpose_item<0>(F.in[27], DM, FF, DM, WSP(bf16, WS_WDN), 0, scr, r, F.lane, nullptr); continue; } r -= I_DN;
        if (r < I_C1) { const int q = r / 32, slot = q >> 1, half = q & 1;
            p0_transpose_item<0>(F.in[slot ? 12 : 9] + (size_t)half * 1024 * 64, 64, 1024, 64, WSP(bf16, WS_WC1) + (size_t)slot * 128 * 1024, half * 64, scr, r % 32, F.lane, nullptr); continue; } r -= I_C1;
        if (r < I_C2) { const int slot = r >> 1;
            p0_transpose_item<0>(F.in[slot ? 13 : 10], 64, 64, 64, WSP(bf16, WS_WC2) + (size_t)slot * 4096, 0, scr, r & 1, F.lane, nullptr); continue; } r -= I_C2;
        { const int q = r >> 1, blk = q >> 1, which = q & 1;
            p0_transpose_item<0>(F.in[which ? 20 : 18] + (size_t)blk * 4096, 64, 64, 64, WSP(bf16, WS_WR) + (size_t)blk * 8192, which * 64, scr, r & 1, F.lane, nullptr); }
    }
    { const int gt = gw * 64 + F.lane;
      if (gt < 2052 * 8) { const int pos = gt >> 3, i = gt & 7;
          const double inv = pow(500000.0, -(double)i / 8.0), ang = (double)pos * inv;
          float* rt = WSP(float, WS_ROT) + pos * 16; rt[i] = (float)cos(ang); rt[8 + i] = (float)sin(ang); } }
    if (gw >= NGW - 64) { const int idx = gw - (NGW - 64), slot = idx >> 5, kp = idx & 31; const float* pe = F.in[slot ? 11 : 8] + kp * 64; const float* w1 = F.in[slot ? 12 : 9] + (size_t)kp * 64 * 64;
        float a = 0.f;
#pragma unroll 16
        for (int k = 0; k < 64; ++k) a += pe[k] * w1[(size_t)k * 64 + F.lane];
        atomicAdd((float*)(F.ws + WS_CTL + CTL_B1) + slot * 64 + F.lane, a); }
    {   const GAS f32x4* gr = (const GAS f32x4*)F.in[24] + F.lane;
        f32x4 gg[4];
#pragma unroll
        for (int j = 0; j < 4; ++j) gg[j] = gr[64 * j];
        for (int m0 = gw; m0 < MT; m0 += 4 * NGW) {
            f32x4 v[4][4]; float s[4];
#pragma unroll
            for (int q = 0; q < 4; ++q) { const int m = m0 + q * NGW; s[q] = 0.f;
                if (m < MT) { const float* xr = m < MP ? F.in[0] + (size_t)m * DM : F.in[1] + (size_t)(m - MP) * DM; const GAS f32x4* xp = (const GAS f32x4*)xr + F.lane;
#pragma unroll
                    for (int j = 0; j < 4; ++j) v[q][j] = xp[64 * j]; } }
#pragma unroll
            for (int q = 0; q < 4; ++q) { const int m = m0 + q * NGW;
                if (m < MT) {
#pragma unroll
                    for (int j = 0; j < 4; ++j) s[q] += (v[q][j].x * v[q][j].x + v[q][j].y * v[q][j].y) + (v[q][j].z * v[q][j].z + v[q][j].w * v[q][j].w);
                    const float rs = rsqrtf(wave_sum(s[q]) * (1.f / DM) + EPSN);
                    GAS unsigned long long* o8 = (GAS unsigned long long*)(WSP(bf16, WS_XN) + (size_t)m * DM) + F.lane;
#pragma unroll
                    for (int j = 0; j < 4; ++j) o8[64 * j] = (unsigned long long)pk2(v[q][j].x * rs * gg[j].x, v[q][j].y * rs * gg[j].y) | ((unsigned long long)pk2(v[q][j].z * rs * gg[j].z, v[q][j].w * rs * gg[j].w) << 32); } }
        }
    }
}
__device__ __forceinline__ void p7_final(Frame& F) {
    const int gw = F.vcu * NWAVES + F.wave, NGW = F.G * NWAVES;
    const GAS f32x4* gr = (const GAS f32x4*)F.in[28] + F.lane;
    f32x4 gg[4];
#pragma unroll
    for (int j = 0; j < 4; ++j) gg[j] = gr[64 * j];
    for (int m0 = gw; m0 < MT; m0 += 4 * NGW) {
        f32x4 v[4][4];
#pragma unroll
        for (int q = 0; q < 4; ++q) { const int m = m0 + q * NGW;
            if (m < MT) { const GAS f32x4* yr = (const GAS f32x4*)(F.out + (size_t)m * DM) + F.lane;
#pragma unroll
                for (int j = 0; j < 4; ++j) v[q][j] = yr[64 * j]; } }
#pragma unroll
        for (int q = 0; q < 4; ++q) { const int m = m0 + q * NGW;
            if (m < MT) { float s = 0.f;
#pragma unroll
                for (int j = 0; j < 4; ++j) s += (v[q][j].x * v[q][j].x + v[q][j].y * v[q][j].y) + (v[q][j].z * v[q][j].z + v[q][j].w * v[q][j].w);
                const float rs = rsqrtf(wave_sum(s) * (1.f / DM) + EPSN);
                GAS f32x4* yr = (GAS f32x4*)(F.out + (size_t)m * DM) + F.lane;
#pragma unroll
                for (int j = 0; j < 4; ++j) yr[64 * j] = v[q][j] * rs * gg[j]; } }
    }
}

__device__ __forceinline__ void rnn_unit(Frame& F, int u_, int probe_u = -1) {
    const int u = probe_u >= 0 ? probe_u : u_;
    const int b = F.wave, lane = F.lane, fr = lane & 15, fq = lane >> 4;
    const bool samp = u >= 256;
    const int rowbase = samp ? MP + 64 * (u - 256) : (u >> 5) * SEQ + (u & 31) * 64;
    const int t0 = samp ? 0 : (u & 31) * 64;
    const float* RX = WSP(float, WS_RX); float* HL = WSP(float, WS_HL); float* AC = WSP(float, WS_AC);
    const float* convw = F.in[16]; const float* convb = F.in[17]; const float* stc = F.in[4]; const float* sth = F.in[5];
    LAS float* xcs = (LAS float*)(F.lds + b * 8704);
    const bf16* wrp = WSP(bf16, WS_WR) + (size_t)b * 8192 + fr * 64 + 8 * fq;
    float hc[4], Ac[4], braA[4], briA[4], spA[4];
#pragma unroll
    for (int nn = 0; nn < 4; ++nn) { const int ch = 64 * b + 16 * nn + fr; hc[nn] = 0.f; Ac[nn] = 1.f; braA[nn] = F.in[19][ch]; briA[nn] = F.in[21][ch]; spA[nn] = log1pf(__expf(-F.in[22][ch])); }
    bf16x8 wq[2][2];
#pragma unroll
    for (int g = 0; g < 2; ++g)
#pragma unroll
        for (int ks = 0; ks < 2; ++ks) wq[g][ks] = *(const bf16x8*)(wrp + (size_t)(64 * g) * 64 + 32 * ks);
#ifndef RNN_PASSES
#define RNN_PASSES 1
#endif
    for (int rpass = 0; rpass < RNN_PASSES; ++rpass) {
    if (rpass > 0) {
#pragma unroll
        for (int nn = 0; nn < 4; ++nn) { hc[nn] = 0.f; Ac[nn] = 1.f; } }
    for (int sub = 0; sub < 2; ++sub) {
        bf16x8 af[2][2];
#pragma unroll
        for (int m = 0; m < 2; ++m) {
            const int tau = 32 * sub + 16 * m + fr;
#pragma unroll
            for (int ks = 0; ks < 2; ++ks) {
                const int cbase = 64 * b + 32 * ks + 8 * fq;
                f32x4 xa = *(const f32x4*)(convb + cbase), xb = *(const f32x4*)(convb + cbase + 4);
#pragma unroll
                for (int k = 0; k < 4; ++k) {
                    const float* src; bool ok = true;
                    if (!samp) { const int rr = tau - 3 + k; ok = (t0 + rr) >= 0; src = RX + (size_t)(rowbase + rr) * 512 + cbase; }
                    else { const int r2 = (tau & 3) - 3 + k;
                        if (r2 >= 0) src = RX + (size_t)(rowbase + (tau & ~3) + r2) * 512 + cbase;
                        else src = stc + ((size_t)((u - 256) * 16 + (tau >> 2)) * 3 + (3 + r2)) * 512 + cbase; }
                    f32x4 v0 = (f32x4){0.f, 0.f, 0.f, 0.f}, v1 = v0;
                    if (ok) { v0 = *(const f32x4*)src; v1 = *(const f32x4*)(src + 4); }
                    const f32x4 w0 = *(const f32x4*)(convw + k * 512 + cbase), w1 = *(const f32x4*)(convw + k * 512 + cbase + 4);
                    xa += w0 * v0; xb += w1 * v1;
                }
                v4u pk; pk.x = pk2(xa[0], xa[1]); pk.y = pk2(xa[2], xa[3]); pk.z = pk2(xb[0], xb[1]); pk.w = pk2(xb[2], xb[3]);
                af[m][ks] = __builtin_bit_cast(bf16x8, pk);
                LAS float* xd = xcs + (16 * m + fr) * 68 + 32 * ks + 8 * fq;
                *(LAS f32x4*)xd = xa; *(LAS f32x4*)(xd + 4) = xb;
            }
        }
        LDS_WAIT();
#pragma unroll 1
        for (int nn = 0; nn < 4; ++nn) {
            const int ch = 64 * b + 16 * nn + fr;
            f32x4 acc[2][2];
#pragma unroll
            for (int m = 0; m < 2; ++m) { acc[m][0] = (f32x4){0.f, 0.f, 0.f, 0.f}; acc[m][1] = acc[m][0]; }
            bf16x8 wc_[2][2];
#pragma unroll
            for (int g = 0; g < 2; ++g)
#pragma unroll
                for (int ks = 0; ks < 2; ++ks) wc_[g][ks] = wq[g][ks];
            { const int nx = (nn + 1) & 3;
#pragma unroll
              for (int g = 0; g < 2; ++g)
#pragma unroll
                  for (int ks = 0; ks < 2; ++ks) wq[g][ks] = *(const bf16x8*)(wrp + (size_t)(64 * g + 16 * nx) * 64 + 32 * ks); }
#pragma unroll
            for (int g = 0; g < 2; ++g)
#pragma unroll
                for (int ks = 0; ks < 2; ++ks)
#pragma unroll
                    for (int m = 0; m < 2; ++m) acc[m][g] = __builtin_amdgcn_mfma_f32_16x16x32_bf16(af[m][ks], wc_[g][ks], acc[m][g], 0, 0, 0);
            float hcn = 0.f, acn = 1.f, bra = 0.f, bri = 0.f, sp = 0.f;
#pragma unroll
            for (int q = 0; q < 4; ++q) if (q == nn) { hcn = hc[q]; acn = Ac[q]; bra = braA[q]; bri = briA[q]; sp = spA[q]; }
#pragma unroll
            for (int m = 0; m < 2; ++m) {
                float a[4], bb[4];
#pragma unroll
                for (int e = 0; e < 4; ++e) {
                    const float r = 1.f / (1.f + __expf(-(acc[m][0][e] + bra)));
                    const float ig = 1.f / (1.f + __expf(-(acc[m][1][e] + bri)));
                    const float la = -8.0f * r * sp;
                    a[e] = __expf(la);
                    const float xcv = xcs[(16 * m + 4 * fq + e) * 68 + 16 * nn + fr];
                    bb[e] = sqrtf(fmaxf(1.f - a[e] * a[e], 0.f)) * (ig * xcv);
                }
                const int trow = rowbase + 32 * sub + 16 * m + 4 * fq;
                if (!samp) {
                    const float Pl = (a[0] * a[1]) * (a[2] * a[3]);
                    float Hl = bb[0]; Hl = a[1] * Hl + bb[1]; Hl = a[2] * Hl + bb[2]; Hl = a[3] * Hl + bb[3];
                    float cin = hcn, ain = acn;
#pragma unroll
                    for (int k = 0; k < 4; ++k) {
                        const float hend = Pl * cin + Hl, aend = ain * Pl;
                        const float nh = __shfl(hend, fr + 16 * k), na = __shfl(aend, fr + 16 * k);
                        if (k < 3) { if (fq == k + 1) { cin = nh; ain = na; } } else { hcn = nh; acn = na; }
                    }
                    float hv = cin, av = ain;
#pragma unroll
                    for (int e = 0; e < 4; ++e) { hv = a[e] * hv + bb[e]; av *= a[e]; HL[(size_t)(trow + e) * 512 + ch] = hv; AC[(size_t)(trow + e) * 512 + ch] = av; }
                } else {
                    const int s = (u - 256) * 16 + 8 * sub + 4 * m + fq;
                    float hv = sth[(size_t)s * 512 + ch];
#pragma unroll
                    for (int e = 0; e < 4; ++e) { hv = a[e] * hv + bb[e]; HL[(size_t)(trow + e) * 512 + ch] = hv; AC[(size_t)(trow + e) * 512 + ch] = 0.f; }
                    F.out[O_HS + (size_t)s * 512 + ch] = hv;
                }
            }
#pragma unroll
            for (int q = 0; q < 4; ++q) if (q == nn) { hc[q] = hcn; Ac[q] = acn; }
        }
        LDS_WAIT();
    }
    }
    if (!samp && fq == 0) { float* sm = WSP(float, WS_SUMM) + (size_t)u * 1024;
#pragma unroll
        for (int nn = 0; nn < 4; ++nn) { const int ch = 64 * b + 16 * nn + fr; sm[ch] = hc[nn]; sm[512 + ch] = Ac[nn]; } }
    if (!samp && probe_u < 0) {
        asm volatile("s_waitcnt vmcnt(0)" ::: "memory");
        __syncthreads();
        volatile LAS unsigned* MISC = (volatile LAS unsigned*)(F.lds + MISC_OFF);
        const int n = u >> 5;
        if (F.tid == 0) {
            __builtin_amdgcn_fence(__ATOMIC_RELEASE, "agent");
            asm volatile("s_waitcnt vmcnt(0)" ::: "memory");
            const unsigned old = __hip_atomic_fetch_add((unsigned*)(F.ctl + CW_RNN + 64 * n), 1u, RLX_AGENT);
            if (old == 31u) { __builtin_amdgcn_fence(__ATOMIC_ACQUIRE, "agent"); asm volatile("s_waitcnt vmcnt(0)" ::: "memory"); }
            MISC[1] = old;
        }
        __syncthreads();
        const bool last = MISC[1] == 31u;
        if (last) {
            const float* sm = WSP(float, WS_SUMM) + (size_t)n * 32 * 1024 + F.tid; float* cr = WSP(float, WS_CARRY) + (size_t)n * 32 * 512 + F.tid;
            float hv[32], av[32];
#pragma unroll
            for (int c = 0; c < 32; ++c) { hv[c] = __builtin_nontemporal_load(sm + c * 1024); av[c] = __builtin_nontemporal_load(sm + c * 1024 + 512); }
            float carry = 0.f;
#pragma unroll
            for (int c = 0; c < 32; ++c) { cr[c * 512] = carry; carry = av[c] * carry + hv[c]; }
        }
    }
}

__device__ __forceinline__ void compress_unit(Frame& F, int cu) {
    const int tid = F.tid, lane = F.lane, w = F.wave, wr = w >> 2, wc = w & 3, fr = lane & 15, fq = lane >> 4;
    const bool samp = cu < 512;
    const int q = samp ? cu : cu - 512, sq = q >> 2, h = (q >> 1) & 1, slot = q & 1;
    const int seqi = samp ? 8 + sq : sq;
    const int r4 = lane >> 4, c16 = lane & 15;
    const float* ab0; const float* ab1;
    if (samp) { const int pg0 = F.page_table[sq * 16 + 2 * w], pg1 = F.page_table[sq * 16 + 2 * w + 1];
        ab0 = F.in[2] + ((size_t)pg0 * 128 + 16 * r4) * 512 + slot * 128 + h * 64 + 4 * c16; ab1 = F.in[2] + ((size_t)pg1 * 128 + 16 * r4) * 512 + slot * 128 + h * 64 + 4 * c16; }
    else { ab0 = F.out + O_KV + ((size_t)sq * SEQ + 16 * (16 * w + r4)) * 512 + slot * 128 + h * 64 + 4 * c16; ab1 = ab0 + (size_t)128 * 512; }
    const int wof0 = (16 * w + r4) * 128 + (((c16 >> 1) ^ r4) << 4) + (c16 & 1) * 8;
#define CMP_ABASE(ii_) (((ii_) < 2 ? ab0 : ab1) + (size_t)(((ii_) & 1) * 64) * 512)
#define CMP_WOFS(ii_) ((((ii_) & 1) ? (wof0 ^ 64) : wof0) + 512 * (ii_))
    const bf16* bbase = WSP(bf16, WS_WC1) + (size_t)slot * 128 * 1024 + (size_t)(16 * w + r4) * 1024 + 4 * c16;
    LAS unsigned char* lds = F.lds;
    f32x4 ar[4][4]; v2u br[4][4];
    f32x4 acc[4][2];
#pragma unroll
    for (int m = 0; m < 4; ++m)
#pragma unroll
        for (int n = 0; n < 2; ++n) acc[m][n] = (f32x4){0.f, 0.f, 0.f, 0.f};
#define CMP_LOAD(s_, j) do { _Pragma("unroll") for (int i_ = 0; i_ < 4; ++i_) { ar[s_][i_] = *(const f32x4*)(CMP_ABASE(i_) + (size_t)(j) * 512); br[s_][i_] = *(const v2u*)(bbase + (size_t)(4 * i_) * 1024 + (j) * 64); } } while (0)
#define CMP_WRITE(s_, st) do { LAS unsigned char* A_ = lds + (st) * 32768; LAS unsigned char* B_ = A_ + 16384; \
        _Pragma("unroll") for (int i_ = 0; i_ < 4; ++i_) { v2u p_; p_.x = pk2(ar[s_][i_][0], ar[s_][i_][1]); p_.y = pk2(ar[s_][i_][2], ar[s_][i_][3]); \
            *(LAS v2u*)(A_ + CMP_WOFS(i_)) = p_; *(LAS v2u*)(B_ + CMP_WOFS(i_)) = br[s_][i_]; } } while (0)
#define CMP_COMPUTE(st) do { const LAS unsigned char* A_ = lds + (st) * 32768; const LAS unsigned char* B_ = A_ + 16384; \
        bf16x8 af[4][2], bf[2][2]; \
        _Pragma("unroll") for (int m = 0; m < 4; ++m) _Pragma("unroll") for (int k = 0; k < 2; ++k) { const int row = 64 * wr + 16 * m + fr; af[m][k] = *(const LAS bf16x8*)(A_ + row * 128 + (((4 * k + fq) ^ (row & 7)) << 4)); } \
        _Pragma("unroll") for (int n = 0; n < 2; ++n) _Pragma("unroll") for (int k = 0; k < 2; ++k) { const int row = 32 * wc + 16 * n + fr; bf[n][k] = *(const LAS bf16x8*)(B_ + row * 128 + (((4 * k + fq) ^ (row & 7)) << 4)); } \
        _Pragma("unroll") for (int m = 0; m < 4; ++m) _Pragma("unroll") for (int n = 0; n < 2; ++n) _Pragma("unroll") for (int k = 0; k < 2; ++k) \
            acc[m][n] = __builtin_amdgcn_mfma_f32_16x16x32_bf16(bf[n][k], af[m][k], acc[m][n], 0, 0, 0); } while (0)
    CMP_LOAD(0, 0); CMP_LOAD(1, 1); CMP_LOAD(2, 2); CMP_WRITE(0, 0);
    __syncthreads();
#pragma unroll
    for (int j = 0; j < 16; ++j) {
        if (j + 3 < 16) CMP_LOAD((j + 3) & 3, j + 3);
        CMP_COMPUTE(j & 1);
        if (j + 1 < 16) CMP_WRITE((j + 1) & 3, (j + 1) & 1);
        __syncthreads();
    }
#undef CMP_COMPUTE
#undef CMP_ABASE
#undef CMP_WOFS
#undef CMP_LOAD
#undef CMP_WRITE
    LAS float* Ys = (LAS float*)lds;
#pragma unroll
    for (int m = 0; m < 4; ++m)
#pragma unroll
        for (int n = 0; n < 2; ++n) *(LAS f32x4*)(Ys + (64 * wr + 16 * m + fr) * 132 + 32 * wc + 16 * n + 4 * fq) = acc[m][n];
    __syncthreads();
    LAS unsigned char* Hs = lds + 73728;
    { const int c = tid >> 2, e0 = (tid & 3) * 16; const float* b1 = (const float*)(F.ws + WS_CTL + CTL_B1) + slot * 64;
      float hv[16];
#pragma unroll
      for (int i = 0; i < 16; ++i) { float v = 0.f; if (c < 127) v = pg8::gelu_tanh(Ys[c * 132 + e0 + i] + Ys[(c + 1) * 132 + 64 + e0 + i] + b1[e0 + i]); hv[i] = v; }
      v4u p0, p1; p0.x = pk2(hv[0], hv[1]); p0.y = pk2(hv[2], hv[3]); p0.z = pk2(hv[4], hv[5]); p0.w = pk2(hv[6], hv[7]);
      p1.x = pk2(hv[8], hv[9]); p1.y = pk2(hv[10], hv[11]); p1.z = pk2(hv[12], hv[13]); p1.w = pk2(hv[14], hv[15]);
      const int c8 = (tid & 3) * 2;
      *(LAS v4u*)(Hs + c * 128 + ((c8 ^ (c & 7)) << 4)) = p0; *(LAS v4u*)(Hs + c * 128 + (((c8 + 1) ^ (c & 7)) << 4)) = p1; }
    __syncthreads();
    { const bf16* w2 = WSP(bf16, WS_WC2) + (size_t)slot * 4096;
      f32x4 a2[4];
#pragma unroll
      for (int n = 0; n < 4; ++n) a2[n] = (f32x4){0.f, 0.f, 0.f, 0.f};
      const int row = 16 * w + fr;
#pragma unroll
      for (int k = 0; k < 2; ++k) { const bf16x8 hf = *(const LAS bf16x8*)(Hs + row * 128 + (((4 * k + fq) ^ (row & 7)) << 4));
#pragma unroll
          for (int n = 0; n < 4; ++n) { const bf16x8 wv = *(const bf16x8*)(w2 + (16 * n + fr) * 64 + 32 * k + 8 * fq); a2[n] = __builtin_amdgcn_mfma_f32_16x16x32_bf16(wv, hf, a2[n], 0, 0, 0); } }
      bf16* dst = WSP(bf16, slot ? WS_VCC : WS_KCC) + ((size_t)seqi * 128 + row) * 128 + h * 64;
#pragma unroll
      for (int n = 0; n < 4; ++n) { v2u o; o.x = pk2(a2[n][0], a2[n][1]); o.y = pk2(a2[n][2], a2[n][3]); *(v2u*)(dst + 16 * n + 4 * fq) = o; } }
    __syncthreads();
}

constexpr float C2S = 0.125f * 1.4426950408889634f;
constexpr float NEGB = -1e30f;
constexpr int A_OA = 65536, A_IMP = 98304, A_SEL = 107520, A_GT = 108032, A_WSF = 111104;
__device__ __forceinline__ int crow(int r, int hi) { return (r & 3) + 8 * (r >> 2) + 4 * hi; }
__device__ __forceinline__ float ex2(float x) { return __builtin_amdgcn_exp2f(x); }

__device__ __forceinline__ void qk_tile(f32x16& p0, f32x16& p1, const LAS unsigned char* Kt, const bf16x8 (&qf)[4], int r32, int hi) {
#pragma unroll
    for (int r = 0; r < 16; ++r) { p0[r] = 0.f; p1[r] = 0.f; }
#pragma unroll
    for (int d0 = 0; d0 < 4; ++d0) {
        const int off = r32 * 128 + (((2 * d0 + hi) ^ (r32 & 7)) << 4);
        const bf16x8 ka = *(const LAS bf16x8*)(Kt + off), kb = *(const LAS bf16x8*)(Kt + off + 4096);
        p0 = __builtin_amdgcn_mfma_f32_32x32x16_bf16(ka, qf[d0], p0, 0, 0, 0);
        p1 = __builtin_amdgcn_mfma_f32_32x32x16_bf16(kb, qf[d0], p1, 0, 0, 0);
    }
}
__device__ __forceinline__ void pv_tile(f32x16 (&o)[2], const LAS unsigned char* Vt, const bf16x8 (&pa)[4], int lane) {
    const int g = lane >> 4, i = lane & 15, q = i >> 2, p = i & 3, hg = g >> 1;
#pragma unroll
    for (int d0 = 0; d0 < 2; ++d0)
#pragma unroll
        for (int ks = 0; ks < 4; ++ks) {
            const int row0 = 16 * ks + 4 * hg + q, chunk = 4 * d0 + 2 * (g & 1) + (p >> 1);
            const LAS unsigned char* a0 = Vt + row0 * 128 + ((chunk ^ (row0 & 7)) << 4) + 8 * (p & 1);
            const s16x4 lo = __builtin_bit_cast(s16x4, __builtin_amdgcn_ds_read_tr16_b64_v4i16((LAS s16x4*)a0));
            const s16x4 hi4 = __builtin_bit_cast(s16x4, __builtin_amdgcn_ds_read_tr16_b64_v4i16((LAS s16x4*)(a0 + 1024)));
            const bf16x8 bv = (bf16x8){lo[0], lo[1], lo[2], lo[3], hi4[0], hi4[1], hi4[2], hi4[3]};
            o[d0] = __builtin_amdgcn_mfma_f32_32x32x16_bf16(pa[ks], bv, o[d0], 0, 0, 0);
        }
}
__device__ __forceinline__ void pack_p(bf16x8 (&pa)[4], const f32x16& p0, const f32x16& p1) {
#pragma unroll
    for (int ks = 0; ks < 2; ++ks) {
        v4u a, b;
        a.x = pk2(p0[8 * ks + 0], p0[8 * ks + 1]); a.y = pk2(p0[8 * ks + 2], p0[8 * ks + 3]); a.z = pk2(p0[8 * ks + 4], p0[8 * ks + 5]); a.w = pk2(p0[8 * ks + 6], p0[8 * ks + 7]);
        b.x = pk2(p1[8 * ks + 0], p1[8 * ks + 1]); b.y = pk2(p1[8 * ks + 2], p1[8 * ks + 3]); b.z = pk2(p1[8 * ks + 4], p1[8 * ks + 5]); b.w = pk2(p1[8 * ks + 6], p1[8 * ks + 7]);
        pa[ks] = __builtin_bit_cast(bf16x8, a); pa[2 + ks] = __builtin_bit_cast(bf16x8, b);
    }
}
__device__ __forceinline__ float mask_scale(f32x16& p0, f32x16& p1, int kbase, int klo, int khi, bool rflag, int hi) {
    float mx = NEGB;
#pragma unroll
    for (int r = 0; r < 16; ++r) { const int kv = kbase + crow(r, hi);
        const bool v0 = rflag && kv >= klo && kv <= khi, v1 = rflag && (kv + 32) >= klo && (kv + 32) <= khi;
        p0[r] = v0 ? p0[r] * C2S : NEGB; p1[r] = v1 ? p1[r] * C2S : NEGB;
        mx = fmaxf(mx, fmaxf(p0[r], p1[r])); }
    return fmaxf(mx, __shfl_xor(mx, 32));
}

template <bool SAMP>
__device__ __forceinline__ void attn_unit(Frame& F, int sq, int qb) {
    int tid = F.tid; asm volatile("" : "+v"(tid));
    const int lane = tid & 63, w = F.wave, r32 = lane & 31, hi = lane >> 5, h = w >> 2, wg = w & 3;
    const int q0 = SAMP ? 0 : qb * 32;
    const int rowbase = SAMP ? MP + 4 * sq : sq * SEQ + q0;
    const int tok = SAMP ? (r32 & 3) : r32;
    const int myhead = h * 4 + (SAMP ? ((r32 >> 2) & 3) : wg);
    const int qpos = SAMP ? SEQ + tok : q0 + r32;
    const int cur = SAMP ? 32 : (q0 >> 6);
    const int seqc = SAMP ? 8 + sq : sq;
    constexpr int NT = SAMP ? 4 : 32;
    LAS unsigned char* lds = F.lds;
    LAS float* IMP = (LAS float*)(lds + A_IMP);
    LAS unsigned long long* SEL = (LAS unsigned long long*)(lds + A_SEL);
    LAS float* GT = (LAS float*)(lds + A_GT);
    LAS float* wsf = (LAS float*)(lds + A_WSF) + w * 64;
    LAS unsigned short* OA = (LAS unsigned short*)(lds + A_OA);
    const bf16 *KS = WSP(bf16, WS_KS), *VS = WSP(bf16, WS_VS), *KW = WSP(bf16, WS_KW), *VW = WSP(bf16, WS_VW), *KCC = WSP(bf16, WS_KCC), *VCC = WSP(bf16, WS_VCC);
    const int lrow = tid >> 3, lch = tid & 7;
    const int lwo = lrow * 128 + ((lch ^ (lrow & 7)) << 4);
    v4u rb[4]; f32x4 rf[8]; bool isf32 = false; unsigned ldmask = 0xF;
#define LD_ISSUE(kind, j, hmask) do { isf32 = false; ldmask = 0; \
        _Pragma("unroll") for (int mi = 0; mi < 4; ++mi) { const int hm_ = mi >> 1, isV_ = mi & 1; \
            if (!(((hmask) >> hm_) & 1)) continue; ldmask |= 1u << mi; \
            if ((kind) == 0) { rb[mi] = *(const v4u*)((isV_ ? VCC : KCC) + ((size_t)(seqc * 128 + 64 * (j) + lrow)) * 128 + hm_ * 64 + lch * 8); } \
            else if (!SAMP) { rb[mi] = *(const v4u*)(((kind) == 1 ? (isV_ ? VS : KS) : (isV_ ? VW : KW)) + ((size_t)(sq * SEQ + 64 * (j) + lrow)) * 128 + hm_ * 64 + lch * 8); } \
            else if ((kind) == 1) { \
                if ((j) < 32) { isf32 = true; const float* s_ = F.in[2] + ((size_t)F.page_table[sq * 16 + ((j) >> 1)] * 128 + ((j) & 1) * 64 + lrow) * 512 + (2 + isV_) * 128 + hm_ * 64 + lch * 8; \
                    rf[2 * mi] = *(const f32x4*)s_; rf[2 * mi + 1] = *(const f32x4*)(s_ + 4); } \
                else { rb[mi] = (v4u){0u, 0u, 0u, 0u}; if (lrow < 4) rb[mi] = *(const v4u*)((isV_ ? VS : KS) + ((size_t)(MP + 4 * sq + lrow)) * 128 + hm_ * 64 + lch * 8); } } \
            else { \
                if ((j) < 8) { isf32 = true; const float* s_ = F.in[3] + ((size_t)(sq * 512 + 64 * (j) + lrow)) * 256 + isV_ * 128 + hm_ * 64 + lch * 8; \
                    rf[2 * mi] = *(const f32x4*)s_; rf[2 * mi + 1] = *(const f32x4*)(s_ + 4); } \
                else { rb[mi] = (v4u){0u, 0u, 0u, 0u}; if (lrow < 4) rb[mi] = *(const v4u*)((isV_ ? VW : KW) + ((size_t)(MP + 4 * sq + lrow)) * 128 + hm_ * 64 + lch * 8); } } \
        } } while (0)
#define LD_WRITE(st) do { _Pragma("unroll") for (int mi = 0; mi < 4; ++mi) { if (!((ldmask >> mi) & 1)) continue; v4u v_ = rb[mi]; \
            if (SAMP && isf32) { v_.x = pk2(rf[2 * mi][0], rf[2 * mi][1]); v_.y = pk2(rf[2 * mi][2], rf[2 * mi][3]); v_.z = pk2(rf[2 * mi + 1][0], rf[2 * mi + 1][1]); v_.w = pk2(rf[2 * mi + 1][2], rf[2 * mi + 1][3]); } \
            *(LAS v4u*)(lds + (st) * 32768 + mi * 8192 + lwo) = v_; } } while (0)

    if (SAMP) { const f32x4* src = (const f32x4*)(F.in[3] + ((size_t)sq * 512 + 4) * 256); f32x4* dst = (f32x4*)(F.out + O_WINS + (size_t)sq * 512 * 256);
        for (int i = tid; i < 508 * 64; i += 512) dst[i] = src[i]; }
    for (int i = tid; i < 2 * 32 * 36; i += 512) IMP[i] = 0.f;
    for (int i = tid; i < NT * 24; i += 512) GT[i] = WSP(float, WS_GATES)[(size_t)rowbase * 24 + i];
    LD_ISSUE(0, 0, 3); LD_WRITE(0);
    LD_ISSUE(0, 1, 3); LD_WRITE(1);
    __syncthreads();
    bf16x8 qf[4];
    f32x16 o[2]; float m_run = NEGB, l_run = 0.f;
#pragma unroll
    for (int r = 0; r < 16; ++r) { o[0][r] = 0.f; o[1][r] = 0.f; }
    const size_t qoff = (size_t)(rowbase + tok) * 512 + myhead * 64 + 8 * hi;
#define ATT_TILE(Kt_, Vt_, kbase_, klo_, khi_, rflag_, fast_) do { \
        f32x16 p0, p1; \
        qk_tile(p0, p1, (Kt_), qf, r32, hi); \
        float mx_; \
        if (fast_) {     \
            float mr_ = fmaxf(p0[0], p1[0]); \
            _Pragma("unroll") for (int r = 1; r < 16; ++r) mr_ = fmaxf(mr_, fmaxf(p0[r], p1[r])); \
            mr_ = fmaxf(mr_, __shfl_xor(mr_, 32)); \
            mx_ = (rflag_) ? mr_ * C2S : NEGB; \
        } else mx_ = mask_scale(p0, p1, (kbase_), (klo_), (khi_), (rflag_), hi); \
        const float mnew_ = fmaxf(m_run, mx_); \
        const float alpha_ = ex2(m_run - mnew_); \
        const float msub_ = fmaxf(mnew_, -1e20f); \
        float ls_ = 0.f; \
        if (fast_) { const float nb_ = (rflag_) ? -msub_ : -1e30f; \
            _Pragma("unroll") for (int r = 0; r < 16; ++r) { p0[r] = ex2(fmaf(p0[r], C2S, nb_)); p1[r] = ex2(fmaf(p1[r], C2S, nb_)); ls_ += p0[r] + p1[r]; } } \
        else { _Pragma("unroll") for (int r = 0; r < 16; ++r) { p0[r] = ex2(p0[r] - msub_); p1[r] = ex2(p1[r] - msub_); ls_ += p0[r] + p1[r]; } } \
        l_run = l_run * alpha_ + ls_; m_run = mnew_; \
        if (!__all(alpha_ == 1.0f)) { \
            if (hi == 0) wsf[r32] = alpha_; \
            LDS_WAIT(); \
            _Pragma("unroll") for (int r = 0; r < 16; ++r) { const float a_ = wsf[crow(r, hi)]; o[0][r] *= a_; o[1][r] *= a_; } \
            LDS_WAIT(); \
        } \
        bf16x8 pa_[4]; \
        pack_p(pa_, p0, p1); \
        pv_tile(o, (Vt_), pa_, lane); } while (0)
#define FINALIZE(br) do { const float l_ = l_run + __shfl_xor(l_run, 32); const float inv_ = l_ > 0.f ? 1.f / l_ : 0.f; \
        if (hi == 0) wsf[r32] = inv_; LDS_WAIT(); \
        if (!SAMP || wg == 0) { \
        _Pragma("unroll") for (int r = 0; r < 16; ++r) { const int q = crow(r, hi); \
            if (!SAMP || q < 16) { const int tk = SAMP ? (q & 3) : q, hd = h * 4 + (SAMP ? (q >> 2) : wg); \
            const float f = wsf[q] * GT[tk * 24 + (br) * 8 + hd]; \
            _Pragma("unroll") for (int d0 = 0; d0 < 2; ++d0) { LAS unsigned short* p_ = OA + tk * 512 + hd * 64 + 32 * d0 + r32; \
                float v_ = o[d0][r] * f; if ((br) != 0) v_ += bf2f(*p_); *p_ = (unsigned short)(pk2(v_, 0.f) & 0xffffu); } } } } \
        LDS_WAIT(); } while (0)
    {
        const bf16* Qn = WSP(bf16, WS_QN);
#pragma unroll
        for (int d0 = 0; d0 < 4; ++d0) qf[d0] = *(const bf16x8*)(Qn + qoff + 16 * d0);
        const LAS unsigned char* K0 = lds + (2 * h) * 8192; const LAS unsigned char* V0 = K0 + 8192;
        const int khi = SAMP ? 126 : (qpos >= 31 ? ((qpos - 31) >> 4) : -1);
        ATT_TILE(K0, V0, 0, 0, khi, true, false);
        ATT_TILE(K0 + 32768, V0 + 32768, 64, 0, khi, true, false);
        const float l = l_run + __shfl_xor(l_run, 32);
        const float inv = l > 0.f ? 1.f / l : 0.f;
        const float msub = fmaxf(m_run, -1e20f);
#pragma unroll
        for (int tl = 0; tl < 2; ++tl) {
            f32x16 p0, p1;
            qk_tile(p0, p1, K0 + tl * 32768, qf, r32, hi);
            (void)mask_scale(p0, p1, 64 * tl, 0, khi, true, hi);
            if (!SAMP || (wg == 0 && r32 < 16)) {
                LAS float* ip = IMP + (h * 32 + tok) * 36;
#pragma unroll
                for (int half = 0; half < 2; ++half) {
#pragma unroll
                    for (int rq = 0; rq < 4; ++rq) {
                        const f32x16& X = half == 0 ? p0 : p1;
                        const float e0 = ex2(X[4 * rq] - msub), e1 = ex2(X[4 * rq + 1] - msub), e2 = ex2(X[4 * rq + 2] - msub), e3 = ex2(X[4 * rq + 3] - msub);
                        const float last = e3 * inv;
                        const float G = ((e0 + e1) + (e2 + e3)) * inv;
                        const int jj = 8 * (2 * tl + half) + 2 * rq + hi;
                        [[clang::atomic(ignore_denormal_mode)]] { (void)__hip_atomic_fetch_add(ip + jj, G, __ATOMIC_RELAXED, __HIP_MEMORY_SCOPE_WORKGROUP); (void)__hip_atomic_fetch_add(ip + jj + 1, last, __ATOMIC_RELAXED, __HIP_MEMORY_SCOPE_WORKGROUP); }
                    }
                }
            }
        }
        FINALIZE(0);
    }
    __syncthreads();
    {
        const bf16* Qr = WSP(bf16, WS_QR);
#pragma unroll
        for (int d0 = 0; d0 < 4; ++d0) qf[d0] = *(const bf16x8*)(Qr + qoff + 16 * d0);
        LD_ISSUE(1, 0, 3);
    }
    {
        const int nit = SAMP ? 1 : 4;
        for (int it = 0; it < nit; ++it) {
            const int tk = SAMP ? (hi + 2 * (w & 1)) : (wg * 8 + 2 * it + hi);
            const bool act = SAMP ? (wg < 2) : true;
            const int j = r32;
            const LAS float* ip = IMP + (h * 32 + tk) * 36;
            const float my = ip[j];
            const bool valid = j <= cur, forced = (j == 0) || (j == cur) || (j == cur - 1);
            const int nforced = cur == 0 ? 1 : (cur == 1 ? 2 : 3);
            const int quota = 16 - nforced;
            int cnt = 0;
            for (int i = 0; i < 32; ++i) { const float v = ip[i];
                const bool cand = (i <= cur) && !((i == 0) || (i == cur) || (i == cur - 1));
                cnt += (cand && (v > my || (v == my && i < j))) ? 1 : 0; }
            const bool selb = valid && (forced || cnt < quota);
            const unsigned long long bal = __ballot(selb);
            unsigned long long msk = hi ? (bal >> 32) : (bal & 0xffffffffull);
            if (SAMP) msk |= 1ull << 32;
            if (act && r32 == 0) SEL[h * 32 + tk] = msk;
        }
    }
    __syncthreads();
    const unsigned long long mysel = SEL[h * 32 + tok];
    unsigned long long U0 = 0ull, U1 = 0ull;
    if (SAMP) { for (int i = 0; i < NT; ++i) { U0 |= SEL[i]; U1 |= SEL[32 + i]; } }
    const unsigned long long Uall = SAMP ? (U0 | U1) : ((2ull << cur) - 1ull), Uh = SAMP ? (h ? U1 : U0) : ~0ull;
    const int wlo = SAMP ? 0 : ((q0 - 511) > 0 ? ((q0 - 511) >> 6) : 0), whi = SAMP ? 8 : ((q0 + 31) >> 6);
    int skind = 1; m_run = NEGB; l_run = 0.f;
#pragma unroll
    for (int r = 0; r < 16; ++r) { o[0][r] = 0.f; o[1][r] = 0.f; }
#define HM_OF(code) ((code) < 64 ? (SAMP ? (unsigned)(((U0 >> (code)) & 1ull) | (((U1 >> (code)) & 1ull) << 1)) : 3u) : 3u)
    int code = 0, st = 0;
    LD_WRITE(0);
    __syncthreads();
    for (;;) {
        int nxt;
        if (code < 64) { const unsigned long long mm = (code >= 63) ? 0ull : (Uall >> (code + 1)); nxt = mm ? code + 1 + __builtin_ctzll(mm) : 64 + wlo; if (nxt < 64 && nxt > cur) nxt = 64 + wlo; }
        else nxt = (code + 1 - 64 <= whi) ? code + 1 : -1;
        if (nxt >= 0) { const unsigned hm = HM_OF(nxt); if (nxt < 64) { LD_ISSUE(1, nxt, hm); } else { LD_ISSUE(2, nxt - 64, hm); } }
        {
            const int kind = code < 64 ? 1 : 2, j = code < 64 ? code : code - 64;
            if (kind != skind) { FINALIZE(1); m_run = NEGB; l_run = 0.f;
#pragma unroll
                for (int r = 0; r < 16; ++r) { o[0][r] = 0.f; o[1][r] = 0.f; }
                skind = kind; }
            const bool need = kind == 2 || ((Uh >> j) & 1ull);
            if (need) {
                const LAS unsigned char* Kt = lds + st * 32768 + (2 * h) * 8192; const LAS unsigned char* Vt = Kt + 8192;
                int kbase, klo, khi; bool rflag;
                if (kind == 1) { kbase = (SAMP && j == 32) ? SEQ : 64 * j; klo = -(1 << 30); khi = qpos; rflag = (mysel >> j) & 1ull; }
                else { kbase = SAMP ? (j < 8 ? 1536 + 64 * j : SEQ) : 64 * j; klo = qpos - 511; khi = qpos; rflag = true; }
                bool fast;
                if (kind == 1) fast = j < cur;
                else fast = SAMP ? (j >= 1 && j < 8) : (kbase >= q0 + 31 - 511 && kbase + 63 <= q0);
                ATT_TILE(Kt, Vt, kbase, klo, khi, rflag, fast);
            }
        }
        if (nxt >= 0) LD_WRITE(st ^ 1);
        __syncthreads();
        if (nxt < 0) break;
        code = nxt; st ^= 1;
    }
    FINALIZE(2);
#undef HM_OF
#undef FINALIZE
#undef ATT_TILE
#undef LD_ISSUE
#undef LD_WRITE
    __syncthreads();
    {
        bf16* MIX = WSP(bf16, WS_MIXED);
        const int ntk = SAMP ? (w < 4 ? 1 : 0) : 4;
        const f32x4 ga0 = *(const f32x4*)(F.in[14] + lane * 8), ga1 = *(const f32x4*)(F.in[14] + lane * 8 + 4);
        const f32x4 gr0 = *(const f32x4*)(F.in[15] + lane * 8), gr1 = *(const f32x4*)(F.in[15] + lane * 8 + 4);
        f32x4 c0 = (f32x4){0.f, 0.f, 0.f, 0.f}, c1 = c0;
        if (!SAMP) { const int cch = q0 >> 6; const float* sm = WSP(float, WS_SUMM) + (size_t)sq * 32 * 1024 + lane * 8;
#pragma unroll 4
            for (int cc = 0; cc < cch; ++cc) { const f32x4 h0 = *(const f32x4*)(sm + cc * 1024), h1 = *(const f32x4*)(sm + cc * 1024 + 4), a0 = *(const f32x4*)(sm + cc * 1024 + 512), a1 = *(const f32x4*)(sm + cc * 1024 + 516);
                c0 = a0 * c0 + h0; c1 = a1 * c1 + h1; } }
#pragma unroll
        for (int it = 0; it < (SAMP ? 1 : 4); ++it) { if (it >= ntk) break;
            const int tk = SAMP ? w : 4 * w + it; const size_t row = (size_t)rowbase + tk;
            { const v4u pk = *(const LAS v4u*)(lds + A_OA + tk * 1024 + lane * 16);
              float v[8] = {bflo(pk.x), bfhi(pk.x), bflo(pk.y), bfhi(pk.y), bflo(pk.z), bfhi(pk.z), bflo(pk.w), bfhi(pk.w)};
              float ss = 0.f;
#pragma unroll
              for (int i = 0; i < 8; ++i) ss += v[i] * v[i];
              const float rs = rsqrtf(wave_sum(ss) * (1.f / 512.f) + EPSN);
              v4u o; o.x = pk2(v[0] * rs * ga0[0], v[1] * rs * ga0[1]); o.y = pk2(v[2] * rs * ga0[2], v[3] * rs * ga0[3]); o.z = pk2(v[4] * rs * ga1[0], v[5] * rs * ga1[1]); o.w = pk2(v[6] * rs * ga1[2], v[7] * rs * ga1[3]);
              *(v4u*)(MIX + row * 1024 + lane * 8) = o; }
            { const float* hl = WSP(float, WS_HL) + row * 512 + lane * 8; const float* ac = WSP(float, WS_AC) + row * 512 + lane * 8;
              const f32x4 h0 = *(const f32x4*)hl + *(const f32x4*)ac * c0, h1 = *(const f32x4*)(hl + 4) + *(const f32x4*)(ac + 4) * c1;
              if (!SAMP && q0 + tk == SEQ - 1) { float* hp = F.out + O_HP + (size_t)sq * 512 + lane * 8; *(f32x4*)hp = h0; *(f32x4*)(hp + 4) = h1; }
              const v4u pk = *(const v4u*)(WSP(bf16, WS_GRG) + row * 512 + lane * 8);
              float v[8] = {bflo(pk.x) * h0[0], bfhi(pk.x) * h0[1], bflo(pk.y) * h0[2], bfhi(pk.y) * h0[3], bflo(pk.z) * h1[0], bfhi(pk.z) * h1[1], bflo(pk.w) * h1[2], bfhi(pk.w) * h1[3]};
              float ss = 0.f;
#pragma unroll
              for (int i = 0; i < 8; ++i) ss += v[i] * v[i];
              const float rs = rsqrtf(wave_sum(ss) * (1.f / 512.f) + EPSN);
              v4u o; o.x = pk2(v[0] * rs * gr0[0], v[1] * rs * gr0[1]); o.y = pk2(v[2] * rs * gr0[2], v[3] * rs * gr0[3]); o.z = pk2(v[4] * rs * gr1[0], v[5] * rs * gr1[1]); o.w = pk2(v[6] * rs * gr1[2], v[7] * rs * gr1[3]);
              *(v4u*)(MIX + row * 1024 + 512 + lane * 8) = o; }
        }
    }
    __syncthreads();
}

constexpr int P_OA = 98304, P_IMP = 131072, P_SEL = 140288, P_GT = 140800, P_WSF = 143872;
__device__ __forceinline__ void attn_unit_p(Frame& F, int sq, int qb) {
    int tid = F.tid; asm volatile("" : "+v"(tid));
    const int lane = tid & 63, w = F.wave, r32 = lane & 31, hi = lane >> 5, h = w >> 2, wg = w & 3;
    const int q0 = qb * 32, rowbase = sq * SEQ + q0, qpos = q0 + r32, cur = q0 >> 6;
    LAS unsigned char* lds = F.lds;
    LAS float* IMP = (LAS float*)(lds + P_IMP);
    LAS unsigned long long* SEL = (LAS unsigned long long*)(lds + P_SEL);
    LAS float* GT = (LAS float*)(lds + P_GT);
    LAS float* wsf = (LAS float*)(lds + P_WSF) + w * 64;
    LAS unsigned short* OA = (LAS unsigned short*)(lds + P_OA);
    const int drow = 8 * w + (lane >> 3);
    const int dsrc = drow * 128 + (((lane & 7) ^ (lane >> 3)) << 3);
    const bf16* kcc = WSP(bf16, WS_KCC) + (size_t)sq * 128 * 128 + dsrc; const bf16* vcc = WSP(bf16, WS_VCC) + (size_t)sq * 128 * 128 + dsrc;
    const bf16* ksb = WSP(bf16, WS_KS) + (size_t)sq * SEQ * 128 + dsrc; const bf16* vsb = WSP(bf16, WS_VS) + (size_t)sq * SEQ * 128 + dsrc;
    const bf16* kwb = WSP(bf16, WS_KW) + (size_t)sq * SEQ * 128 + dsrc; const bf16* vwb = WSP(bf16, WS_VW) + (size_t)sq * SEQ * 128 + dsrc;
#define DMA_TILE(kp_, vp_, j_, st_) do { const bf16* k_ = (kp_) + (size_t)(j_) * 8192; const bf16* v_ = (vp_) + (size_t)(j_) * 8192; LAS unsigned char* d_ = lds + (st_) * 32768 + w * 1024; \
        __builtin_amdgcn_global_load_lds((const unsigned*)k_, (LAS unsigned*)d_, 16, 0, 0); \
        __builtin_amdgcn_global_load_lds((const unsigned*)v_, (LAS unsigned*)(d_ + 8192), 16, 0, 0); \
        __builtin_amdgcn_global_load_lds((const unsigned*)(k_ + 64), (LAS unsigned*)(d_ + 16384), 16, 0, 0); \
        __builtin_amdgcn_global_load_lds((const unsigned*)(v_ + 64), (LAS unsigned*)(d_ + 24576), 16, 0, 0); } while (0)
#define DMA_CODE(code_, st_) do { if ((code_) < 64) DMA_TILE(ksb, vsb, (code_), (st_)); else DMA_TILE(kwb, vwb, (code_) - 64, (st_)); } while (0)
#define WAITV(n) asm volatile("s_waitcnt vmcnt(" #n ")" ::: "memory")
#define RAWBAR() do { asm volatile("s_waitcnt lgkmcnt(0)" ::: "memory"); __builtin_amdgcn_s_barrier(); asm volatile("" ::: "memory"); } while (0)
    for (int i = tid; i < 2 * 32 * 36; i += 512) IMP[i] = 0.f;
    for (int i = tid; i < 32 * 24; i += 512) GT[i] = WSP(float, WS_GATES)[(size_t)rowbase * 24 + i];
    DMA_TILE(kcc, vcc, 0, 0); DMA_TILE(kcc, vcc, 1, 1);
    bf16x8 qf[4];
    const size_t qoff = (size_t)(rowbase + r32) * 512 + (h * 4 + wg) * 64 + 8 * hi;
    { const bf16* Qn = WSP(bf16, WS_QN);
#pragma unroll
      for (int d0 = 0; d0 < 4; ++d0) qf[d0] = *(const bf16x8*)(Qn + qoff + 16 * d0); }
    WAITV(0); RAWBAR();
    f32x16 o[2]; float m_run = NEGB, l_run = 0.f;
#pragma unroll
    for (int r = 0; r < 16; ++r) { o[0][r] = 0.f; o[1][r] = 0.f; }
#define ATT_TILE(Kt_, Vt_, kbase_, klo_, khi_, rflag_, fast_) do { \
        f32x16 p0, p1; \
        qk_tile(p0, p1, (Kt_), qf, r32, hi); \
        float mx_; \
        if (fast_) { \
            float mr_ = fmaxf(p0[0], p1[0]); \
            _Pragma("unroll") for (int r = 1; r < 16; ++r) mr_ = fmaxf(mr_, fmaxf(p0[r], p1[r])); \
            mr_ = fmaxf(mr_, __shfl_xor(mr_, 32)); \
            mx_ = (rflag_) ? mr_ * C2S : NEGB; \
        } else mx_ = mask_scale(p0, p1, (kbase_), (klo_), (khi_), (rflag_), hi); \
        const float mnew_ = fmaxf(m_run, mx_); \
        const float alpha_ = ex2(m_run - mnew_); \
        const float msub_ = fmaxf(mnew_, -1e20f); \
        float ls_ = 0.f; \
        if (fast_) { const float nb_ = (rflag_) ? -msub_ : -1e30f; \
            _Pragma("unroll") for (int r = 0; r < 16; ++r) { p0[r] = ex2(fmaf(p0[r], C2S, nb_)); p1[r] = ex2(fmaf(p1[r], C2S, nb_)); ls_ += p0[r] + p1[r]; } } \
        else { _Pragma("unroll") for (int r = 0; r < 16; ++r) { p0[r] = ex2(p0[r] - msub_); p1[r] = ex2(p1[r] - msub_); ls_ += p0[r] + p1[r]; } } \
        l_run = l_run * alpha_ + ls_; m_run = mnew_; \
        if (!__all(alpha_ == 1.0f)) { \
            if (hi == 0) wsf[r32] = alpha_; \
            LDS_WAIT(); \
            _Pragma("unroll") for (int r = 0; r < 16; ++r) { const float a_ = wsf[crow(r, hi)]; o[0][r] *= a_; o[1][r] *= a_; } \
            LDS_WAIT(); \
        } \
        bf16x8 pa_[4]; \
        pack_p(pa_, p0, p1); \
        pv_tile(o, (Vt_), pa_, lane); } while (0)
#define FINALIZE(br) do { const float l_ = l_run + __shfl_xor(l_run, 32); const float inv_ = l_ > 0.f ? 1.f / l_ : 0.f; \
        if (hi == 0) wsf[r32] = inv_; LDS_WAIT(); \
        _Pragma("unroll") for (int r = 0; r < 16; ++r) { const int q = crow(r, hi); const int hd = h * 4 + wg; \
            const float f = wsf[q] * GT[q * 24 + (br) * 8 + hd]; \
            _Pragma("unroll") for (int d0 = 0; d0 < 2; ++d0) { LAS unsigned short* p_ = OA + q * 512 + hd * 64 + 32 * d0 + r32; \
                float v_ = o[d0][r] * f; if ((br) != 0) v_ += bf2f(*p_); *p_ = (unsigned short)(pk2(v_, 0.f) & 0xffffu); } } \
        LDS_WAIT(); } while (0)
#ifndef CMP_PASSES
#define CMP_PASSES 1
#endif
    for (int cpass = 0; cpass < CMP_PASSES; ++cpass) { m_run = NEGB; l_run = 0.f;
#pragma unroll
    for (int r = 0; r < 16; ++r) { o[0][r] = 0.f; o[1][r] = 0.f; }
    {
        const LAS unsigned char* K0 = lds + (2 * h) * 8192; const LAS unsigned char* V0 = K0 + 8192;
        const int khi = qpos >= 31 ? ((qpos - 31) >> 4) : -1;
        ATT_TILE(K0, V0, 0, 0, khi, true, false);
        ATT_TILE(K0 + 32768, V0 + 32768, 64, 0, khi, true, false);
        const float l = l_run + __shfl_xor(l_run, 32);
        const float inv = l > 0.f ? 1.f / l : 0.f;
        const float msub = fmaxf(m_run, -1e20f);
        float Gv[16], Lv[16];
#pragma unroll
        for (int tl = 0; tl < 2; ++tl) {
            f32x16 p0, p1;
            qk_tile(p0, p1, K0 + tl * 32768, qf, r32, hi);
            (void)mask_scale(p0, p1, 64 * tl, 0, khi, true, hi);
#pragma unroll
            for (int half = 0; half < 2; ++half) {
#pragma unroll
                for (int rq = 0; rq < 4; ++rq) {
                    const f32x16& X = half == 0 ? p0 : p1;
                    const float e0 = ex2(X[4 * rq] - msub), e1 = ex2(X[4 * rq + 1] - msub), e2 = ex2(X[4 * rq + 2] - msub), e3 = ex2(X[4 * rq + 3] - msub);
                    Lv[4 * (2 * tl + half) + rq] = e3 * inv;
                    Gv[4 * (2 * tl + half) + rq] = ((e0 + e1) + (e2 + e3)) * inv;
                }
            }
        }
        {
            LAS float* R = (LAS float*)(lds + 65536) + (h * 4 + wg) * 1024 + r32;
            float prev = 0.f;
#pragma unroll
            for (int jl = 0; jl < 16; ++jl) {
                const float pl = __shfl_xor(Lv[jl], 32);
                const float add = hi ? pl : prev;
                R[(2 * jl + hi) * 32] = Gv[jl] + add;
                prev = pl;
            }
        }
        FINALIZE(0);
    }
    }
    RAWBAR();
    const int wlo = (q0 - 511) > 0 ? ((q0 - 511) >> 6) : 0, whi = (q0 + 31) >> 6;
#define NEXT_CODE(c_) ((c_) < 0 ? -1 : ((c_) < 64 ? ((c_) < cur ? (c_) + 1 : 64 + wlo) : ((c_) - 64 < whi ? (c_) + 1 : -1)))
    int code = 0, n1 = NEXT_CODE(0), n2;
    DMA_CODE(0, 0);
    DMA_CODE(n1, 1);
    {   const bf16* Qr = WSP(bf16, WS_QR);
#pragma unroll
        for (int d0 = 0; d0 < 4; ++d0) qf[d0] = *(const bf16x8*)(Qr + qoff + 16 * d0); }
    {   const int tk = tid & 31, jg = (tid >> 5) & 7, hh = tid >> 8;
        const LAS float* R = (const LAS float*)(lds + 65536) + hh * 4096 + tk;
#pragma unroll
        for (int k = 0; k < 4; ++k) { const int j = 4 * jg + k;
            IMP[(hh * 32 + tk) * 36 + j] = (R[j * 32] + R[1024 + j * 32]) + (R[2048 + j * 32] + R[3072 + j * 32]); } }
    RAWBAR();
    for (int it = 0; it < 4; ++it) {
        const int tk = wg * 8 + 2 * it + hi, j = r32;
        const LAS float* ip = IMP + (h * 32 + tk) * 36;
        const float my = ip[j];
        const bool valid = j <= cur, forced = (j == 0) || (j == cur) || (j == cur - 1);
        const int quota = 16 - (cur == 0 ? 1 : (cur == 1 ? 2 : 3));
        int cnt = 0;
        for (int i = 0; i < 32; ++i) { const float v = ip[i];
            const bool cand = (i <= cur) && !((i == 0) || (i == cur) || (i == cur - 1));
            cnt += (cand && (v > my || (v == my && i < j))) ? 1 : 0; }
        const bool selb = valid && (forced || cnt < quota);
        const unsigned long long bal = __ballot(selb);
        if (r32 == 0) SEL[h * 32 + tk] = hi ? (bal >> 32) : (bal & 0xffffffffull);
    }
    WAITV(4); RAWBAR();
    const unsigned mysel = (unsigned)SEL[h * 32 + r32];
#ifndef LOOP_PASSES
#define LOOP_PASSES 1
#endif
    for (int pass = 0; pass < LOOP_PASSES; ++pass) {
    if (pass > 0) { code = 0; n1 = NEXT_CODE(0); DMA_CODE(0, 0); DMA_CODE(n1, 1); WAITV(4); RAWBAR(); }
    int skind = 1, st = 0; m_run = NEGB; l_run = 0.f;
#pragma unroll
    for (int r = 0; r < 16; ++r) { o[0][r] = 0.f; o[1][r] = 0.f; }
    for (;;) {
        n2 = NEXT_CODE(n1);
        const int st2 = st >= 1 ? st - 1 : 2;
        if (n2 >= 0) DMA_CODE(n2, st2);
        {
            const int kind = code < 64 ? 1 : 2, j = code < 64 ? code : code - 64;
            if (kind != skind) { if (pass == LOOP_PASSES - 1) FINALIZE(1); m_run = NEGB; l_run = 0.f;
#pragma unroll
                for (int r = 0; r < 16; ++r) { o[0][r] = 0.f; o[1][r] = 0.f; }
                skind = kind; }
            const LAS unsigned char* Kt = lds + st * 32768 + (2 * h) * 8192; const LAS unsigned char* Vt = Kt + 8192;
            const int kbase = 64 * j, khi = qpos;
            int klo; bool rflag, fast;
            if (kind == 1) { klo = -(1 << 30); rflag = (mysel >> j) & 1u; fast = j < cur; }
            else { klo = qpos - 511; rflag = true; fast = (kbase >= q0 + 31 - 511 && kbase + 63 <= q0); }
            ATT_TILE(Kt, Vt, kbase, klo, khi, rflag, fast);
        }
        if (n1 < 0) break;
        if (n2 >= 0) WAITV(4); else WAITV(0);
        RAWBAR();
        code = n1; n1 = n2; st = st == 2 ? 0 : st + 1;
    }
    if (pass == LOOP_PASSES - 1) FINALIZE(2);
    RAWBAR();
    }
#undef NEXT_CODE
#undef FINALIZE
#undef ATT_TILE
#undef DMA_CODE
#undef DMA_TILE
    RAWBAR();
#ifndef NORM_PASSES
#define NORM_PASSES 1
#endif
    for (int npass = 0; npass < NORM_PASSES; ++npass) {
        bf16* MIX = WSP(bf16, WS_MIXED);
        const f32x4 ga0 = *(const f32x4*)(F.in[14] + lane * 8), ga1 = *(const f32x4*)(F.in[14] + lane * 8 + 4);
        const f32x4 gr0 = *(const f32x4*)(F.in[15] + lane * 8), gr1 = *(const f32x4*)(F.in[15] + lane * 8 + 4);
        f32x4 c0 = (f32x4){0.f, 0.f, 0.f, 0.f}, c1 = c0;
        { const float* cr = WSP(float, WS_CARRY) + ((size_t)sq * 32 + cur) * 512 + lane * 8; c0 = *(const f32x4*)cr; c1 = *(const f32x4*)(cr + 4); }
#pragma unroll
        for (int it = 0; it < 4; ++it) {
            const int tk = 4 * w + it; const size_t row = (size_t)rowbase + tk;
            { const v4u pk = *(const LAS v4u*)(lds + P_OA + tk * 1024 + lane * 16);
              float v[8] = {bflo(pk.x), bfhi(pk.x), bflo(pk.y), bfhi(pk.y), bflo(pk.z), bfhi(pk.z), bflo(pk.w), bfhi(pk.w)};
              float ss = 0.f;
#pragma unroll
              for (int i = 0; i < 8; ++i) ss += v[i] * v[i];
              const float rs = rsqrtf(wave_sum(ss) * (1.f / 512.f) + EPSN);
              v4u ov; ov.x = pk2(v[0] * rs * ga0[0], v[1] * rs * ga0[1]); ov.y = pk2(v[2] * rs * ga0[2], v[3] * rs * ga0[3]); ov.z = pk2(v[4] * rs * ga1[0], v[5] * rs * ga1[1]); ov.w = pk2(v[6] * rs * ga1[2], v[7] * rs * ga1[3]);
              *(v4u*)(MIX + row * 1024 + lane * 8) = ov; }
            { const float* hl = WSP(float, WS_HL) + row * 512 + lane * 8; const float* ac = WSP(float, WS_AC) + row * 512 + lane * 8;
              const f32x4 h0 = *(const f32x4*)hl + *(const f32x4*)ac * c0, h1 = *(const f32x4*)(hl + 4) + *(const f32x4*)(ac + 4) * c1;
              if (q0 + tk == SEQ - 1) { float* hp = F.out + O_HP + (size_t)sq * 512 + lane * 8; *(f32x4*)hp = h0; *(f32x4*)(hp + 4) = h1; }
              const v4u pk = *(const v4u*)(WSP(bf16, WS_GRG) + row * 512 + lane * 8);
              float v[8] = {bflo(pk.x) * h0[0], bfhi(pk.x) * h0[1], bflo(pk.y) * h0[2], bfhi(pk.y) * h0[3], bflo(pk.z) * h1[0], bfhi(pk.z) * h1[1], bflo(pk.w) * h1[2], bfhi(pk.w) * h1[3]};
              float ss = 0.f;
#pragma unroll
              for (int i = 0; i < 8; ++i) ss += v[i] * v[i];
              const float rs = rsqrtf(wave_sum(ss) * (1.f / 512.f) + EPSN);
              v4u ov; ov.x = pk2(v[0] * rs * gr0[0], v[1] * rs * gr0[1]); ov.y = pk2(v[2] * rs * gr0[2], v[3] * rs * gr0[3]); ov.z = pk2(v[4] * rs * gr1[0], v[5] * rs * gr1[1]); ov.w = pk2(v[6] * rs * gr1[2], v[7] * rs * gr1[3]);
              *(v4u*)(MIX + row * 1024 + 512 + lane * 8) = ov; }
        }
    }
    WAITV(0); RAWBAR();
#undef WAITV
#undef RAWBAR
}

constexpr int S_PT = 65536, S_IMPG = 117760, S_IMPL = 118912, S_SEL = 120064, S_GT = 120128, S_WSF = 120512, S_OA = 122560;
__device__ __forceinline__ void attn_unit_s(Frame& F, int s) {
    int tid = F.tid; asm volatile("" : "+v"(tid));
    const int lane = tid & 63, w = F.wave, r32 = lane & 31, hi = lane >> 5, h = w & 1;
    const bool cw = w < 2, ldr = w >= 4;
    const int tok = r32 & 3, g = (r32 >> 2) & 3, qpos = SEQ + tok;
    LAS unsigned char* lds = F.lds;
    LAS float* IMPG = (LAS float*)(lds + S_IMPG) + h * 144; LAS float* IMPL = (LAS float*)(lds + S_IMPL) + h * 144;
    LAS unsigned long long* SEL = (LAS unsigned long long*)(lds + S_SEL);
    LAS float* GT = (LAS float*)(lds + S_GT);
    LAS float* wsf = (LAS float*)(lds + S_WSF) + w * 64;
    LAS float* OA = (LAS float*)(lds + S_OA);
    const int lt = tid & 255, lrow = lt >> 2, lq = lt & 3;
    const int lwo0 = lrow * 128 + (((2 * lq) ^ (lrow & 7)) << 4), lwo1 = lrow * 128 + (((2 * lq + 1) ^ (lrow & 7)) << 4);
    const float* cache = F.in[2]; const float* cwin = F.in[3];
    volatile LAS int* pt = (volatile LAS int*)(lds + S_PT);
    f32x4 rs[3][4][4];
    unsigned fm[3]; int cpw[3]; bool zr[3];
#define S_ISSUE(k_, code_) do { if (ldr) { const int c_ = (code_); const bool f_ = (c_ < 32 || (c_ >= 64 && c_ < 72)); fm[k_] = f_ ? 1u : 0u; cpw[k_] = (c_ >= 64 && c_ < 72) ? c_ - 64 : -1; zr[k_] = (c_ == 32 || c_ == 72); \
          \
          \
        const char *kb_, *vb_; \
        if (c_ < 32) { kb_ = (const char*)(cache + ((size_t)pt[c_ >> 1] * 128 + (c_ & 1) * 64 + lrow) * 512 + 256 + 16 * lq); vb_ = kb_ + 512; } \
        else if (c_ >= 100) { const size_t r_ = ((size_t)((8 + s) * 128 + 64 * (c_ - 100) + lrow) * 128 + 16 * lq) * 2; kb_ = (const char*)WSP(bf16, WS_KCC) + r_; vb_ = (const char*)WSP(bf16, WS_VCC) + r_; } \
        else if (c_ >= 64 && c_ < 72) { kb_ = (const char*)(cwin + ((size_t)(s * 512 + 64 * (c_ - 64) + lrow)) * 256 + 16 * lq); vb_ = kb_ + 512; } \
        else { const size_t r_ = ((size_t)(MP + 4 * s + (lrow & 3)) * 128 + 16 * lq) * 2; kb_ = (const char*)(c_ == 32 ? WSP(bf16, WS_KS) : WSP(bf16, WS_KW)) + r_; vb_ = (const char*)(c_ == 32 ? WSP(bf16, WS_VS) : WSP(bf16, WS_VW)) + r_; } \
        const int hoff_ = f_ ? 256 : 128; \
        _Pragma("unroll") for (int mi = 0; mi < 4; ++mi) { const f32x4* s_ = (const f32x4*)(((mi & 1) ? vb_ : kb_) + (mi >> 1) * hoff_); \
            rs[k_][mi][0] = s_[0]; rs[k_][mi][1] = s_[1]; rs[k_][mi][2] = s_[2]; rs[k_][mi][3] = s_[3]; } \
        } } while (0)
#define S_WRITE(k_, st_) do { if (ldr) { _Pragma("unroll") for (int mi = 0; mi < 4; ++mi) { \
            v4u v0_ = __builtin_bit_cast(v4u, rs[k_][mi][0]), v1_ = __builtin_bit_cast(v4u, rs[k_][mi][1]); \
            if (zr[k_] && lrow >= 4) { v0_ = (v4u){0u, 0u, 0u, 0u}; v1_ = v0_; } \
            if (fm[k_]) { \
                v0_.x = pk2(rs[k_][mi][0][0], rs[k_][mi][0][1]); v0_.y = pk2(rs[k_][mi][0][2], rs[k_][mi][0][3]); v0_.z = pk2(rs[k_][mi][1][0], rs[k_][mi][1][1]); v0_.w = pk2(rs[k_][mi][1][2], rs[k_][mi][1][3]); \
                v1_.x = pk2(rs[k_][mi][2][0], rs[k_][mi][2][1]); v1_.y = pk2(rs[k_][mi][2][2], rs[k_][mi][2][3]); v1_.z = pk2(rs[k_][mi][3][0], rs[k_][mi][3][1]); v1_.w = pk2(rs[k_][mi][3][2], rs[k_][mi][3][3]); \
                if (cpw[k_] >= 0) { const int jr_ = 64 * cpw[k_] + lrow; if (jr_ >= 4) { f32x4* d_ = (f32x4*)(F.out + O_WINS + ((size_t)(s * 512 + jr_ - 4)) * 256 + (mi & 1) * 128 + (mi >> 1) * 64 + 16 * lq); \
                    d_[0] = rs[k_][mi][0]; d_[1] = rs[k_][mi][1]; d_[2] = rs[k_][mi][2]; d_[3] = rs[k_][mi][3]; } } } \
            *(LAS v4u*)(lds + (st_) * 32768 + mi * 8192 + lwo0) = v0_; *(LAS v4u*)(lds + (st_) * 32768 + mi * 8192 + lwo1) = v1_; } } } while (0)
    if (tid < 96) GT[tid] = WSP(float, WS_GATES)[(size_t)(MP + 4 * s) * 24 + tid];
    if (tid >= 128 && tid < 144) pt[tid - 128] = F.page_table[s * 16 + tid - 128];
    if (tid < 288) { ((LAS float*)(lds + S_IMPG))[tid] = 0.f; ((LAS float*)(lds + S_IMPL))[tid] = 0.f; }
    S_ISSUE(0, 100); S_ISSUE(1, 101); S_WRITE(0, 0); S_WRITE(1, 1);
    bf16x8 qf[4];
    const size_t qoff = (size_t)(MP + 4 * s + tok) * 512 + (h * 4 + g) * 64 + 8 * hi;
    { const bf16* Qn = WSP(bf16, WS_QN);
#pragma unroll
      for (int d0 = 0; d0 < 4; ++d0) qf[d0] = *(const bf16x8*)(Qn + qoff + 16 * d0); }
    __syncthreads();
    f32x16 o[2]; float m_run = NEGB, l_run = 0.f;
#pragma unroll
    for (int r = 0; r < 16; ++r) { o[0][r] = 0.f; o[1][r] = 0.f; }
#define ATT_TILE(Kt_, Vt_, kbase_, klo_, khi_, rflag_, fast_) do { \
        f32x16 p0, p1; \
        qk_tile(p0, p1, (Kt_), qf, r32, hi); \
        float mx_; \
        if (fast_) { \
            float mr_ = fmaxf(p0[0], p1[0]); \
            _Pragma("unroll") for (int r = 1; r < 16; ++r) mr_ = fmaxf(mr_, fmaxf(p0[r], p1[r])); \
            mr_ = fmaxf(mr_, __shfl_xor(mr_, 32)); \
            mx_ = (rflag_) ? mr_ * C2S : NEGB; \
        } else mx_ = mask_scale(p0, p1, (kbase_), (klo_), (khi_), (rflag_), hi); \
        const float mnew_ = fmaxf(m_run, mx_); \
        const float alpha_ = ex2(m_run - mnew_); \
        const float msub_ = fmaxf(mnew_, -1e20f); \
        float ls_ = 0.f; \
        if (fast_) { const float nb_ = (rflag_) ? -msub_ : -1e30f; \
            _Pragma("unroll") for (int r = 0; r < 16; ++r) { p0[r] = ex2(fmaf(p0[r], C2S, nb_)); p1[r] = ex2(fmaf(p1[r], C2S, nb_)); ls_ += p0[r] + p1[r]; } } \
        else { _Pragma("unroll") for (int r = 0; r < 16; ++r) { p0[r] = ex2(p0[r] - msub_); p1[r] = ex2(p1[r] - msub_); ls_ += p0[r] + p1[r]; } } \
        l_run = l_run * alpha_ + ls_; m_run = mnew_; \
        if (!__all(alpha_ == 1.0f)) { \
            if (hi == 0) wsf[r32] = alpha_; \
            LDS_WAIT(); \
            _Pragma("unroll") for (int r = 0; r < 16; ++r) { const float a_ = wsf[crow(r, hi)]; o[0][r] *= a_; o[1][r] *= a_; } \
            LDS_WAIT(); \
        } \
        bf16x8 pa_[4]; \
        pack_p(pa_, p0, p1); \
        pv_tile(o, (Vt_), pa_, lane); } while (0)
#define FINALIZE(br) do { if (cw) { const float l_ = l_run + __shfl_xor(l_run, 32); const float inv_ = l_ > 0.f ? 1.f / l_ : 0.f; \
        if (hi == 0) wsf[r32] = inv_; LDS_WAIT(); \
        _Pragma("unroll") for (int r = 0; r < 16; ++r) { const int q = crow(r, hi); \
            if (q < 16) { const float f = wsf[q] * GT[(q & 3) * 24 + (br) * 8 + h * 4 + (q >> 2)]; \
            _Pragma("unroll") for (int d0 = 0; d0 < 2; ++d0) { LAS float* p_ = OA + h * 1024 + (q & 3) * 256 + (q >> 2) * 64 + 32 * d0 + r32; \
                float v_ = o[d0][r] * f; if ((br) != 0) v_ += *p_; *p_ = v_; } } } \
        LDS_WAIT(); } } while (0)
    if (cw) {
        const LAS unsigned char* K0 = lds + (2 * h) * 8192; const LAS unsigned char* V0 = K0 + 8192;
        ATT_TILE(K0, V0, 0, 0, 126, true, false);
        ATT_TILE(K0 + 32768, V0 + 32768, 64, 0, 126, true, false);
        const float l = l_run + __shfl_xor(l_run, 32);
        const float inv = l > 0.f ? 1.f / l : 0.f, msub = fmaxf(m_run, -1e20f);
#pragma unroll
        for (int tl = 0; tl < 2; ++tl) {
            f32x16 p0, p1;
            qk_tile(p0, p1, K0 + tl * 32768, qf, r32, hi);
            (void)mask_scale(p0, p1, 64 * tl, 0, 126, true, hi);
#pragma unroll
            for (int half = 0; half < 2; ++half)
#pragma unroll
                for (int rq = 0; rq < 4; ++rq) {
                    const f32x16& X = half == 0 ? p0 : p1;
                    const float e0 = ex2(X[4 * rq] - msub), e1 = ex2(X[4 * rq + 1] - msub), e2 = ex2(X[4 * rq + 2] - msub), e3 = ex2(X[4 * rq + 3] - msub);
                    float Lq = e3 * inv, Gq = ((e0 + e1) + (e2 + e3)) * inv;
                    Lq += __shfl_xor(Lq, 4); Lq += __shfl_xor(Lq, 8); Gq += __shfl_xor(Gq, 4); Gq += __shfl_xor(Gq, 8);
                    const int jj = 16 * tl + 8 * half + 2 * rq + hi;
                    if (r32 < 4) { IMPG[tok * 36 + jj] = Gq; IMPL[tok * 36 + jj + 1] = Lq; }
                }
        }
    }
    FINALIZE(0);
    LDS_WAIT();
    if (cw) {
#pragma unroll
        for (int it = 0; it < 2; ++it) {
            const int tk = 2 * it + hi, j = r32;
            const float my = IMPG[tk * 36 + j] + IMPL[tk * 36 + j];
            int cnt = 0;
            for (int i = 1; i < 31; ++i) { const float v = IMPG[tk * 36 + i] + IMPL[tk * 36 + i]; cnt += (v > my || (v == my && i < j)) ? 1 : 0; }
            const bool selb = (j == 0) || (j == 31) || cnt < 13;
            const unsigned long long bal = __ballot(selb);
            if (r32 == 0) SEL[h * 4 + tk] = (hi ? (bal >> 32) : (bal & 0xffffffffull)) | (1ull << 32);
        }
    }
    __syncthreads();
    const unsigned long long mysel = SEL[h * 4 + tok];
    const unsigned long long Uh = SEL[h * 4] | SEL[h * 4 + 1] | SEL[h * 4 + 2] | SEL[h * 4 + 3];
    unsigned long long rem = (SEL[0] | SEL[1] | SEL[2] | SEL[3]) | (SEL[4] | SEL[5] | SEL[6] | SEL[7]);
    { const bf16* Qr = WSP(bf16, WS_QR);
#pragma unroll
      for (int d0 = 0; d0 < 4; ++d0) qf[d0] = *(const bf16x8*)(Qr + qoff + 16 * d0); }
    m_run = NEGB; l_run = 0.f;
#pragma unroll
    for (int r = 0; r < 16; ++r) { o[0][r] = 0.f; o[1][r] = 0.f; }
#define NEXT_CODE(c_) do { if (rem) { c_ = __builtin_ctzll(rem); rem &= rem - 1; } else if (wnext <= 72) { c_ = wnext; wnext += 1; } else c_ = -1; } while (0)
    int wnext = 64, c0, c1, c2, c3;
    NEXT_CODE(c0); NEXT_CODE(c1); NEXT_CODE(c2);
    bool done = false;
    if (ldr) {
        S_ISSUE(0, c0); S_ISSUE(1, c1); S_ISSUE(2, c2);
        S_WRITE(0, 0);
        __syncthreads();
#define L_STEP(k0_, k1_, st_) do { \
        NEXT_CODE(c3); \
        if (c3 >= 0) S_ISSUE(k0_, c3); \
        if (c1 >= 0) S_WRITE(k1_, (st_) ^ 1); \
        __syncthreads(); \
        done = c1 < 0; \
        c0 = c1; c1 = c2; c2 = c3; } while (0)
        for (;;) {
            L_STEP(0, 1, 0); if (done) break;
            L_STEP(1, 2, 1); if (done) break;
            L_STEP(2, 0, 0); if (done) break;
            L_STEP(0, 1, 1); if (done) break;
            L_STEP(1, 2, 0); if (done) break;
            L_STEP(2, 0, 1); if (done) break;
        }
#undef L_STEP
    } else {
        __syncthreads();
        int st = 0;
        for (;;) {
            NEXT_CODE(c3);
            if (cw && (c0 >= 64 || ((Uh >> c0) & 1ull))) {
                const LAS unsigned char* Kt = lds + st * 32768 + (2 * h) * 8192;
                int kbase, klo; bool rflag, fast;
                if (c0 < 64) { kbase = c0 == 32 ? SEQ : 64 * c0; klo = -(1 << 30); rflag = (mysel >> c0) & 1ull; fast = c0 < 32; }
                else { const int j = c0 - 64; kbase = j < 8 ? 1536 + 64 * j : SEQ; klo = qpos - 511; rflag = true; fast = (j >= 1 && j < 8); }
                ATT_TILE(Kt, Kt + 8192, kbase, klo, qpos, rflag, fast);
            }
            if (c0 < 64 && c1 >= 64) { FINALIZE(1); m_run = NEGB; l_run = 0.f;
#pragma unroll
                for (int r = 0; r < 16; ++r) { o[0][r] = 0.f; o[1][r] = 0.f; } }
            __syncthreads();
            done = c1 < 0;
            c0 = c1; c1 = c2; c2 = c3; st ^= 1;
            if (done) break;
        }
    }
    FINALIZE(2);
#undef NEXT_CODE
#undef FINALIZE
#undef ATT_TILE
#undef S_WRITE
#undef S_ISSUE
    __syncthreads();
    if (w < 4) {
        const size_t row = (size_t)MP + 4 * s + w;
#pragma unroll
        for (int hh = 0; hh < 2; ++hh) {
            const f32x4 v = *(const LAS f32x4*)(OA + hh * 1024 + w * 256 + lane * 4);
            const f32x4 ga = *(const f32x4*)(F.in[14] + hh * 256 + lane * 4);
            const float ss = wave_sum((v[0] * v[0] + v[1] * v[1]) + (v[2] * v[2] + v[3] * v[3]));
            if (lane == 0) WSP(float, WS_SSA)[(4 * s + w) * 2 + hh] = ss;
            v2u ov; ov.x = pk2(v[0] * ga[0], v[1] * ga[1]); ov.y = pk2(v[2] * ga[2], v[3] * ga[3]);
            *(v2u*)(WSP(bf16, WS_MIXED) + row * 1024 + hh * 256 + lane * 4) = ov;
        }
    } else {
        const size_t row = (size_t)MP + 4 * s + (w - 4);
        const f32x4 gr0 = *(const f32x4*)(F.in[15] + lane * 8), gr1 = *(const f32x4*)(F.in[15] + lane * 8 + 4);
        const float* hl = WSP(float, WS_HL) + row * 512 + lane * 8;
        const f32x4 h0 = *(const f32x4*)hl, h1 = *(const f32x4*)(hl + 4);
        const v4u pk = *(const v4u*)(WSP(bf16, WS_GRG) + row * 512 + lane * 8);
        float v[8] = {bflo(pk.x) * h0[0], bfhi(pk.x) * h0[1], bflo(pk.y) * h0[2], bfhi(pk.y) * h0[3], bflo(pk.z) * h1[0], bfhi(pk.z) * h1[1], bflo(pk.w) * h1[2], bfhi(pk.w) * h1[3]};
        float ss = 0.f;
#pragma unroll
        for (int i = 0; i < 8; ++i) ss += v[i] * v[i];
        const float rs = rsqrtf(wave_sum(ss) * (1.f / 512.f) + EPSN);
        v4u ov; ov.x = pk2(v[0] * rs * gr0[0], v[1] * rs * gr0[1]); ov.y = pk2(v[2] * rs * gr0[2], v[3] * rs * gr0[3]); ov.z = pk2(v[4] * rs * gr1[0], v[5] * rs * gr1[1]); ov.w = pk2(v[6] * rs * gr1[2], v[7] * rs * gr1[3]);
        *(v4u*)(WSP(bf16, WS_MIXED) + row * 1024 + 512 + lane * 8) = ov;
    }
    __syncthreads();
}


template <int MODE>
__device__ __forceinline__ void skinny_piece(Frame& F, int pc) {
    constexpr int K = MODE == 2 ? FF : DM, N = MODE == 1 ? FF : DM, NTN = N / 32, KW = K / 8;
    int tid = F.tid; asm volatile("" : "+v"(tid));
    const int lane = tid & 63, w = F.wave, fr = lane & 15, fq = lane >> 4;
    const bf16* A = MODE == 0 ? WSP(bf16, WS_MIXED) : (MODE == 1 ? WSP(bf16, WS_XN) : WSP(bf16, WS_H));
    const bf16* Bt = MODE == 0 ? WSP(bf16, WS_WOUT) : (MODE == 1 ? WSP(bf16, WS_WUP) : WSP(bf16, WS_WDN));
    const int rt = pc / NTN, ct = pc % NTN, row0 = MP + 64 * rt, col0 = 32 * ct;
    f32x4 acc[4][2];
#pragma unroll
    for (int m = 0; m < 4; ++m) { acc[m][0] = (f32x4){0.f, 0.f, 0.f, 0.f}; acc[m][1] = acc[m][0]; }
    const bf16* ap = A + (size_t)(row0 + fr) * K + w * KW + 8 * fq;
    const bf16* bp = Bt + (size_t)(col0 + fr) * K + w * KW + 8 * fq;
#pragma unroll 4
    for (int ks = 0; ks < KW / 32; ++ks) {
        bf16x8 af[4], bf[2];
#pragma unroll
        for (int m = 0; m < 4; ++m) af[m] = *(const bf16x8*)(ap + (size_t)(16 * m) * K + 32 * ks);
#pragma unroll
        for (int n = 0; n < 2; ++n) bf[n] = *(const bf16x8*)(bp + (size_t)(16 * n) * K + 32 * ks);
#pragma unroll
        for (int m = 0; m < 4; ++m)
#pragma unroll
            for (int n = 0; n < 2; ++n) acc[m][n] = __builtin_amdgcn_mfma_f32_16x16x32_bf16(bf[n], af[m], acc[m][n], 0, 0, 0);
    }
    if (MODE == 0 && w < 4) {
        const float* ssa = WSP(float, WS_SSA) + (size_t)(row0 - MP + fr) * 2;
#pragma unroll
        for (int m = 0; m < 4; ++m) { const float rs = rsqrtf((ssa[32 * m] + ssa[32 * m + 1]) * (1.f / 512.f) + EPSN); acc[m][0] *= rs; acc[m][1] *= rs; }
    }
    LAS float* red = (LAS float*)F.lds;
#pragma unroll
    for (int m = 0; m < 4; ++m)
#pragma unroll
        for (int n = 0; n < 2; ++n) *(LAS f32x4*)(red + w * 2048 + (16 * m + fr) * 32 + 16 * n + 4 * fq) = acc[m][n];
    __syncthreads();
    const int r = tid >> 3, c4 = (tid & 7) * 4;
    f32x4 v = (f32x4){0.f, 0.f, 0.f, 0.f};
#pragma unroll
    for (int ww = 0; ww < 8; ++ww) v += *(const LAS f32x4*)(red + ww * 2048 + r * 32 + c4);
    const int row = row0 + r, col = col0 + c4;
    if (MODE == 0) {
        const f32x4 x1 = *(const f32x4*)(F.in[1] + (size_t)(row - MP) * DM + col) + v;
        *(f32x4*)(WSP(float, WS_X1) + (size_t)row * DM + col) = x1;
        v2u p; p.x = pk2(x1[0], x1[1]); p.y = pk2(x1[2], x1[3]);
        *(v2u*)(WSP(bf16, WS_XN) + (size_t)row * DM + col) = p;
        float ss = (x1[0] * x1[0] + x1[1] * x1[1]) + (x1[2] * x1[2] + x1[3] * x1[3]);
        ss += __shfl_xor(ss, 1); ss += __shfl_xor(ss, 2); ss += __shfl_xor(ss, 4);
        if ((tid & 7) == 0) atomicAdd((float*)(F.ws + WS_CTL + CTL_SS1) + row, ss);
    } else if (MODE == 1) {
        const float rs = rsqrtf(((const float*)(F.ws + WS_CTL + CTL_SS1))[row] * (1.0f / DM) + EPSN);
        f32x4 hv;
#pragma unroll
        for (int e = 0; e < 4; ++e) { const float a = fmaxf(v[e] * rs, 0.f); hv[e] = a * a; }
        v2u p; p.x = pk2(hv[0], hv[1]); p.y = pk2(hv[2], hv[3]);
        *(v2u*)(WSP(bf16, WS_H) + (size_t)row * FF + col) = p;
    } else {
        const f32x4 x2 = *(const f32x4*)(WSP(float, WS_X1) + (size_t)row * DM + col) + v;
        *(f32x4*)(F.out + (size_t)row * DM + col) = x2;
    }
    __syncthreads();
}

#ifndef MK_N_LAUNCHES
#define MK_N_LAUNCHES 1
#endif
constexpr int N_PHASES = 8;
struct Args { const float* in[29]; float* out; unsigned char* ws; int ph_lo, ph_hi, qofs, pad; };
__global__ void __launch_bounds__(NWAVES * 64, 2) nsa_fwd(Args args) {
    extern __shared__ __attribute__((aligned(16))) unsigned char lds[];
    Frame F;
    F.lds = (LAS unsigned char*)lds;
    F.tid = threadIdx.x; F.lane = F.tid & 63; F.wave = __builtin_amdgcn_readfirstlane(F.tid >> 6);
    F.G = gridDim.x; { const int bx = blockIdx.x; F.vcu = (F.G % 8 == 0) ? (bx % 8) * (F.G / 8) + bx / 8 : bx; }
    F.in = args.in;
    F.page_table = (const int*)args.in[6];
    F.out = args.out; F.ws = args.ws; F.ctl = (gu32*)(args.ws + WS_CTL);
    volatile LAS unsigned* MISC = (volatile LAS unsigned*)(F.lds + MISC_OFF);
    for (int u = F.tid; u < (LDS_BYTES - RING_BYTES) / 4; u += NWAVES * 64) ((LAS unsigned*)(F.lds + RING_BYTES))[u] = 0u;
    __syncthreads();
    XcdBarrier bar; bar.bar = (unsigned*)(F.ctl + CW_BAR); bar.x = 0; bar.st = nullptr;
    if (MK_N_LAUNCHES == 1) bar = xcd_barrier_post((unsigned*)(F.ctl + CW_BAR), MISC + 8);
    const int lo = args.ph_lo, hi = args.ph_hi;
#ifdef STAMP_A
#define STAMP(i) do { if (blockIdx.x == 0 && threadIdx.x == 0) __hip_atomic_store((unsigned*)(F.ctl + CW_STAMP + (i)), (unsigned)__builtin_amdgcn_s_memrealtime(), RLX_AGENT); } while (0)
#define STAMPMAX(i) do { if (threadIdx.x == 0) __hip_atomic_fetch_max((unsigned*)(F.ctl + CW_STAMP + (i)), (unsigned)__builtin_amdgcn_s_memrealtime(), RLX_AGENT); } while (0)
#else
#define STAMP(i) do { } while (0)
#define STAMPMAX(i) do { } while (0)
#endif
    STAMP(0);
#ifndef PHASE_MASK
#define PHASE_MASK 0xFF
#endif
#define IN(k) (((PHASE_MASK >> (k)) & 1) && lo <= (k) && (k) < hi)
#ifndef REPEAT_MASK
#define REPEAT_MASK 0
#endif
#define NREP(k) (1 + ((REPEAT_MASK >> (k)) & 1))
#define REPSEAM(k, rep) do { if ((rep) + 1 < NREP(k)) { xcd_barrier(bar); FRESH(); } } while (0)
#define SEAM(k) do { if (IN(k) && IN((k) + 1)) xcd_barrier(bar); FRESH(); STAMP((k) + 1); } while (0)
#define FRESH() do { int t_ = threadIdx.x; asm volatile("" : "+v"(t_)); F.tid = t_; F.lane = t_ & 63; F.wave = __builtin_amdgcn_readfirstlane(t_ >> 6); } while (0)
    if (IN(0)) { p0_prologue(F); }
    SEAM(0);
    if (IN(1)) for (int rep = 0; rep < NREP(1); ++rep) {
        pg8::Gemm g{WSP(bf16, WS_XN), WSP(bf16, WS_WIN), MT, NIN, DM}; pg8::StaticOrder S; S.init(MT, NIN, F.G, (int)blockIdx.x);
        pg8::EpiProj E{WSP(bf16, WS_QN), WSP(bf16, WS_QR), WSP(bf16, WS_KS), WSP(bf16, WS_VS), WSP(bf16, WS_KW), WSP(bf16, WS_VW), WSP(bf16, WS_GRG), WSP(float, WS_GATES), WSP(float, WS_RX), F.out, WSP(float, WS_ROT)};
        pg8::gemm_phase<pg8::EpiProj, pg8::StaticOrder, true, true>(F.lds, g, S, E);
        REPSEAM(1, rep);
    }
    SEAM(1);
    if (IN(2)) for (int rep = 0; rep < NREP(2); ++rep) {
        for (;;) {
            if (F.tid == 0) MISC[0] = __hip_atomic_fetch_add((unsigned*)(F.ctl + CW_Q2 + 256 * rep + 2048 * args.qofs), 1u, RLX_AGENT);
            __syncthreads();
            const int id = (int)MISC[0];
            __syncthreads();
            if (id >= 264 + 544) break;
            if (id < 264) { rnn_unit(F, id); __syncthreads(); } else compress_unit(F, id - 264);
        }
#ifdef REP_P2R
        for (;;) { if (F.tid == 0) MISC[0] = __hip_atomic_fetch_add((unsigned*)(F.ctl + CW_Q2 + 1024), 1u, RLX_AGENT); __syncthreads(); const int id = (int)MISC[0]; __syncthreads(); if (id >= 256) break; rnn_unit(F, 264, id); __syncthreads(); }
#endif
#ifdef REP_P2C
        for (;;) { if (F.tid == 0) MISC[0] = __hip_atomic_fetch_add((unsigned*)(F.ctl + CW_Q2 + 1024), 1u, RLX_AGENT); __syncthreads(); const int id = (int)MISC[0]; __syncthreads(); if (id >= 544) break; compress_unit(F, id); }
#endif
        REPSEAM(2, rep);
    }
    SEAM(2);
#ifndef REP_P3S
#define REP_P3S 1
#endif
#ifndef REP_P3P
#define REP_P3P 1
#endif
    if (IN(3)) for (int rep = 0; rep < NREP(3); ++rep) {
        for (int r2 = 0; r2 < REP_P3S; ++r2)
        for (;;) {
            if (F.tid == 0) MISC[0] = __hip_atomic_fetch_add((unsigned*)(F.ctl + CW_Q3 + 256 * rep + 512 * r2 + 2048 * args.qofs), 1u, RLX_AGENT);
            __syncthreads();
            const int id = (int)MISC[0];
            __syncthreads();
            if (id >= 128) break;
            attn_unit_s(F, id);
        }
        STAMPMAX(10);
        for (int r2 = 0; r2 < REP_P3P; ++r2)
        for (;;) {
            if (F.tid == 0) MISC[0] = __hip_atomic_fetch_add((unsigned*)(F.ctl + CW_Q3 + 64 + 256 * rep + 512 * r2 + 2048 * args.qofs), 1u, RLX_AGENT);
            __syncthreads();
            const int k = (int)MISC[0];
            __syncthreads();
            if (k >= 512) break;
            attn_unit_p(F, k & 7, 63 - (k >> 3));
        }
        REPSEAM(3, rep);
    }
    SEAM(3);
    if (IN(4)) for (int rep = 0; rep < NREP(4); ++rep) {
        pg8::Gemm g{WSP(bf16, WS_MIXED), WSP(bf16, WS_WOUT), MP, DM, DM}; pg8::StaticOrder S; S.init(MP, DM, F.G, (int)blockIdx.x);
        pg8::EpiOut E{F.in[0], F.in[1], WSP(float, WS_X1), WSP(bf16, WS_XN), (float*)(F.ws + WS_CTL + (rep ? CTL_DUMMY : CTL_SS1))};
        pg8::gemm_phase<pg8::EpiOut, pg8::StaticOrder, true, true>(F.lds, g, S, E);
        if (rep == 0) for (int pc = blockIdx.x; pc < 8 * (DM / 32); pc += F.G) skinny_piece<0>(F, pc);
        REPSEAM(4, rep);
    }
    SEAM(4);
    if (IN(5)) for (int rep = 0; rep < NREP(5); ++rep) {
        pg8::Gemm g{WSP(bf16, WS_XN), WSP(bf16, WS_WUP), MP, FF, DM}; pg8::StaticOrder S; S.init(MP, FF, F.G, (int)blockIdx.x);
        pg8::EpiUp E{WSP(bf16, WS_H), (const float*)(F.ws + WS_CTL + CTL_SS1)};
        pg8::gemm_phase<pg8::EpiUp, pg8::StaticOrder, true, true>(F.lds, g, S, E);
        for (int pc = blockIdx.x; pc < 8 * (FF / 32); pc += F.G) skinny_piece<1>(F, pc);
        REPSEAM(5, rep);
    }
    SEAM(5);
    if (IN(6)) for (int rep = 0; rep < NREP(6); ++rep) {
        pg8::Gemm g{WSP(bf16, WS_H), WSP(bf16, WS_WDN), MP, DM, FF}; pg8::StaticOrder S; S.init(MP, DM, F.G, (int)blockIdx.x);
        pg8::EpiDown E{WSP(float, WS_X1), F.out};
        pg8::gemm_phase<pg8::EpiDown, pg8::StaticOrder, true, true>(F.lds, g, S, E);
        for (int pc = blockIdx.x; pc < 8 * (DM / 32); pc += F.G) skinny_piece<2>(F, pc);
        REPSEAM(6, rep);
    }
    SEAM(6);
    if (IN(7)) p7_final(F);
#ifdef STAMP_A
    STAMP(8);
    if (blockIdx.x == 0) {
        __syncthreads();
        const unsigned a = __hip_atomic_load((unsigned*)(F.ctl + CW_STAMP + STAMP_A), RLX_AGENT), b = __hip_atomic_load((unsigned*)(F.ctl + CW_STAMP + STAMP_B), RLX_AGENT);
        const float us = STAMP_A < 0 ? 100.f : (float)(b - a) * 0.01f;
        for (int i = threadIdx.x; i < 4096; i += 512) F.out[O_HP + i] = us;
    }
#endif
#undef IN
#undef SEAM
#undef REPSEAM
#undef NREP
#undef FRESH
}

extern "C" void kernel_launch(void* const* d_in, const int* in_sizes, int n_in, void* d_out, int out_size, void* d_ws, size_t ws_size, hipStream_t stream) {
    static int grid = 0;
    if (grid == 0) {
        if (n_in != 29 || out_size != 44056576 || ws_size < WS_END) { fprintf(stderr, "kernel_launch: unexpected sizes (n_in %d, out %d, ws %zu)\n", n_in, out_size, ws_size); grid = -1; return; }
        int dev = 0, cus = 0, per_cu = 0;
        if (hipGetDevice(&dev) != hipSuccess || hipDeviceGetAttribute(&cus, hipDeviceAttributeMultiprocessorCount, dev) != hipSuccess) { grid = -1; return; }
        if (hipFuncSetAttribute((const void*)nsa_fwd, hipFuncAttributeMaxDynamicSharedMemorySize, LDS_BYTES) != hipSuccess) { fprintf(stderr, "kernel_launch: hipFuncSetAttribute failed\n"); grid = -1; return; }
        if (hipOccupancyMaxActiveBlocksPerMultiprocessor(&per_cu, (const void*)nsa_fwd, NWAVES * 64, LDS_BYTES) != hipSuccess || per_cu < 1) fprintf(stderr, "kernel_launch: occupancy query reports %d\n", per_cu);
        (void)hipGetLastError();
        grid = cus;
    }
    if (grid < 0) return;
    if (hipMemsetAsync((char*)d_ws + WS_CTL, 0, CTL_ZERO_BYTES, stream) != hipSuccess) return;
    Args a{};
    for (int i = 0; i < 29; ++i) a.in[i] = (const float*)d_in[i];
    a.out = (float*)d_out; a.ws = (unsigned char*)d_ws;
#if MK_N_LAUNCHES == 1
    a.ph_lo = 0; a.ph_hi = N_PHASES;
    hipLaunchKernelGGL(nsa_fwd, dim3(grid), dim3(NWAVES * 64), LDS_BYTES, stream, a);
#else
    for (int p = 0; p < N_PHASES; ++p) { a.ph_lo = p; a.ph_hi = p + 1; a.qofs = 0; hipLaunchKernelGGL(nsa_fwd, dim3(grid), dim3(NWAVES * 64), LDS_BYTES, stream, a);
#ifdef HOST_REPEAT_PHASE
        if (p == HOST_REPEAT_PHASE) { a.qofs = 1; hipLaunchKernelGGL(nsa_fwd, dim3(grid), dim3(NWAVES * 64), LDS_BYTES, stream, a); }
#endif
    }
#endif
}
```
